# Optimizing an MI355X kernel written in HIP

```python
import math
import jax, jax.numpy as jnp
from jax import lax
import numpy as np

D_MODEL = 1024
BATCH = 32
SEQ = 2048
DEPTH = 1

PLE_DIM = 256
EPS = 1e-6
NEG = -1e30

HEAD_DIM_A = 64
A_WIDTH = D_MODEL // 2
N_HEADS_A = A_WIDTH // HEAD_DIM_A
DILATED_BRANCHES = ((128, 1), (512, 4), (2048, 16))
BAND_BLOCK = 128

REL_BUCKETS = 32
REL_MAX_DISTANCE = 2048

M_WIDTH = D_MODEL - A_WIDTH
V_DIM = 64
N_HEADS_M = M_WIDTH // V_DIM
Q_LORA = 384
KV_LORA = 256
NOPE_DIM = 64
ROPE_DIM = 32
ROPE_THETA = 10000.0
QUERY_BLOCK = 128

IN_COLS = 3 * A_WIDTH + Q_LORA + KV_LORA + ROPE_DIM

N_GROUPS = 4
EXPERTS_PER_GROUP = 8
N_EXPERTS = N_GROUPS * EXPERTS_PER_GROUP
TOP_K_IN_GROUP = 2
EXPERT_FF = 512
MOE_BLOCK = 256

kernel_name = "hybrid_dilated_mla_hiermoe_layer"


def rms_norm(x, gain):
    xf = x.astype(jnp.float32)
    y = xf * lax.rsqrt(jnp.mean(xf * xf, axis=-1, keepdims=True) + EPS)
    return (y * gain.astype(jnp.float32)).astype(x.dtype)


def rope(x, pos):
    half = ROPE_DIM // 2
    inv = 1.0 / (ROPE_THETA ** (jnp.arange(half, dtype=jnp.float32) * 2.0 / ROPE_DIM))
    ang = pos.astype(jnp.float32)[:, None] * inv[None, :]
    cos = jnp.cos(ang)[:, None, :]
    sin = jnp.sin(ang)[:, None, :]
    xf = x.astype(jnp.float32)
    x1, x2 = xf[..., :half], xf[..., half:]
    return jnp.concatenate([x1 * cos - x2 * sin, x2 * cos + x1 * sin], axis=-1).astype(x.dtype)


def t5_bucket(dist):
    max_exact = REL_BUCKETS // 2
    n = jnp.maximum(dist, 0)
    nf = jnp.maximum(n, 1).astype(jnp.float32)
    large = max_exact + (jnp.log(nf / max_exact) / math.log(REL_MAX_DISTANCE / max_exact)
                         * (REL_BUCKETS - max_exact)).astype(jnp.int32)
    large = jnp.minimum(large, REL_BUCKETS - 1)
    return jnp.where(n < max_exact, n, large)


def dilated_branch(q, k, v, rel_bias, window, dilation):
    B, S, H, Dh = q.shape
    L = S // dilation
    nb = -(-L // BAND_BLOCK)
    Lp = nb * BAND_BLOCK
    band = window // dilation
    BB = BAND_BLOCK

    def to_sub(t):
        t = t.reshape(B, L, dilation, H, Dh).transpose(0, 3, 2, 1, 4)
        t = jnp.pad(t, ((0, 0), (0, 0), (0, 0), (0, Lp - L), (0, 0)))
        return t.reshape(B, H, dilation, nb, BB, Dh)

    def with_prev(t):
        prev = jnp.pad(t, ((0, 0), (0, 0), (0, 0), (1, 0), (0, 0), (0, 0)))[:, :, :, :-1]
        return jnp.concatenate([prev, t], axis=4)

    qs = to_sub(q)
    kk = with_prev(to_sub(k))
    vv = with_prev(to_sub(v)).astype(jnp.float32)

    s = jnp.einsum('bhrnid,bhrnjd->bhrnij', qs, kk).astype(jnp.float32) * (Dh ** -0.5)
    i = jnp.arange(BB)[:, None]
    j = jnp.arange(2 * BB)[None, :]
    delta = BB + i - j
    bias = rel_bias.astype(jnp.float32)[t5_bucket(delta * dilation)]
    bias = bias.transpose(2, 0, 1)[:, None, None]
    band_ok = (delta >= 0) & (delta <= band)
    key_ok = (jnp.arange(nb)[:, None, None] > 0) | (j[None] >= BB)
    mask = band_ok[None] & key_ok
    s = jnp.where(mask, s + bias, NEG)
    m = jnp.max(s, axis=-1, keepdims=True)
    e = jnp.exp(s - m)
    den = jnp.sum(e, axis=-1)
    o = jnp.einsum('bhrnij,bhrnjd->bhrnid', e, vv) / den[..., None]
    lse = m[..., 0] + jnp.log(den)

    o = o.reshape(B, H, dilation, Lp, Dh)[:, :, :, :L].transpose(0, 3, 2, 1, 4).reshape(B, S, H, Dh)
    lse = lse.reshape(B, H, dilation, Lp)[:, :, :, :L].transpose(0, 3, 2, 1).reshape(B, S, H)
    return o, lse


def dilated_attention(q, k, v, rel_bias):
    outs, lses = [], []
    for window, dilation in DILATED_BRANCHES:
        o, lse = dilated_branch(q, k, v, rel_bias, window, dilation)
        outs.append(o)
        lses.append(lse)
    w = jax.nn.softmax(jnp.stack(lses), axis=0)
    o = jnp.sum(w[..., None] * jnp.stack(outs), axis=0)
    B, S, H, Dh = o.shape
    return o.reshape(B, S, H * Dh)


def mla(cq, ckv, kr, q_a_gain, w_q_up, kv_a_gain, w_kv_up,
        qn_nope_gain, qn_rope_gain, kn_nope_gain, kn_rope_gain, pos):
    B, S, _ = cq.shape
    q = (rms_norm(cq, q_a_gain) @ w_q_up).reshape(B, S, N_HEADS_M, NOPE_DIM + ROPE_DIM)
    kv = (rms_norm(ckv, kv_a_gain) @ w_kv_up).reshape(B, S, N_HEADS_M, NOPE_DIM + V_DIM)
    k_nope, v = kv[..., :NOPE_DIM], kv[..., NOPE_DIM:]
    q_nope = rms_norm(q[..., :NOPE_DIM], qn_nope_gain)
    q_rope = rope(rms_norm(q[..., NOPE_DIM:], qn_rope_gain), pos)
    k_nope = rms_norm(k_nope, kn_nope_gain)
    k_rope = rope(rms_norm(kr, kn_rope_gain)[:, :, None, :], pos)
    qh = jnp.concatenate([q_nope, q_rope], axis=-1).transpose(0, 2, 1, 3)
    kh = jnp.concatenate([k_nope, jnp.broadcast_to(k_rope, (B, S, N_HEADS_M, ROPE_DIM))],
                         axis=-1).transpose(0, 2, 1, 3)
    vh = v.transpose(0, 2, 1, 3).astype(jnp.float32)
    scale = (NOPE_DIM + ROPE_DIM) ** -0.5
    nq = S // QUERY_BLOCK
    qb = qh.reshape(B, N_HEADS_M, nq, QUERY_BLOCK, NOPE_DIM + ROPE_DIM).transpose(2, 0, 1, 3, 4)
    kpos = jnp.arange(S)

    def block(args):
        qi, bi = args
        s = jnp.einsum('bhid,bhjd->bhij', qi, kh).astype(jnp.float32) * scale
        qpos = bi * QUERY_BLOCK + jnp.arange(QUERY_BLOCK)
        s = jnp.where(kpos[None, :] <= qpos[:, None], s, NEG)
        pr = jax.nn.softmax(s, axis=-1)
        return jnp.einsum('bhij,bhjd->bhid', pr, vh)

    o = lax.map(block, (qb, jnp.arange(nq)))
    return o.transpose(1, 0, 3, 2, 4).reshape(B, S, N_HEADS_M * V_DIM)


def hier_moe(xn, w_rg, b_rg, w_re, b_re, w_gate, w_up, w_down):
    B, S, D = xn.shape
    N = B * S
    K = TOP_K_IN_GROUP
    xt = xn.reshape(N, D)
    gprob = jax.nn.softmax((xt @ w_rg + b_rg).astype(jnp.float32), axis=-1)
    g_gate, g_idx = lax.top_k(gprob, 1)
    elog = (xt @ w_re + b_re).astype(jnp.float32).reshape(N, N_GROUPS, EXPERTS_PER_GROUP)
    elog = jnp.take_along_axis(elog, g_idx[:, :, None], axis=1)[:, 0]
    e_w, e_idx = lax.top_k(jax.nn.softmax(elog, axis=-1), K)
    e_w = e_w / jnp.sum(e_w, axis=-1, keepdims=True)
    weights = (g_gate * e_w).reshape(-1)
    flat_e = (g_idx * EXPERTS_PER_GROUP + e_idx).reshape(-1).astype(jnp.int32)
    flat_t = jnp.repeat(jnp.arange(N, dtype=jnp.int32), K)
    order = jnp.argsort(flat_e)
    sorted_e = flat_e[order]
    counts = jax.ops.segment_sum(jnp.ones_like(flat_e), flat_e, num_segments=N_EXPERTS)
    pcounts = (counts + MOE_BLOCK - 1) // MOE_BLOCK * MOE_BLOCK
    pend = jnp.cumsum(pcounts)
    pstart = pend - pcounts
    start = jnp.cumsum(counts) - counts
    dest = pstart[sorted_e] + (jnp.arange(N * K, dtype=jnp.int32) - start[sorted_e])
    R = N * K + N_EXPERTS * MOE_BLOCK
    row_tok = jnp.full((R,), N, jnp.int32).at[dest].set(flat_t[order])
    row_w = jnp.zeros((R,), jnp.float32).at[dest].set(weights[order])
    x_pad = jnp.concatenate([xt, jnp.zeros((1, D), xt.dtype)], axis=0)
    xr = x_pad[row_tok].reshape(R // MOE_BLOCK, MOE_BLOCK, D)
    blk_e = jnp.minimum(jnp.searchsorted(pend, jnp.arange(R // MOE_BLOCK) * MOE_BLOCK, side='right'),
                        N_EXPERTS - 1)

    def expert_block(args):
        xb, e = args
        hdn = jax.nn.silu(xb @ w_gate[e]) * (xb @ w_up[e])
        return hdn @ w_down[e]

    y = lax.map(expert_block, (xr, blk_e)).reshape(R, D)
    out = jax.ops.segment_sum(y.astype(jnp.float32) * row_w[:, None], row_tok, num_segments=N + 1)[:N]
    return out.reshape(B, S, D).astype(xn.dtype)


def setup_inputs(seed: int = 0) -> dict:
    key = jax.random.key(seed)
    ks = jax.random.split(key, 32)
    f32 = jnp.float32
    L = DEPTH
    D = D_MODEL

    def w(k, shape, fan_in):
        return jax.random.normal(k, shape, f32) * (fan_in ** -0.5)

    def gain(k, shape):
        return 1.0 + 0.05 * jax.random.normal(k, shape, f32)

    return {
        "x": jax.random.normal(ks[0], (BATCH, SEQ, D), f32),
        "p": jax.random.normal(ks[1], (DEPTH, BATCH, SEQ, PLE_DIM), f32),
        "rel_bias": 0.5 * jax.random.normal(ks[2], (REL_BUCKETS, N_HEADS_A), f32),
        "norm_mix_gain": gain(ks[3], (L, D)),
        "w_in": w(ks[4], (L, D, IN_COLS), D),
        "qn_a_gain": gain(ks[5], (L, HEAD_DIM_A)),
        "kn_a_gain": gain(ks[6], (L, HEAD_DIM_A)),
        "q_a_gain": gain(ks[7], (L, Q_LORA)),
        "w_q_up": w(ks[8], (L, Q_LORA, N_HEADS_M * (NOPE_DIM + ROPE_DIM)), Q_LORA),
        "kv_a_gain": gain(ks[9], (L, KV_LORA)),
        "w_kv_up": w(ks[10], (L, KV_LORA, N_HEADS_M * (NOPE_DIM + V_DIM)), KV_LORA),
        "qn_nope_gain": gain(ks[11], (L, NOPE_DIM)),
        "qn_rope_gain": gain(ks[12], (L, ROPE_DIM)),
        "kn_nope_gain": gain(ks[13], (L, NOPE_DIM)),
        "kn_rope_gain": gain(ks[14], (L, ROPE_DIM)),
        "w_out": w(ks[15], (L, A_WIDTH + M_WIDTH, D), A_WIDTH + M_WIDTH),
        "norm_ffn_gain": gain(ks[16], (L, D)),
        "w_router_group": w(ks[17], (L, D, N_GROUPS), D),
        "b_router_group": 0.01 * jax.random.normal(ks[18], (L, N_GROUPS), f32),
        "w_router_expert": w(ks[19], (L, D, N_EXPERTS), D),
        "b_router_expert": 0.01 * jax.random.normal(ks[20], (L, N_EXPERTS), f32),
        "w_exp_gate": w(ks[21], (L, N_EXPERTS, D, EXPERT_FF), D),
        "w_exp_up": w(ks[22], (L, N_EXPERTS, D, EXPERT_FF), D),
        "w_exp_down": w(ks[23], (L, N_EXPERTS, EXPERT_FF, D), EXPERT_FF),
        "w_ple_proj": w(ks[24], (L, PLE_DIM, D), PLE_DIM),
        "ple_norm_gain": gain(ks[25], (L, D)),
        "w_ple_gate": w(ks[26], (L, D, D), D),
        "b_ple_gate": 0.1 * jax.random.normal(ks[27], (L, D), f32),
    }


def reference(x, p, rel_bias, norm_mix_gain, w_in, qn_a_gain, kn_a_gain, q_a_gain, w_q_up,
              kv_a_gain, w_kv_up, qn_nope_gain, qn_rope_gain, kn_nope_gain, kn_rope_gain,
              w_out, norm_ffn_gain, w_router_group, b_router_group, w_router_expert,
              b_router_expert, w_exp_gate, w_exp_up, w_exp_down, w_ple_proj, ple_norm_gain,
              w_ple_gate, b_ple_gate):
    B, S, D = x.shape
    pos = jnp.arange(S, dtype=jnp.int32)
    h = x
    c0 = 0
    c1 = A_WIDTH
    c2 = 2 * A_WIDTH
    c3 = 3 * A_WIDTH
    c4 = c3 + Q_LORA
    c5 = c4 + KV_LORA
    for i in range(DEPTH):
        xn = rms_norm(h, norm_mix_gain[i])
        proj = xn @ w_in[i]
        qa = rms_norm(proj[..., c0:c1].reshape(B, S, N_HEADS_A, HEAD_DIM_A), qn_a_gain[i])
        ka = rms_norm(proj[..., c1:c2].reshape(B, S, N_HEADS_A, HEAD_DIM_A), kn_a_gain[i])
        va = proj[..., c2:c3].reshape(B, S, N_HEADS_A, HEAD_DIM_A)
        o_a = dilated_attention(qa, ka, va, rel_bias)
        o_m = mla(proj[..., c3:c4], proj[..., c4:c5], proj[..., c5:], q_a_gain[i], w_q_up[i],
                  kv_a_gain[i], w_kv_up[i], qn_nope_gain[i], qn_rope_gain[i],
                  kn_nope_gain[i], kn_rope_gain[i], pos)
        mix = jnp.concatenate([o_a, o_m], axis=-1).astype(h.dtype)
        h = h + mix @ w_out[i]
        h = h + hier_moe(rms_norm(h, norm_ffn_gain[i]), w_router_group[i], b_router_group[i],
                         w_router_expert[i], b_router_expert[i], w_exp_gate[i], w_exp_up[i],
                         w_exp_down[i])
        e = rms_norm(p[i] @ w_ple_proj[i], ple_norm_gain[i]).astype(jnp.float32)
        g = jax.nn.sigmoid((h @ w_ple_gate[i] + b_ple_gate[i]).astype(jnp.float32))
        h = h + (g * e).astype(h.dtype)
    return h
```

```cpp
#include <hip/hip_runtime.h>
#include <cstdio>
#include <cstdint>

#define LAS __attribute__((address_space(3)))
#define GAS __attribute__((address_space(1)))
typedef unsigned short bf16_t;
typedef short bf16x8 __attribute__((ext_vector_type(8)));
typedef short s16x4 __attribute__((ext_vector_type(4)));
typedef short v4i16_t __attribute__((ext_vector_type(4)));
typedef float f32x4 __attribute__((ext_vector_type(4)));
typedef float f32x2 __attribute__((ext_vector_type(2)));
typedef float f32x16 __attribute__((ext_vector_type(16)));
typedef unsigned u32x4 __attribute__((ext_vector_type(4)));
typedef unsigned u32x2 __attribute__((ext_vector_type(2)));
typedef int i32x4 __attribute__((ext_vector_type(4)));
typedef __bf16 bf16x2_t __attribute__((ext_vector_type(2)));

constexpr int BATCH = 32, SEQ = 2048, DM = 1024, M = BATCH * SEQ;
constexpr int PLE = 256;
constexpr int AW = 512, QLORA = 384, KVLORA = 256, ROPE = 32;
constexpr int INC = 2208, INC_PAD = 2304;
constexpr int NEXP = 32, EFF = 512, NPAIR = 112;
constexpr int MAXT = 368;
constexpr float EPS = 1e-6f;
constexpr float LOG2E = 1.4426950408889634f;
constexpr float C2A = 0.125f * LOG2E;
constexpr float C2M = 0.10206207261596575f * LOG2E;

constexpr size_t MiB = 1u << 20;
constexpr size_t WS_CTL = 0, CTL_ZERO_BYTES = 1 * MiB;
constexpr size_t WS_TBG = 1 * MiB;
constexpr size_t WS_ROPE = 1 * MiB + 65536;
constexpr size_t WS_ROWREC = 2 * MiB;
constexpr size_t WS_ROWOFF = 3 * MiB + 524288;
constexpr size_t WS_ROUTE = 4 * MiB;
constexpr size_t WS_RSTD2 = 5 * MiB;
constexpr size_t WS_SSQCQ = 6 * MiB;
constexpr size_t WS_SSQCKV = 8 * MiB;
constexpr size_t WS_SSQH1 = 9 * MiB;
constexpr size_t WS_SSQE = 13 * MiB;
constexpr size_t WS_LSE2 = 17 * MiB;
constexpr size_t WS_LSE3 = 19 * MiB;
constexpr size_t WS_KROPE = 21 * MiB;
constexpr size_t WS_WIN = 25 * MiB;
constexpr size_t WS_WQUP = 30 * MiB;
constexpr size_t WS_WKVUP = 31 * MiB;
constexpr size_t WS_WR = 32 * MiB;
constexpr size_t WS_WOUT = 33 * MiB;
constexpr size_t WS_WPP = 35 * MiB;
constexpr size_t WS_WPG = 36 * MiB;
constexpr size_t WS_WGU = 40 * MiB;
constexpr size_t WS_WD = 104 * MiB;
constexpr size_t WS_XN = 136 * MiB;
constexpr size_t WS_MIX = WS_XN;
constexpr size_t WS_QA = 264 * MiB, WS_KA = 328 * MiB, WS_VA = 392 * MiB;
constexpr size_t WS_HDN = 264 * MiB;
constexpr size_t WS_QM = 456 * MiB;
constexpr size_t WS_KN = 552 * MiB, WS_VM = 616 * MiB;
constexpr size_t WS_H2B = 456 * MiB;
constexpr size_t WS_PB = 680 * MiB;
constexpr size_t WS_CQ = 712 * MiB;
constexpr size_t WS_CKV = 760 * MiB;
constexpr size_t WS_O2 = 680 * MiB, WS_O3 = 744 * MiB;
constexpr size_t WS_H1B = 680 * MiB;
constexpr size_t WS_E = 808 * MiB;
constexpr size_t WS_END = 936 * MiB;
constexpr int CW_BAR = 4096;
constexpr int CW_CNT = 16384;

constexpr int RING_BYTES = 131072;
constexpr int ATT_WSF = 98304;
constexpr int ATT_OST = 102400;
constexpr int MISC_OFF = 135168;
constexpr int TB_OFF = MISC_OFF + 512;
constexpr int MOE_OFF = TB_OFF + 3840;
constexpr int LDS_BYTES = 147456;
static_assert(MOE_OFF + 128 * 4 * 2 + MAXT * 4 <= LDS_BYTES, "LDS map");

#define LDS_WAIT() asm volatile("s_waitcnt lgkmcnt(0)" ::: "memory")
#define VM_WAIT() asm volatile("s_waitcnt vmcnt(0)" ::: "memory")
#define RLX_AGENT __ATOMIC_RELAXED, __HIP_MEMORY_SCOPE_AGENT

__device__ __forceinline__ unsigned pk2(float lo, float hi) { f32x2 v = {lo, hi}; bf16x2_t b = __builtin_convertvector(v, bf16x2_t); return __builtin_bit_cast(unsigned, b); }
__device__ __forceinline__ float bflo(unsigned u) { return __uint_as_float(u << 16); }
__device__ __forceinline__ float bfhi(unsigned u) { return __uint_as_float(u & 0xffff0000u); }
__device__ __forceinline__ void st8(bf16_t* p, f32x4 a, f32x4 b) { u32x4 w; w.x = pk2(a[0], a[1]); w.y = pk2(a[2], a[3]); w.z = pk2(b[0], b[1]); w.w = pk2(b[2], b[3]); *(u32x4*)p = w; }
__device__ __forceinline__ void ld8(const bf16_t* p, f32x4& a, f32x4& b) { const u32x4 w = *(const u32x4*)p; a = (f32x4){bflo(w.x), bfhi(w.x), bflo(w.y), bfhi(w.y)}; b = (f32x4){bflo(w.z), bfhi(w.z), bflo(w.w), bfhi(w.w)}; }
__device__ __forceinline__ float dot4(f32x4 a) { return (a[0] * a[0] + a[1] * a[1]) + (a[2] * a[2] + a[3] * a[3]); }
__device__ __forceinline__ float red_fq(float s) { s += __shfl_xor(s, 16); s += __shfl_xor(s, 32); return s; }
__device__ __forceinline__ float rsq(float x) { return __builtin_amdgcn_rsqf(x); }
__device__ __forceinline__ float fexp2(float x) { return __builtin_amdgcn_exp2f(x); }
__device__ __forceinline__ float frcp(float x) { return __builtin_amdgcn_rcpf(x); }

namespace pg8 {
constexpr int BM = 256, BK = 64, HALF = 128, HTB = HALF * BK * 2, STAGE_BYTES = 8 * HTB, NXCD = 8, WGM = 8;
__host__ __device__ __forceinline__ int lds_byte(int r, int c) { const int st = (r >> 4) * 2 + (c >> 5), rr = r & 15, cc = c & 31, ob = rr * 64 + cc * 2; return st * 1024 + (ob ^ (((ob >> 9) & 1) << 5)); }
__host__ __device__ __forceinline__ void stage_rc(int b, int& R, int& C) { const int st = b / 1024, sb = b % 1024, swz = sb ^ (((sb >> 9) & 1) << 5); R = (st >> 1) * 16 + swz / 64; C = (st & 1) * 32 + (swz % 64) / 2; }
__host__ __device__ __forceinline__ int perm32(int rho) { const int n = rho >> 4, i = rho & 15; return 8 * (i >> 2) + 4 * n + (i & 3); }
struct Unit { int pm, pn; };

__device__ __forceinline__ int xcd_remap(int L, int nwg) { const int q = nwg / NXCD, r = nwg % NXCD, xcd = L % NXCD, off = L / NXCD; return (xcd < r ? xcd * (q + 1) : r * (q + 1) + (xcd - r) * q) + off; }
struct DenseSched {
    const char* A; const char* Bt; int K, nM, nN, nwg, G, c;
    __device__ __forceinline__ void init(const bf16_t* A_, const bf16_t* Bt_, int Mr, int N, int K_, int G_, int c_) { A = (const char*)A_; Bt = (const char*)Bt_; K = K_; nM = Mr / BM; nN = N / BM; nwg = nM * nN; G = G_; c = c_; }
    __device__ __forceinline__ bool next(int i, Unit& u) const {
        const int L = i * G + c; if (L >= nwg) return false;
        const int wgid = xcd_remap(L, nwg);
        const int nig = WGM * nN, gid = wgid / nig, fm = gid * WGM, gsz = (nM - fm) < WGM ? (nM - fm) : WGM;
        u.pm = fm + ((wgid % nig) % gsz); u.pn = (wgid % nig) / gsz; return true;
    }
    __device__ __forceinline__ const char* a_base(const Unit& u) const { return A + (size_t)u.pm * ((size_t)BM * K * 2); }
    __device__ __forceinline__ const char* b_base(const Unit& u) const { return Bt + (size_t)u.pn * ((size_t)BM * K * 2); }
    __device__ __forceinline__ const char* b_base2(const Unit& u) const { return b_base(u); }
    __device__ __forceinline__ const unsigned* a_rowptr(const Unit&, int) const { return nullptr; }
};
__device__ __forceinline__ unsigned gld_untracked(const unsigned* p) { unsigned r; asm volatile("global_load_dword %0, %1, off" : "=&v"(r) : "v"(p) : "memory"); return r; }

template <class Epi, class Sched, bool GATHER, bool BSPLIT>
__device__ __forceinline__ void gemm_phase(LAS unsigned char* lds, const int K_, const Sched& S, const Epi& E) {
    int K = K_; asm volatile("" : "+s"(K));
    int tid_ = threadIdx.x; asm volatile("" : "+v"(tid_));
    const int tid = tid_, wid = __builtin_amdgcn_readfirstlane(tid >> 6), lane = tid & 63, wr = wid >> 2, wc = wid & 3, fr = lane & 15, fq = lane >> 4;
    const int nt = K / BK, nth = BSPLIT ? nt / 2 : nt, ldb = BSPLIT ? K / 2 : K;
    int Rr[2], Cc[2]; unsigned voffB[2];
#pragma unroll
    for (int i = 0; i < 2; ++i) { stage_rc(tid * 16 + i * 8192, Rr[i], Cc[i]); const int Rb = (Rr[i] & ~31) + perm32(Rr[i] & 31); voffB[i] = (unsigned)(Rb * ldb + Cc[i]) * 2u; }
    const size_t kstep = (size_t)(BK * 2);
    const size_t hstepB = (size_t)HALF * ldb * 2;
    const unsigned hstepA = (unsigned)HALF * (unsigned)K * 2u;
    const unsigned ldsw = (unsigned)wid * 1024u;
    const int aoff = lds_byte(wr * 64 + fr, fq * 8), boff = lds_byte(wc * 32 + fr, fq * 8);
#define PG8_SA(b, h) (((b) * 2 + (h)) * HTB)
#define PG8_SB(b, h) ((4 + (b) * 2 + (h)) * HTB)
#define PG8_STAGE(bufoff, gbase, o0, o1) do { \
        __builtin_amdgcn_global_load_lds((const unsigned*)((const char*)(gbase) + (o0)), (LAS unsigned*)(lds + (bufoff) + ldsw), 16, 0, 0); \
        __builtin_amdgcn_global_load_lds((const unsigned*)((const char*)(gbase) + (o1)), (LAS unsigned*)(lds + (bufoff) + ldsw + 8192), 16, 0, 0); } while (0)
#define PG8_STAGE_B(bufoff, gbase) PG8_STAGE(bufoff, gbase, voffB[0], voffB[1])
#define PG8_LDA(dst, b, h) do { _Pragma("unroll") for (int m = 0; m < 4; ++m) _Pragma("unroll") for (int k = 0; k < 2; ++k) dst[m][k] = *(const LAS bf16x8*)(lds + PG8_SA(b, h) + aoff + m * 2048 + k * 1024); } while (0)
#define PG8_LDB(dst, b, h) do { _Pragma("unroll") for (int n = 0; n < 2; ++n) _Pragma("unroll") for (int k = 0; k < 2; ++k) dst[n][k] = *(const LAS bf16x8*)(lds + PG8_SB(b, h) + boff + n * 2048 + k * 1024); } while (0)
#define PG8_MMA(ai, bj, At, Bt) do { __builtin_amdgcn_s_setprio(1); _Pragma("unroll") for (int m = 0; m < 4; ++m) _Pragma("unroll") for (int n = 0; n < 2; ++n) _Pragma("unroll") for (int k = 0; k < 2; ++k) \
        acc[ai][bj][m][n] = __builtin_amdgcn_mfma_f32_16x16x32_bf16(Bt[n][k], At[m][k], acc[ai][bj][m][n], 0, 0, 0); __builtin_amdgcn_s_setprio(0); } while (0)
#define PG8_WAIT_V(n) asm volatile("s_waitcnt vmcnt(" #n ")" ::: "memory")
#define PG8_WAIT_L(n) asm volatile("s_waitcnt lgkmcnt(" #n ")" ::: "memory")
#define PG8_BAR __builtin_amdgcn_s_barrier()
#define PG8_SCHED __builtin_amdgcn_sched_barrier(0)
    Unit cur, nxt; int ui = 0;
    if (!S.next(0, cur)) return;
    f32x4 acc[2][2][4][2];
#pragma unroll
    for (int a = 0; a < 2; ++a)
#pragma unroll
        for (int b = 0; b < 2; ++b)
#pragma unroll
            for (int m = 0; m < 4; ++m)
#pragma unroll
                for (int n = 0; n < 2; ++n) acc[a][b][m][n] = (f32x4){0.f, 0.f, 0.f, 0.f};
    bf16x8 At[4][2], B0[2][2], B1[2][2];
    unsigned oC[2][2], oN[2][2], rawN[2][2];
    if (GATHER) {
#pragma unroll
        for (int h = 0; h < 2; ++h)
#pragma unroll
            for (int i = 0; i < 2; ++i) rawN[h][i] = gld_untracked(S.a_rowptr(cur, Rr[i] + HALF * h));
        asm volatile("s_waitcnt vmcnt(0)" ::: "memory");
#pragma unroll
        for (int h = 0; h < 2; ++h)
#pragma unroll
            for (int i = 0; i < 2; ++i) { asm volatile("" : "+v"(rawN[h][i])); oC[h][i] = rawN[h][i] + (unsigned)Cc[i] * 2u; oN[h][i] = oC[h][i]; }
    } else {
#pragma unroll
        for (int h = 0; h < 2; ++h)
#pragma unroll
            for (int i = 0; i < 2; ++i) { oC[h][i] = (unsigned)(Rr[i] * K + Cc[i]) * 2u + (unsigned)h * hstepA; oN[h][i] = oC[h][i]; rawN[h][i] = 0u; }
    }
    const char* cA = S.a_base(cur); const char* cB = S.b_base(cur); const char* cB2 = S.b_base2(cur);
    PG8_STAGE_B(PG8_SB(0, 0), cB); PG8_STAGE_B(PG8_SB(0, 1), cB + hstepB); PG8_STAGE(PG8_SA(0, 0), cA, oC[0][0], oC[0][1]); PG8_STAGE(PG8_SA(0, 1), cA, oC[1][0], oC[1][1]);
    if (wr == 1) PG8_BAR;
    PG8_WAIT_V(2); PG8_BAR;
    PG8_STAGE_B(PG8_SB(1, 0), cB + kstep); PG8_STAGE(PG8_SA(1, 0), cA + kstep, oC[0][0], oC[0][1]); PG8_STAGE_B(PG8_SB(1, 1), cB + hstepB + kstep);
    PG8_WAIT_V(6); PG8_BAR;
    for (;;) {
        const bool has_next = S.next(ui + 1, nxt);
        const char* nA = has_next ? S.a_base(nxt) : cA; const char* nB = has_next ? S.b_base(nxt) : cB;
        if (GATHER) {
            if (has_next) {
#pragma unroll
                for (int h = 0; h < 2; ++h)
#pragma unroll
                    for (int i = 0; i < 2; ++i) rawN[h][i] = gld_untracked(S.a_rowptr(nxt, Rr[i] + HALF * h));
            }
        }
        for (int t = 0; t < nt; t += 2) {
            const bool last = (t == nt - 2);
            const char* a1 = cA + (size_t)(t + 1) * kstep;
            const char* a2 = last ? nA : cA + (size_t)(t + 2) * kstep;
            const char* b2 = last ? nB : ((BSPLIT && t + 2 >= nth) ? cB2 + (size_t)(t + 2 - nth) * kstep : cB + (size_t)(t + 2) * kstep);
            const char* a3 = a2 + kstep; const char* b3 = b2 + kstep;
            unsigned o2[2][2];
            if (GATHER && last && has_next) {
#pragma unroll
                for (int h = 0; h < 2; ++h)
#pragma unroll
                    for (int i = 0; i < 2; ++i) { asm volatile("" : "+v"(rawN[h][i])); oN[h][i] = rawN[h][i] + (unsigned)Cc[i] * 2u; }
            }
#pragma unroll
            for (int h = 0; h < 2; ++h)
#pragma unroll
                for (int i = 0; i < 2; ++i) o2[h][i] = (GATHER && last && has_next) ? oN[h][i] : oC[h][i];
            PG8_LDB(B0, 0, 0); PG8_LDB(B1, 0, 1); PG8_SCHED; PG8_LDA(At, 0, 0); PG8_STAGE(PG8_SA(1, 1), a1, oC[1][0], oC[1][1]);
            PG8_WAIT_V(8); PG8_WAIT_L(0); PG8_BAR; PG8_MMA(0, 0, At, B0); PG8_MMA(0, 1, At, B1); PG8_BAR; PG8_SCHED;
            PG8_LDA(At, 0, 1); PG8_STAGE_B(PG8_SB(0, 0), b2); PG8_STAGE_B(PG8_SB(0, 1), b2 + hstepB); PG8_STAGE(PG8_SA(0, 0), a2, o2[0][0], o2[0][1]);
            PG8_WAIT_V(8); PG8_WAIT_L(0); PG8_BAR; PG8_MMA(1, 0, At, B0); PG8_MMA(1, 1, At, B1); PG8_BAR; PG8_SCHED;
            PG8_LDB(B0, 1, 0); PG8_LDB(B1, 1, 1); PG8_SCHED; PG8_LDA(At, 1, 0); PG8_STAGE(PG8_SA(0, 1), a2, o2[1][0], o2[1][1]);
            PG8_WAIT_V(8); PG8_WAIT_L(0); PG8_BAR; PG8_MMA(0, 0, At, B0); PG8_MMA(0, 1, At, B1); PG8_BAR; PG8_SCHED;
            PG8_LDA(At, 1, 1); PG8_STAGE_B(PG8_SB(1, 0), b3); PG8_STAGE_B(PG8_SB(1, 1), b3 + hstepB); PG8_STAGE(PG8_SA(1, 0), a3, o2[0][0], o2[0][1]);
            PG8_WAIT_V(8); PG8_WAIT_L(0); PG8_BAR; PG8_MMA(1, 0, At, B0); PG8_MMA(1, 1, At, B1); PG8_BAR; PG8_SCHED;
        }
        if (wr == 0) PG8_BAR;
        E(acc, cur, wr, wc, fr, fq);
        if (!has_next) break;
#pragma unroll
        for (int a = 0; a < 2; ++a)
#pragma unroll
            for (int b = 0; b < 2; ++b)
#pragma unroll
                for (int m = 0; m < 4; ++m)
#pragma unroll
                    for (int n = 0; n < 2; ++n) acc[a][b][m][n] = (f32x4){0.f, 0.f, 0.f, 0.f};
        cur = nxt; cA = nA; cB = nB; cB2 = S.b_base2(cur); ++ui;
        if (GATHER) {
#pragma unroll
            for (int h = 0; h < 2; ++h)
#pragma unroll
                for (int i = 0; i < 2; ++i) oC[h][i] = oN[h][i];
        }
        if (wr == 1) PG8_BAR;
    }
    PG8_WAIT_V(0);
    PG8_BAR;
#undef PG8_SA
#undef PG8_SB
#undef PG8_STAGE
#undef PG8_STAGE_B
#undef PG8_LDA
#undef PG8_LDB
#undef PG8_MMA
#undef PG8_WAIT_V
#undef PG8_WAIT_L
#undef PG8_BAR
#undef PG8_SCHED
}
}

namespace att {
#define SBAR() __builtin_amdgcn_sched_barrier(0)
typedef LAS const char* lds_cptr;
__device__ __forceinline__ int crow(int r, int hi) { return (r & 3) + 8 * (r >> 2) + 4 * hi; }
__device__ __forceinline__ void glds16(const void* gsrc, unsigned lds_dst) { unsigned keep;
    asm volatile("s_mov_b32 %0, m0\n\ts_mov_b32 m0, %2\n\ts_nop 0\n\tglobal_load_lds_dwordx4 %1, off\n\ts_mov_b32 m0, %0" : "=&s"(keep) : "v"(gsrc), "s"(lds_dst) : "memory"); }
__device__ __forceinline__ float max3f(float a, float b, float c) { return __builtin_fmaxf(__builtin_fmaxf(a, b), c); }
__device__ __forceinline__ float rowmax(const f32x16& p0, const f32x16& p1) {
    float a = max3f(p0[0], p0[1], p1[0]), b = max3f(p0[2], p0[3], p1[1]); a = max3f(a, p1[2], p1[3]);
#pragma unroll
    for (int r = 4; r < 16; r += 4) { a = max3f(a, p0[r], p0[r + 1]); b = max3f(b, p0[r + 2], p0[r + 3]); a = max3f(a, p1[r], p1[r + 1]); b = max3f(b, p1[r + 2], p1[r + 3]); }
    const float m = __builtin_fmaxf(a, b);
    auto rr = __builtin_amdgcn_permlane32_swap(__float_as_uint(m), __float_as_uint(m), false, false);
    return __builtin_fmaxf(__uint_as_float(rr[0]), __uint_as_float(rr[1]));
}
template <int ND> __device__ __forceinline__ void qkt(f32x16& p0, f32x16& p1, lds_cptr Kslot, const bf16x8* qr, const f32x16& negm, int r32, int hi) {
    lds_cptr kb = Kslot + hi * 1024 + r32 * 16;
#pragma unroll
    for (int d0 = 0; d0 < ND; ++d0) {
        const bf16x8 b0 = *(const LAS bf16x8*)(kb + d0 * 2048);
        const bf16x8 b1 = *(const LAS bf16x8*)(kb + d0 * 2048 + 512);
        if (d0 == 0) { p0 = __builtin_amdgcn_mfma_f32_32x32x16_bf16(b0, qr[0], negm, 0, 0, 0); p1 = __builtin_amdgcn_mfma_f32_32x32x16_bf16(b1, qr[0], negm, 0, 0, 0); }
        else { p0 = __builtin_amdgcn_mfma_f32_32x32x16_bf16(b0, qr[d0], p0, 0, 0, 0); p1 = __builtin_amdgcn_mfma_f32_32x32x16_bf16(b1, qr[d0], p1, 0, 0, 0); }
    }
}
__device__ __forceinline__ void pv(f32x16* o, int vb, bf16x8 pa0, bf16x8 pa1, bf16x8 pa2, bf16x8 pa3) {
#pragma unroll
    for (int d0 = 0; d0 < 2; ++d0) { s16x4 lo[4], hi[4];
#pragma unroll
        for (int ks = 0; ks < 4; ++ks) {
            asm volatile("ds_read_b64_tr_b16 %0,%1 offset:%c2" : "=&v"(lo[ks]) : "v"(vb), "i"(d0 * 4096 + ks * 1024) : "memory");
            asm volatile("ds_read_b64_tr_b16 %0,%1 offset:%c2" : "=&v"(hi[ks]) : "v"(vb), "i"(d0 * 4096 + ks * 1024 + 512) : "memory"); }
        asm volatile("s_waitcnt lgkmcnt(0)" ::: "memory"); SBAR();
#define PK(k) (bf16x8){lo[k][0], lo[k][1], lo[k][2], lo[k][3], hi[k][0], hi[k][1], hi[k][2], hi[k][3]}
        o[d0] = __builtin_amdgcn_mfma_f32_32x32x16_bf16(pa0, PK(0), o[d0], 0, 0, 0);
        o[d0] = __builtin_amdgcn_mfma_f32_32x32x16_bf16(pa1, PK(1), o[d0], 0, 0, 0);
        o[d0] = __builtin_amdgcn_mfma_f32_32x32x16_bf16(pa2, PK(2), o[d0], 0, 0, 0);
        o[d0] = __builtin_amdgcn_mfma_f32_32x32x16_bf16(pa3, PK(3), o[d0], 0, 0, 0);
#undef PK
    }
}
constexpr float THR = 8.0f;
struct SoftState { float mhat, l; f32x16 negm; f32x16 o[2]; };
__device__ __forceinline__ void softmax_pv(SoftState& st, f32x16& p0, f32x16& p1, LAS float* wsf, int vb, int r32, int hi) {
    const float rm = rowmax(p0, p1);
    if (__any(rm > THR)) {
        const float dl = __builtin_fmaxf(rm, 0.f);
        st.mhat += dl;
#pragma unroll
        for (int r = 0; r < 16; ++r) { p0[r] -= dl; p1[r] -= dl; }
#pragma unroll
        for (int r = 0; r < 16; ++r) st.negm[r] = -st.mhat;
        const float f = fexp2(-dl); st.l *= f;
        if (hi == 0) wsf[r32] = f;
        LDS_WAIT();
#pragma unroll
        for (int r = 0; r < 16; ++r) { const float fr_ = wsf[crow(r, hi)]; st.o[0][r] *= fr_; st.o[1][r] *= fr_; }
        LDS_WAIT();
    }
    float sacc = 0.f;
#pragma unroll
    for (int r = 0; r < 16; ++r) { p0[r] = fexp2(p0[r]); p1[r] = fexp2(p1[r]); sacc += p0[r] + p1[r]; }
    st.l += sacc;
    u32x4 w0, w1, w2, w3;
    w0 = (u32x4){pk2(p0[0], p0[1]), pk2(p0[2], p0[3]), pk2(p0[4], p0[5]), pk2(p0[6], p0[7])};
    w1 = (u32x4){pk2(p0[8], p0[9]), pk2(p0[10], p0[11]), pk2(p0[12], p0[13]), pk2(p0[14], p0[15])};
    w2 = (u32x4){pk2(p1[0], p1[1]), pk2(p1[2], p1[3]), pk2(p1[4], p1[5]), pk2(p1[6], p1[7])};
    w3 = (u32x4){pk2(p1[8], p1[9]), pk2(p1[10], p1[11]), pk2(p1[12], p1[13]), pk2(p1[14], p1[15])};
    pv(st.o, vb, __builtin_bit_cast(bf16x8, w0), __builtin_bit_cast(bf16x8, w1), __builtin_bit_cast(bf16x8, w2), __builtin_bit_cast(bf16x8, w3));
}
__device__ __forceinline__ void finish_rows(SoftState& st, LAS float* wsf, LAS bf16_t* stg, int r32, int hi) {
    float l = st.l;
    { auto rr = __builtin_amdgcn_permlane32_swap(__float_as_uint(l), __float_as_uint(l), false, false); l = __uint_as_float(rr[0]) + __uint_as_float(rr[1]); }
    if (hi == 0) { wsf[32 + r32] = l; wsf[64 + r32] = st.mhat + __builtin_amdgcn_logf(l); }
    LDS_WAIT();
#pragma unroll
    for (int r = 0; r < 16; ++r) { const int orow = crow(r, hi); const float rl = frcp(wsf[32 + orow]);
#pragma unroll
        for (int d0 = 0; d0 < 2; ++d0) stg[orow * 64 + d0 * 32 + r32] = (bf16_t)(pk2(st.o[d0][r] * rl, 0.f) & 0xffffu); }
    LDS_WAIT();
}

constexpr int MK_SLOT = 12288, MV_SLOT = 8192, M_LK = 0, M_LV = 3 * MK_SLOT;
__device__ __forceinline__ void mla_unit(int b, int h, int qb, const bf16_t* QM, const bf16_t* KN, const bf16_t* KR, const bf16_t* VM, bf16_t* MIX, LAS char* shm) {
    int tid_ = threadIdx.x; asm volatile("" : "+v"(tid_)); const int tid = tid_, lane = tid & 63, r32 = lane & 31, hi = lane >> 5; const int wid = __builtin_amdgcn_readfirstlane(tid >> 6);
    const long rowbase = (long)b * SEQ; const int q0 = qb * 256;
    const unsigned lds0 = (unsigned)(uintptr_t)shm;
    LAS float* wsf = (LAS float*)(shm + ATT_WSF) + wid * 128;
    LAS bf16_t* stg = (LAS bf16_t*)(shm + ATT_OST) + wid * 2048;
    const bf16_t* ksrc0 = KN + (rowbase + lane) * 512 + h * 64 + wid * 8;
    const bf16_t* ksrc1 = KR + (rowbase + lane) * 32 + (wid & 3) * 8;
    const bf16_t* vsrc = VM + (rowbase + 16 * (wid & 3) + (lane >> 2)) * 512 + h * 64 + (wid >> 2) * 32 + (lane & 3) * 8;
    const unsigned kdst0 = lds0 + M_LK + wid * 1024, kdst1 = lds0 + M_LK + (8 + (wid & 3)) * 1024, vdst = lds0 + M_LV + wid * 1024;
#define MLA_DMA(t, s) do { glds16(ksrc0 + (long)(t) * 64 * 512, (unsigned)__builtin_amdgcn_readfirstlane(kdst0 + (s) * MK_SLOT)); \
        glds16(ksrc1 + (long)(t) * 64 * 32, (unsigned)__builtin_amdgcn_readfirstlane(kdst1 + (s) * MK_SLOT)); \
        glds16(vsrc + (long)(t) * 64 * 512, (unsigned)__builtin_amdgcn_readfirstlane(vdst + (s) * MV_SLOT)); } while (0)
    const int NT = (q0 + 256) / 64;
    MLA_DMA(0, 0); MLA_DMA(1, 1);
    const bf16_t* Qw = QM + (rowbase + q0 + wid * 32 + r32) * 768 + h * 96 + hi * 8;
    bf16x8 qr[6];
#pragma unroll
    for (int d0 = 0; d0 < 6; ++d0) qr[d0] = *(const bf16x8*)(Qw + d0 * 16);
    SoftState st; st.mhat = 0.f; st.l = 0.f; st.negm = f32x16{}; st.o[0] = f32x16{}; st.o[1] = f32x16{};
    const int qw0 = q0 + wid * 32, qrel = qw0 + r32;
    const int vb0 = (int)(lds0 + M_LV) + ((lane >> 4) & 1) * 32 + (lane & 3) * 8 + (4 * hi + ((lane & 15) >> 2)) * 64;
    int slot = 0;
    for (int t = 0; t < NT; ++t) {
        if (t + 1 < NT) asm volatile("s_waitcnt vmcnt(3) lgkmcnt(0)\n\ts_barrier" ::: "memory");
        else asm volatile("s_waitcnt vmcnt(0) lgkmcnt(0)\n\ts_barrier" ::: "memory");
        if (t + 2 < NT) { const int s2 = slot == 0 ? 2 : slot - 1; MLA_DMA(t + 2, s2); }
        if (64 * t <= qw0 + 31) {
            f32x16 p0, p1;
            qkt<6>(p0, p1, (lds_cptr)(shm + M_LK + slot * MK_SLOT), qr, st.negm, r32, hi);
            if (64 * t + 63 > qw0) {
                const int kb = 64 * t + 4 * hi;
#pragma unroll
                for (int r = 0; r < 16; ++r) { const int kv = kb + (r & 3) + 8 * (r >> 2); if (kv > qrel) p0[r] = -INFINITY; if (kv + 32 > qrel) p1[r] = -INFINITY; }
            }
            softmax_pv(st, p0, p1, wsf, vb0 + slot * MV_SLOT, r32, hi);
        }
        slot = slot == 2 ? 0 : slot + 1;
    }
    finish_rows(st, wsf, stg, r32, hi);
    bf16_t* Ow = MIX + (rowbase + q0 + wid * 32) * 1024 + 512 + h * 64;
#pragma unroll
    for (int i = 0; i < 4; ++i) { const int row = i * 8 + (lane >> 3), ch = lane & 7; const u32x4 v = *(const LAS u32x4*)(stg + row * 64 + ch * 8); *(u32x4*)(Ow + (long)row * 1024 + ch * 8) = v; }
    asm volatile("s_waitcnt lgkmcnt(0)\n\ts_barrier" ::: "memory");
#undef MLA_DMA
}

constexpr int D_LK = 0, D_LV = 49152;
__device__ __forceinline__ void dil_unit(int b, int h, int br, int uu, const bf16_t* QA, const bf16_t* KA, const bf16_t* VA, bf16_t* O2, bf16_t* O3, float* LSE2, float* LSE3, bf16_t* MIX,
                                         LAS char* shm, const LAS float* tbl) {
    int tid_ = threadIdx.x; asm volatile("" : "+v"(tid_)); const int tid = tid_, lane = tid & 63, r32 = lane & 31, hi = lane >> 5; const int wid = __builtin_amdgcn_readfirstlane(tid >> 6);
    const long rowbase = (long)b * SEQ;
    const unsigned lds0 = (unsigned)(uintptr_t)shm;
    LAS float* wsf = (LAS float*)(shm + ATT_WSF) + wid * 128;
    LAS bf16_t* stg = (LAS bf16_t*)(shm + ATT_OST) + wid * 2048;
    const int dsh = 2 * br, d = 1 << dsh;
    int res0, tb, nslot;
    if (br == 2) { res0 = 2 * uu; tb = 0; nslot = 4; }
    else { res0 = (br == 0) ? 0 : (uu >> 1); const int Q0 = (br == 0) ? 256 * uu : 256 * (uu & 1); tb = Q0 / 64 - 2; nslot = 6; }
    int wres, qs, j0, nj;
    if (br == 2) { wres = res0 + (wid >> 2); qs = 32 * (wid & 3); j0 = 2 * (wid >> 2); nj = (wid & 3) < 2 ? 1 : 2; }
    else { wres = res0; qs = (tb + 2) * 64 + 32 * wid; j0 = wid >> 1; nj = 3; }
    for (int j = 0; j < nslot; ++j) {
        const int tile = (br == 2) ? (j & 1) : tb + j; const int res = (br == 2) ? res0 + (j >> 1) : res0;
        if (tile < 0) continue;
        const long krow = rowbase + res + (long)d * (64 * tile + lane);
        const long vrow = rowbase + res + (long)d * (64 * tile + 16 * (wid & 3) + (lane >> 2));
        glds16(KA + krow * 512 + h * 64 + wid * 8, (unsigned)__builtin_amdgcn_readfirstlane(lds0 + D_LK + j * 8192 + wid * 1024));
        glds16(VA + vrow * 512 + h * 64 + (wid >> 2) * 32 + (lane & 3) * 8, (unsigned)__builtin_amdgcn_readfirstlane(lds0 + D_LV + j * 8192 + wid * 1024));
    }
    const bf16_t* Qw = QA + (rowbase + wres + (long)d * (qs + r32)) * 512 + h * 64 + hi * 8;
    bf16x8 qr[4];
#pragma unroll
    for (int d0 = 0; d0 < 4; ++d0) qr[d0] = *(const bf16x8*)(Qw + d0 * 16);
    asm volatile("s_waitcnt vmcnt(0) lgkmcnt(0)\n\ts_barrier" ::: "memory");
    SoftState st; st.mhat = 0.f; st.l = 0.f; st.negm = f32x16{}; st.o[0] = f32x16{}; st.o[1] = f32x16{};
    const int vb0 = (int)(lds0 + D_LV) + ((lane >> 4) & 1) * 32 + (lane & 3) * 8 + (4 * hi + ((lane & 15) >> 2)) * 64;
    const LAS float* tbr = tbl + br * 320;
    for (int jj = 0; jj < nj; ++jj) {
        const int j = j0 + jj; const int tile = (br == 2) ? jj : tb + j;
        if (tile < 0) continue;
        f32x16 p0, p1;
        qkt<4>(p0, p1, (lds_cptr)(shm + D_LK + j * 8192), qr, st.negm, r32, hi);
        const LAS float* tp = tbr + (qs + r32 - 64 * tile + 33 - 4 * hi);
#pragma unroll
        for (int r = 0; r < 16; ++r) { const int c0 = (r & 3) + 8 * (r >> 2); p0[r] += tp[63 - c0]; p1[r] += tp[31 - c0]; }
        softmax_pv(st, p0, p1, wsf, vb0 + j * 8192, r32, hi);
    }
    finish_rows(st, wsf, stg, r32, hi);
    const long trow0 = rowbase + wres + (long)d * qs;
    if (br != 0) {
        bf16_t* Ob = (br == 1) ? O2 : O3; float* Lb = (br == 1) ? LSE2 : LSE3;
#pragma unroll
        for (int i = 0; i < 4; ++i) { const int row = i * 8 + (lane >> 3), ch = lane & 7; const long tr = trow0 + (long)d * row;
            const u32x4 v = *(const LAS u32x4*)(stg + row * 64 + ch * 8); *(u32x4*)(Ob + tr * 512 + h * 64 + ch * 8) = v;
            if (ch == 0) Lb[tr * 8 + h] = wsf[64 + row]; }
    } else {
#pragma unroll
        for (int i = 0; i < 4; ++i) { const int row = i * 8 + (lane >> 3), ch = lane & 7; const long tr = trow0 + row;
            f32x4 a1, b1, a2, b2, a3, b3;
            { const u32x4 w = *(const LAS u32x4*)(stg + row * 64 + ch * 8); a1 = (f32x4){bflo(w.x), bfhi(w.x), bflo(w.y), bfhi(w.y)}; b1 = (f32x4){bflo(w.z), bfhi(w.z), bflo(w.w), bfhi(w.w)}; }
            ld8(O2 + tr * 512 + h * 64 + ch * 8, a2, b2); ld8(O3 + tr * 512 + h * 64 + ch * 8, a3, b3);
            const float l1 = wsf[64 + row], l2 = LSE2[tr * 8 + h], l3 = LSE3[tr * 8 + h];
            const float mx = max3f(l1, l2, l3); const float e1 = fexp2(l1 - mx), e2 = fexp2(l2 - mx), e3 = fexp2(l3 - mx); const float inv = frcp(e1 + e2 + e3);
            const float w1 = e1 * inv, w2 = e2 * inv, w3 = e3 * inv;
            st8(MIX + tr * 1024 + h * 64 + ch * 8, a1 * w1 + a2 * w2 + a3 * w3, b1 * w1 + b2 * w2 + b3 * w3); }
    }
    asm volatile("s_waitcnt lgkmcnt(0)\n\ts_barrier" ::: "memory");
}
#undef SBAR
}

#define XB_TMO      128
#define XB_XCNT(j)  (256  + 64 * (j))
#define XB_XSUB(j)  (1280 + 64 * (j))
#define XB_XGEN(j)  (2304 + 64 * (j))
#define XB_TOP      3328
#define XB_TOPGEN   3392
#define XCD_BAR_WORDS 3456
#define XB_SPIN_CAP (1u << 18)

__device__ __forceinline__ unsigned xb_ld(unsigned* p)              { return __hip_atomic_load(p, __ATOMIC_RELAXED, __HIP_MEMORY_SCOPE_AGENT); }
__device__ __forceinline__ unsigned xb_add(unsigned* p, unsigned v) { return __hip_atomic_fetch_add(p, v, __ATOMIC_RELAXED, __HIP_MEMORY_SCOPE_AGENT); }
__device__ __forceinline__ unsigned xb_xcc_id() { return (unsigned)__builtin_amdgcn_s_getreg((3 << 11) | 20) & 0xFu; }
#define XB_SPIN(cond, bar) do { unsigned _sp = 0; while (cond) { __builtin_amdgcn_s_sleep(1); \
    if ((++_sp & 255u) == 0u) { if (xb_ld(&(bar)[XB_TMO])) break; if (_sp > XB_SPIN_CAP) { atomicAdd(&(bar)[XB_TMO], 1u); break; } } } } while (0)

struct XcdBarrier {
    unsigned* bar; unsigned x;
    volatile LAS unsigned* st;
};

__device__ __forceinline__ XcdBarrier xcd_barrier_post(unsigned* bar, volatile LAS unsigned* st) {
    XcdBarrier b; b.bar = bar; b.x = xb_xcc_id(); b.st = st;
    if (threadIdx.x == 0) (void)xb_add(&bar[XB_XCNT(b.x)], 1u);
    return b;
}
__device__ __forceinline__ void xcd_barrier_complete(unsigned* bar, unsigned x, unsigned& nloc, unsigned& nx) {
    const unsigned G = gridDim.x * gridDim.y * gridDim.z;
    unsigned sum, cnt, mine, sp = 0u;
    for (;;) {
        sum = 0u; cnt = 0u; mine = 0u;
#pragma unroll
        for (unsigned j = 0; j < 16; ++j) { const unsigned c = xb_ld(&bar[XB_XCNT(j)]); sum += c; cnt += (c > 0u) ? 1u : 0u; mine = (j == x) ? c : mine; }
        if (sum == G) break;
        __builtin_amdgcn_s_sleep(1);
        if ((++sp & 255u) == 0u) { if (xb_ld(&bar[XB_TMO])) break; if (sp > XB_SPIN_CAP) { atomicAdd(&bar[XB_TMO], 1u); break; } }
    }
    nloc = mine > 0u ? mine : 1u; nx = cnt > 0u ? cnt : 1u;
}

__device__ __forceinline__ void xcd_barrier(const XcdBarrier& b) {
    asm volatile("s_waitcnt vmcnt(0)" ::: "memory");
    __syncthreads();
    if (threadIdx.x == 0) {
        unsigned* bar = b.bar;
        __builtin_amdgcn_s_waitcnt(0);
        unsigned nloc = b.st[0], nx = b.st[1];
        if (nloc == 0u) { xcd_barrier_complete(bar, b.x, nloc, nx); b.st[0] = nloc; b.st[1] = nx; }
        const unsigned old = xb_add(&bar[XB_XSUB(b.x)], 1u);
        const unsigned gen = old / nloc;
        if (old + 1u == (gen + 1u) * nloc) {
            __builtin_amdgcn_fence(__ATOMIC_RELEASE, "agent");
            asm volatile("s_waitcnt vmcnt(0)" ::: "memory");
            const unsigned og = xb_add(&bar[XB_TOP], 1u);
            const unsigned tg = og / nx;
            if (og + 1u == (tg + 1u) * nx) xb_add(&bar[XB_TOPGEN], 1u);
            else XB_SPIN(xb_ld(&bar[XB_TOPGEN]) == tg, bar);
            __builtin_amdgcn_fence(__ATOMIC_ACQUIRE, "agent");
            xb_add(&bar[XB_XGEN(b.x)], 1u);
            asm volatile("s_waitcnt vmcnt(0)" ::: "memory");
        } else {
            XB_SPIN(xb_ld(&bar[XB_XGEN(b.x)]) == gen, bar);
            __builtin_amdgcn_fence(__ATOMIC_ACQUIRE, "agent");
            asm volatile("s_waitcnt vmcnt(0)" ::: "memory");
        }
    }
    __syncthreads();
}

struct Frame {
    LAS unsigned char* lds; volatile LAS unsigned* MISC; unsigned* ctl; unsigned char* ws;
    int tid, lane, wave, vcu, G;
};
struct Args {
    const float* in[28]; float* out; unsigned char* ws;
};
enum { I_X = 0, I_P, I_RELB, I_NMG, I_WIN, I_QNA, I_KNA, I_QAG, I_WQUP, I_KVAG, I_WKVUP, I_QNN, I_QNR, I_KNN, I_KNR, I_WOUT, I_NFG, I_WRG, I_BRG, I_WRE, I_BRE, I_WEG, I_WEU, I_WED, I_WPP, I_PNG, I_WPG, I_BPG };

__device__ __forceinline__ float wave_sum(float v) {
#pragma unroll
    for (int o = 1; o < 64; o <<= 1) v += __shfl_xor(v, o);
    return v;
}

template <class RowMap>
__device__ __forceinline__ void tr_item(const float* __restrict__ W, int N, const float* __restrict__ kscale, bf16_t* WT, int ldt, RowMap map, LAS float* scr, int k0, int n0, int lane) {
#pragma unroll 8
    for (int i = 0; i < 32; ++i) { const int kk = 2 * i + (lane >> 5); float v = W[(size_t)(k0 + kk) * N + n0 + (lane & 31)]; if (kscale) v *= kscale[k0 + kk]; scr[kk * 33 + (lane & 31)] = v; }
    LDS_WAIT(); asm volatile("" ::: "memory");
    const int c = lane & 7;
#pragma unroll
    for (int j = 0; j < 4; ++j) { const int n = (lane >> 3) + 8 * j; const LAS float* s = scr + (8 * c) * 33 + n;
        u32x4 o; o.x = pk2(s[0 * 33], s[1 * 33]); o.y = pk2(s[2 * 33], s[3 * 33]); o.z = pk2(s[4 * 33], s[5 * 33]); o.w = pk2(s[6 * 33], s[7 * 33]);
        const int dr = map(n0 + n);
        if (dr >= 0) *(u32x4*)(WT + (size_t)dr * ldt + k0 + 8 * c) = o; }
    LDS_WAIT(); asm volatile("" ::: "memory");
}
struct MapId { int off; __device__ __forceinline__ int operator()(int n) const { return off + n; } };
__device__ __forceinline__ int slot_row(int s, int c64) { return 256 * (s >> 2) + 128 * (c64 >> 5) + 32 * (s & 3) + (c64 & 31); }
__device__ __forceinline__ int rope_j(int dim) { return 8 * ((dim & 15) >> 2) + 4 * (dim >> 4) + (dim & 3); }
struct MapWin { __device__ __forceinline__ int operator()(int L) const {
    if (L < 1024) return slot_row(L >> 6, L & 63);
    if (L < 1536) return L;
    if (L < 2176) return 1536 + slot_row((L - 1536) >> 6, (L - 1536) & 63);
    return 1536 + slot_row(10, rope_j(L - 2176));
} };
struct MapQup { __device__ __forceinline__ int operator()(int L) const { const int hd = L / 96, dd = L % 96;
    if (dd < 64) return slot_row(hd, dd);
    return 512 + slot_row(hd >> 1, 32 * (hd & 1) + rope_j(dd - 64));
} };
struct MapKVup { __device__ __forceinline__ int operator()(int L) const { const int hd = L >> 7, dd = L & 127;
    if (dd < 64) return slot_row(hd, dd);
    return 512 + hd * 64 + (dd - 64);
} };
struct MapGU { int up; __device__ __forceinline__ int operator()(int c) const { return (c >> 7) * 256 + up * 128 + (c & 127); } };

__device__ __forceinline__ int t5_bucket(int n) {
    if (n < 16) return n;
    int lg = 16 + (int)(__builtin_amdgcn_logf((float)n * 0.0625f) * (16.0f / 7.0f));
    return lg < 31 ? lg : 31;
}

__device__ __forceinline__ void p0_prologue(Frame& F, const Args& a) {
    LAS float* scr = (LAS float*)(F.lds + F.wave * 16384);
    const int gw = F.vcu * 8 + F.wave, NGW = F.G * 8, lane = F.lane;
    unsigned char* ws = F.ws;
    constexpr int I0 = 16 * 69, I1 = 6 * 24, I2 = 4 * 32, I3 = 16 * 32, I4 = 16, I5 = NEXP * 256, I6 = NEXP * 256, I7 = NEXP * 256, I8 = 4 * 32, I9 = 16 * 32;
    constexpr int NITEMS = I0 + I1 + I2 + I3 + I4 + I5 + I6 + I7 + I8 + I9;
    for (int it = gw; it < NITEMS; it += NGW) {
        int r = it;
        if (r < I0) { tr_item(a.in[I_WIN], INC, nullptr, (bf16_t*)(ws + WS_WIN), 1024, MapWin{}, scr, 64 * (r / 69), 32 * (r % 69), lane); continue; } r -= I0;
        if (r < I1) { tr_item(a.in[I_WQUP], 768, a.in[I_QAG], (bf16_t*)(ws + WS_WQUP), 384, MapQup{}, scr, 64 * (r / 24), 32 * (r % 24), lane); continue; } r -= I1;
        if (r < I2) { tr_item(a.in[I_WKVUP], 1024, a.in[I_KVAG], (bf16_t*)(ws + WS_WKVUP), 256, MapKVup{}, scr, 64 * (r / 32), 32 * (r % 32), lane); continue; } r -= I2;
        if (r < I3) { tr_item(a.in[I_WOUT], 1024, nullptr, (bf16_t*)(ws + WS_WOUT), 1024, MapId{0}, scr, 64 * (r / 32), 32 * (r % 32), lane); continue; } r -= I3;
        if (r < I4) { tr_item(a.in[I_WRE], 32, a.in[I_NFG], (bf16_t*)(ws + WS_WR), 1024, MapId{0}, scr, 64 * r, 0, lane); continue; } r -= I4;
        if (r < I5) { const int e = r >> 8, q = r & 255; tr_item(a.in[I_WEG] + (size_t)e * 1024 * 512, 512, a.in[I_NFG], (bf16_t*)(ws + WS_WGU) + (size_t)e * 1024 * 1024, 1024, MapGU{0}, scr, 64 * (q >> 4), 32 * (q & 15), lane); continue; } r -= I5;
        if (r < I6) { const int e = r >> 8, q = r & 255; tr_item(a.in[I_WEU] + (size_t)e * 1024 * 512, 512, a.in[I_NFG], (bf16_t*)(ws + WS_WGU) + (size_t)e * 1024 * 1024, 1024, MapGU{1}, scr, 64 * (q >> 4), 32 * (q & 15), lane); continue; } r -= I6;
        if (r < I7) { const int e = r >> 8, q = r & 255; tr_item(a.in[I_WED] + (size_t)e * 512 * 1024, 1024, nullptr, (bf16_t*)(ws + WS_WD) + (size_t)e * 1024 * 512, 512, MapId{0}, scr, 64 * (q >> 5), 32 * (q & 31), lane); continue; } r -= I7;
        if (r < I8) { tr_item(a.in[I_WPP], 1024, nullptr, (bf16_t*)(ws + WS_WPP), 256, MapId{0}, scr, 64 * (r / 32), 32 * (r % 32), lane); continue; } r -= I8;
        tr_item(a.in[I_WPG], 1024, nullptr, (bf16_t*)(ws + WS_WPG), 1024, MapId{0}, scr, 64 * (r / 32), 32 * (r % 32), lane);
    }
    const int gt = F.vcu * 512 + F.tid, NGT = F.G * 512;
    { bf16_t* WR = (bf16_t*)(ws + WS_WR); const float* wrg = a.in[I_WRG]; const float* nfg = a.in[I_NFG];
      for (int i = gt; i < 224 * 1024; i += NGT) { const int rr = 32 + (i >> 10), k = i & 1023; float v = 0.f; if (rr >= 128 && rr < 132) v = wrg[k * 4 + (rr - 128)] * nfg[k]; WR[(size_t)rr * 1024 + k] = (bf16_t)(pk2(v, 0.f) & 0xffffu); }
      bf16_t* WI = (bf16_t*)(ws + WS_WIN);
      for (int i = gt; i < 96 * 1024; i += NGT) { const int q = i >> 10, k = i & 1023; const int rr = (q < 32) ? 1536 + slot_row(10, 32 + q) : 1536 + slot_row(11, q - 32); WI[(size_t)rr * 1024 + k] = 0; } }
    { float* cs = (float*)(ws + WS_ROPE);
      for (int i = gt; i < 2048 * 16; i += NGT) { const int pos = i >> 4, k = i & 15; const float inv = __builtin_amdgcn_exp2f(-(float)k * (13.287712379549449f / 16.0f));
          const float ang = (float)pos * inv; double rv = (double)ang * 0.15915494309189535; rv -= __builtin_floor(rv); const float rf = (float)rv;
          cs[pos * 32 + k] = __builtin_amdgcn_cosf(rf); cs[pos * 32 + 16 + k] = __builtin_amdgcn_sinf(rf); }
      float* tb = (float*)(ws + WS_TBG); const float* relb = a.in[I_RELB];
      for (int i = gt; i < 3 * 8 * 320; i += NGT) { const int br = i / 2560, hh = (i / 320) & 7, idx = i % 320, delta = idx - 96;
          float v = -1e30f; if (delta >= 0 && delta <= 128) v = relb[t5_bucket(delta << (2 * br)) * 8 + hh] * LOG2E; tb[i] = v; }
      i32x4* rr4 = (i32x4*)(ws + WS_ROWREC); unsigned* ro = (unsigned*)(ws + WS_ROWOFF);
      for (int i = gt; i < MAXT * 256; i += NGT) { rr4[i] = (i32x4){-1, 0, 0, 0}; ro[i] = 0u; } }
    { const f32x4* p4 = (const f32x4*)a.in[I_P]; u32x4* pb = (u32x4*)(ws + WS_PB);
      for (int i = gt; i < M * PLE / 8; i += NGT) { const f32x4 u = p4[2 * i], v = p4[2 * i + 1]; u32x4 o; o.x = pk2(u[0], u[1]); o.y = pk2(u[2], u[3]); o.z = pk2(v[0], v[1]); o.w = pk2(v[2], v[3]); pb[i] = o; } }
    { const float* x = a.in[I_X]; const f32x4* g4 = (const f32x4*)a.in[I_NMG]; bf16_t* XN = (bf16_t*)(ws + WS_XN);
      f32x4 gv[4];
#pragma unroll
      for (int j = 0; j < 4; ++j) gv[j] = g4[lane + 64 * j];
      for (int m = gw; m < M; m += NGW) {
          const f32x4* xr = (const f32x4*)(x + (size_t)m * DM) + lane; f32x4 v[4]; float s = 0.f;
#pragma unroll
          for (int j = 0; j < 4; ++j) { v[j] = xr[64 * j]; s += dot4(v[j]); }
          const float rstd = rsq(wave_sum(s) * (1.f / DM) + EPS);
          u32x2* o8 = (u32x2*)(XN + (size_t)m * DM) + lane;
#pragma unroll
          for (int j = 0; j < 4; ++j) { const f32x4 y = v[j] * rstd * gv[j]; u32x2 o; o.x = pk2(y[0], y[1]); o.y = pk2(y[2], y[3]); o8[64 * j] = o; }
      } }
}

typedef f32x4 AccT[2][2][4][2];
#define EPI_ROWS for (int ai = 0; ai < 2; ++ai) _Pragma("unroll") for (int m = 0; m < 4; ({ if (m & 1) asm volatile("" ::: "memory"); }), ++m)
#define EPI_ROW(u) ((u).pm * 256 + ai * 128 + wr * 64 + m * 16 + fr)
#define EPI_FENCE() asm volatile("" ::: "memory")

struct EpiInProj {
    bf16_t *QA, *KA, *VA, *CQ, *CKV, *KR; float *ssq_cq, *ssq_ckv; const float *qn_gain, *kn_gain, *knr_gain, *rope_cs;
    __device__ __forceinline__ void operator()(const AccT& acc, const pg8::Unit& u, int wr, int wc, int fr, int fq) const {
        const int pn = u.pn;
        if (pn < 4) {
            const bool isq = pn < 2; const int head = (pn & 1) * 4 + wc; const float* gain = isq ? qn_gain : kn_gain; bf16_t* dst = isq ? QA : KA; const float sc = isq ? C2A : 1.0f;
            f32x4 g[2][2];
#pragma unroll
            for (int bj = 0; bj < 2; ++bj)
#pragma unroll
                for (int n = 0; n < 2; ++n) g[bj][n] = *(const f32x4*)(gain + 32 * bj + 8 * fq + 4 * n) * sc;
#pragma unroll
            EPI_ROWS { const size_t row = EPI_ROW(u);
                float ss = dot4(acc[ai][0][m][0]) + dot4(acc[ai][0][m][1]) + dot4(acc[ai][1][m][0]) + dot4(acc[ai][1][m][1]); ss = red_fq(ss);
                const float rn = rsq(ss * (1.f / 64.f) + EPS);
#pragma unroll
                for (int bj = 0; bj < 2; ++bj) st8(dst + row * 512 + head * 64 + 32 * bj + 8 * fq, acc[ai][bj][m][0] * rn * g[bj][0], acc[ai][bj][m][1] * rn * g[bj][1]); }
        } else if (pn < 6) {
#pragma unroll
            EPI_ROWS { const size_t row = EPI_ROW(u);
#pragma unroll
                for (int bj = 0; bj < 2; ++bj) st8(VA + row * 512 + (pn - 4) * 256 + 128 * bj + 32 * wc + 8 * fq, acc[ai][bj][m][0], acc[ai][bj][m][1]); }
        } else {
            const int s = 4 * (pn - 6) + wc;
            if (s < 10) {
                const bool iscq = s < 6; bf16_t* dst = iscq ? CQ : CKV; const int ld = iscq ? 384 : 256; const int col = iscq ? 64 * s : 64 * (s - 6);
                float* sq = iscq ? ssq_cq : ssq_ckv; const int sld = iscq ? 8 : 4, sidx = iscq ? s : s - 6;
#pragma unroll
                EPI_ROWS { const size_t row = EPI_ROW(u);
                    float ss = dot4(acc[ai][0][m][0]) + dot4(acc[ai][0][m][1]) + dot4(acc[ai][1][m][0]) + dot4(acc[ai][1][m][1]); ss = red_fq(ss);
                    if (fq == 0) sq[row * sld + sidx] = ss;
#pragma unroll
                    for (int bj = 0; bj < 2; ++bj) st8(dst + row * ld + col + 32 * bj + 8 * fq, acc[ai][bj][m][0], acc[ai][bj][m][1]); }
            } else if (s == 10) {
                const f32x4 g1 = *(const f32x4*)(knr_gain + 4 * fq), g2 = *(const f32x4*)(knr_gain + 16 + 4 * fq);
#pragma unroll
                EPI_ROWS { const size_t row = EPI_ROW(u);
                    f32x4 x1 = acc[ai][0][m][0], x2 = acc[ai][0][m][1];
                    float ss = red_fq(dot4(x1) + dot4(x2)); const float rn = rsq(ss * (1.f / 32.f) + EPS);
                    x1 = x1 * rn * g1; x2 = x2 * rn * g2;
                    const int pos = (int)(row & (SEQ - 1)); const f32x4 c = *(const f32x4*)(rope_cs + pos * 32 + 4 * fq), sn = *(const f32x4*)(rope_cs + pos * 32 + 16 + 4 * fq);
                    const f32x4 o1 = x1 * c - x2 * sn, o2 = x2 * c + x1 * sn;
                    u32x2 w1, w2; w1.x = pk2(o1[0], o1[1]); w1.y = pk2(o1[2], o1[3]); w2.x = pk2(o2[0], o2[1]); w2.y = pk2(o2[2], o2[3]);
                    *(u32x2*)(KR + row * 32 + 4 * fq) = w1; *(u32x2*)(KR + row * 32 + 16 + 4 * fq) = w2; }
            }
        }
    }
};
struct EpiRawSsq {
    bf16_t* O; int ld; float* ssq;
    __device__ __forceinline__ void operator()(const AccT& acc, const pg8::Unit& u, int wr, int wc, int fr, int fq) const {
#pragma unroll
        EPI_ROWS { const size_t row = EPI_ROW(u);
            float ss = dot4(acc[ai][0][m][0]) + dot4(acc[ai][0][m][1]) + dot4(acc[ai][1][m][0]) + dot4(acc[ai][1][m][1]); ss = red_fq(ss);
            if (fq == 0) ssq[row * 16 + 4 * u.pn + wc] = ss;
#pragma unroll
            for (int bj = 0; bj < 2; ++bj) st8(O + row * ld + 256 * u.pn + 128 * bj + 32 * wc + 8 * fq, acc[ai][bj][m][0], acc[ai][bj][m][1]); }
    }
};
struct EpiQup {
    bf16_t* QM; const float *ssq_cq, *nope_gain, *rope_gain, *rope_cs;
    __device__ __forceinline__ void operator()(const AccT& acc, const pg8::Unit& u, int wr, int wc, int fr, int fq) const {
        const int pn = u.pn;
        if (pn < 2) {
            const int head = 4 * pn + wc; f32x4 g[2][2];
#pragma unroll
            for (int bj = 0; bj < 2; ++bj)
#pragma unroll
                for (int n = 0; n < 2; ++n) g[bj][n] = *(const f32x4*)(nope_gain + 32 * bj + 8 * fq + 4 * n) * C2M;
#pragma unroll
            EPI_ROWS { const size_t row = EPI_ROW(u);
                const f32x4 s0 = *(const f32x4*)(ssq_cq + row * 8), s1 = *(const f32x4*)(ssq_cq + row * 8 + 4);
                const float rq = rsq(((s0[0] + s0[1]) + (s0[2] + s0[3]) + (s1[0] + s1[1])) * (1.f / 384.f) + EPS);
                f32x4 v[2][2]; float ss = 0.f;
#pragma unroll
                for (int bj = 0; bj < 2; ++bj)
#pragma unroll
                    for (int n = 0; n < 2; ++n) { v[bj][n] = acc[ai][bj][m][n] * rq; ss += dot4(v[bj][n]); }
                ss = red_fq(ss); const float rn = rsq(ss * (1.f / 64.f) + EPS);
#pragma unroll
                for (int bj = 0; bj < 2; ++bj) st8(QM + row * 768 + head * 96 + 32 * bj + 8 * fq, v[bj][0] * rn * g[bj][0], v[bj][1] * rn * g[bj][1]); }
        } else {
            const f32x4 g1 = *(const f32x4*)(rope_gain + 4 * fq) * C2M, g2 = *(const f32x4*)(rope_gain + 16 + 4 * fq) * C2M;
#pragma unroll
            EPI_ROWS { const size_t row = EPI_ROW(u);
                const f32x4 s0 = *(const f32x4*)(ssq_cq + row * 8), s1 = *(const f32x4*)(ssq_cq + row * 8 + 4);
                const float rq = rsq(((s0[0] + s0[1]) + (s0[2] + s0[3]) + (s1[0] + s1[1])) * (1.f / 384.f) + EPS);
                const int pos = (int)(row & (SEQ - 1)); const f32x4 c = *(const f32x4*)(rope_cs + pos * 32 + 4 * fq), sn = *(const f32x4*)(rope_cs + pos * 32 + 16 + 4 * fq);
#pragma unroll
                for (int bj = 0; bj < 2; ++bj) { const int head = 2 * wc + bj;
                    f32x4 x1 = acc[ai][bj][m][0] * rq, x2 = acc[ai][bj][m][1] * rq;
                    float ss = red_fq(dot4(x1) + dot4(x2)); const float rn = rsq(ss * (1.f / 32.f) + EPS);
                    x1 = x1 * rn * g1; x2 = x2 * rn * g2;
                    const f32x4 o1 = x1 * c - x2 * sn, o2 = x2 * c + x1 * sn;
                    u32x2 w1, w2; w1.x = pk2(o1[0], o1[1]); w1.y = pk2(o1[2], o1[3]); w2.x = pk2(o2[0], o2[1]); w2.y = pk2(o2[2], o2[3]);
                    *(u32x2*)(QM + row * 768 + head * 96 + 64 + 4 * fq) = w1; *(u32x2*)(QM + row * 768 + head * 96 + 80 + 4 * fq) = w2; } }
        }
    }
};
struct EpiKVup {
    bf16_t *KN, *VM; const float *ssq_ckv, *nope_gain;
    __device__ __forceinline__ void operator()(const AccT& acc, const pg8::Unit& u, int wr, int wc, int fr, int fq) const {
        const int pn = u.pn;
        if (pn < 2) {
            const int head = 4 * pn + wc; f32x4 g[2][2];
#pragma unroll
            for (int bj = 0; bj < 2; ++bj)
#pragma unroll
                for (int n = 0; n < 2; ++n) g[bj][n] = *(const f32x4*)(nope_gain + 32 * bj + 8 * fq + 4 * n);
#pragma unroll
            EPI_ROWS { const size_t row = EPI_ROW(u);
                const f32x4 s0 = *(const f32x4*)(ssq_ckv + row * 4);
                const float rk = rsq(((s0[0] + s0[1]) + (s0[2] + s0[3])) * (1.f / 256.f) + EPS);
                f32x4 v[2][2]; float ss = 0.f;
#pragma unroll
                for (int bj = 0; bj < 2; ++bj)
#pragma unroll
                    for (int n = 0; n < 2; ++n) { v[bj][n] = acc[ai][bj][m][n] * rk; ss += dot4(v[bj][n]); }
                ss = red_fq(ss); const float rn = rsq(ss * (1.f / 64.f) + EPS);
#pragma unroll
                for (int bj = 0; bj < 2; ++bj) st8(KN + row * 512 + head * 64 + 32 * bj + 8 * fq, v[bj][0] * rn * g[bj][0], v[bj][1] * rn * g[bj][1]); }
        } else {
#pragma unroll
            EPI_ROWS { const size_t row = EPI_ROW(u);
                const f32x4 s0 = *(const f32x4*)(ssq_ckv + row * 4);
                const float rk = rsq(((s0[0] + s0[1]) + (s0[2] + s0[3])) * (1.f / 256.f) + EPS);
#pragma unroll
                for (int bj = 0; bj < 2; ++bj) st8(VM + row * 512 + (pn - 2) * 256 + 128 * bj + 32 * wc + 8 * fq, acc[ai][bj][m][0] * rk, acc[ai][bj][m][1] * rk); }
        }
    }
};
struct EpiWout {
    const float* x; bf16_t* H1B; float* ssq;
    __device__ __forceinline__ void operator()(const AccT& acc, const pg8::Unit& u, int wr, int wc, int fr, int fq) const {
#pragma unroll
        EPI_ROWS { const size_t row = EPI_ROW(u); float ss = 0.f;
#pragma unroll
            for (int bj = 0; bj < 2; ++bj) { const size_t off = row * 1024 + 256 * u.pn + 128 * bj + 32 * wc + 8 * fq;
                const f32x4 h0 = acc[ai][bj][m][0] + *(const f32x4*)(x + off), h1 = acc[ai][bj][m][1] + *(const f32x4*)(x + off + 4);
                ss += dot4(h0) + dot4(h1); st8(H1B + off, h0, h1); }
            ss = red_fq(ss); if (fq == 0) ssq[row * 16 + 4 * u.pn + wc] = ss;
            }
    }
};
struct EpiRoute {
    const float *ssq_h1, *b_rg, *b_re; float* rstd2; i32x4* route; unsigned* cnt;
    __device__ __forceinline__ void operator()(const AccT& acc, const pg8::Unit& u, int wr, int wc, int fr, int fq) const {
        if (wc != 0) return;
        const f32x4 be0 = *(const f32x4*)(b_re + 8 * fq), be1 = *(const f32x4*)(b_re + 8 * fq + 4), bg = *(const f32x4*)b_rg;
#pragma unroll
        EPI_ROWS { const size_t row = EPI_ROW(u);
            float s = 0.f;
#pragma unroll
            for (int q = 0; q < 4; ++q) { const f32x4 t = *(const f32x4*)(ssq_h1 + row * 16 + 4 * q); s += (t[0] + t[1]) + (t[2] + t[3]); }
            const float r2 = rsq(s * (1.f / 1024.f) + EPS);
            if (fq == 0) rstd2[row] = r2;
            const f32x4 e0 = acc[ai][0][m][0] * r2 + be0, e1 = acc[ai][0][m][1] * r2 + be1;
            const f32x4 gloc = acc[ai][1][m][0] * r2 + bg;
            float gl[4];
#pragma unroll
            for (int j = 0; j < 4; ++j) gl[j] = __shfl(gloc[j], fr);
            int gi = 0; float gm = gl[0];
#pragma unroll
            for (int j = 1; j < 4; ++j) if (gl[j] > gm) { gm = gl[j]; gi = j; }
            float den = 0.f;
#pragma unroll
            for (int j = 0; j < 4; ++j) den += __expf(gl[j] - gm);
            const float gate = 1.0f / den;
            if (fq == gi) {
                float el[8] = {e0[0], e0[1], e0[2], e0[3], e1[0], e1[1], e1[2], e1[3]};
                int i1 = 0; float l1 = el[0];
#pragma unroll
                for (int j = 1; j < 8; ++j) if (el[j] > l1) { l1 = el[j]; i1 = j; }
                int i2 = -1; float l2 = -INFINITY;
#pragma unroll
                for (int j = 0; j < 8; ++j) if (j != i1 && el[j] > l2) { l2 = el[j]; i2 = j; }
                const float w1 = gate / (1.0f + __expf(l2 - l1)), w2 = gate - w1;
                const int ea = i1 < i2 ? i1 : i2, eb = i1 < i2 ? i2 : i1; const float wa = i1 < i2 ? w1 : w2, wb = i1 < i2 ? w2 : w1;
                const int pair = gi * 28 + (ea * (15 - ea)) / 2 + (eb - ea - 1);
                const unsigned pos = __hip_atomic_fetch_add(cnt + 16 * pair, 1u, RLX_AGENT);
                route[row] = (i32x4){pair, (int)pos, (int)__float_as_uint(wa), (int)__float_as_uint(wb)};
            }
            }
    }
};
struct EpiGateUp {
    const i32x4* rowrec; bf16_t* HDN;
    __device__ __forceinline__ void operator()(const AccT& acc, const pg8::Unit& u, int wr, int wc, int fr, int fq) const {
        const int slot = u.pn >> 2, cc = u.pn & 3;
#pragma unroll
        for (int ai = 0; ai < 2; ++ai) {
            i32x4 rec[4];
#pragma unroll
            for (int m = 0; m < 4; ++m) rec[m] = rowrec[EPI_ROW(u)];
#pragma unroll
            for (int m = 0; m < 4; ++m) { const size_t rr = EPI_ROW(u);
                const float r2 = __uint_as_float((unsigned)rec[m].y), w = __uint_as_float((unsigned)(slot ? rec[m].w : rec[m].z));
                f32x4 hd[2];
#pragma unroll
                for (int n = 0; n < 2; ++n)
#pragma unroll
                    for (int e = 0; e < 4; ++e) { const float g = acc[ai][0][m][n][e] * r2, up = acc[ai][1][m][n][e] * r2; hd[n][e] = g * frcp(1.0f + fexp2(-g * LOG2E)) * up * w; }
                st8(HDN + rr * 1024 + slot * 512 + cc * 128 + 32 * wc + 8 * fq, hd[0], hd[1]); }
            EPI_FENCE();
        }
    }
};
struct EpiDown {
    const i32x4* rowrec; const bf16_t* H1B; bf16_t* H2B;
    __device__ __forceinline__ void operator()(const AccT& acc, const pg8::Unit& u, int wr, int wc, int fr, int fq) const {
        int tk[2][4];
#pragma unroll
        for (int ai = 0; ai < 2; ++ai)
#pragma unroll
            for (int m = 0; m < 4; ++m) tk[ai][m] = ((const int*)rowrec)[(size_t)EPI_ROW(u) * 4];
#pragma unroll
        EPI_ROWS { const int tok = tk[ai][m];
            if (tok >= 0) {
#pragma unroll
                for (int bj = 0; bj < 2; ++bj) { const size_t off = (size_t)tok * 1024 + 256 * u.pn + 128 * bj + 32 * wc + 8 * fq; f32x4 a, b; ld8(H1B + off, a, b);
                    st8(H2B + off, a + acc[ai][bj][m][0], b + acc[ai][bj][m][1]); } }
            }
    }
};
struct EpiFinal {
    const bf16_t *H2B, *E; const float *ssq_e, *b_pg, *gain; float* out;
    __device__ __forceinline__ void operator()(const AccT& acc, const pg8::Unit& u, int wr, int wc, int fr, int fq) const {
#pragma unroll
        EPI_ROWS { const size_t row = EPI_ROW(u);
            float s = 0.f;
#pragma unroll
            for (int q = 0; q < 4; ++q) { const f32x4 t = *(const f32x4*)(ssq_e + row * 16 + 4 * q); s += (t[0] + t[1]) + (t[2] + t[3]); }
            const float re = rsq(s * (1.f / 1024.f) + EPS);
#pragma unroll
            for (int bj = 0; bj < 2; ++bj) { const int col = 256 * u.pn + 128 * bj + 32 * wc + 8 * fq; const size_t off = row * 1024 + col;
                f32x4 h0, h1, e0, e1; ld8(H2B + off, h0, h1); ld8(E + off, e0, e1);
                const f32x4 z0 = acc[ai][bj][m][0] + *(const f32x4*)(b_pg + col), z1 = acc[ai][bj][m][1] + *(const f32x4*)(b_pg + col + 4);
                const f32x4 g0 = *(const f32x4*)(gain + col) * re, g1 = *(const f32x4*)(gain + col + 4) * re;
                f32x4 o0, o1;
#pragma unroll
                for (int e = 0; e < 4; ++e) { o0[e] = h0[e] + frcp(1.0f + fexp2(-z0[e] * LOG2E)) * e0[e] * g0[e]; o1[e] = h1[e] + frcp(1.0f + fexp2(-z1[e] * LOG2E)) * e1[e] * g1[e]; }
                *(f32x4*)(out + off) = o0; *(f32x4*)(out + off + 4) = o1; }
            }
    }
};

struct MoeSchedUp {
    const LAS int* tinfo; int T, G, c; const char* A; const char* W; const unsigned* rowoff;
    __device__ __forceinline__ bool next(int i, pg8::Unit& u) const { const int nun = T * 8, L = i * G + c; if (L >= nun) return false; const int w = pg8::xcd_remap(L, nun); u.pm = w >> 3; u.pn = w & 7; return true; }
    __device__ __forceinline__ const char* a_base(const pg8::Unit&) const { return A; }
    __device__ __forceinline__ const char* b_base(const pg8::Unit& u) const { const int ti = tinfo[u.pm]; const int e = (u.pn < 4) ? (ti >> 8) : (ti & 255); return W + (size_t)e * (1024 * 1024 * 2) + (size_t)(u.pn & 3) * (256 * 1024 * 2); }
    __device__ __forceinline__ const char* b_base2(const pg8::Unit& u) const { return b_base(u); }
    __device__ __forceinline__ const unsigned* a_rowptr(const pg8::Unit& u, int r) const { return rowoff + u.pm * 256 + r; }
};
struct MoeSchedDown {
    const LAS int* tinfo; int T, G, c; const char* A; const char* W;
    __device__ __forceinline__ bool next(int i, pg8::Unit& u) const { const int nun = T * 4, L = i * G + c; if (L >= nun) return false; const int w = pg8::xcd_remap(L, nun); u.pm = w >> 2; u.pn = w & 3; return true; }
    __device__ __forceinline__ const char* a_base(const pg8::Unit& u) const { return A + (size_t)u.pm * (256 * 1024 * 2); }
    __device__ __forceinline__ const char* b_base(const pg8::Unit& u) const { const int e = tinfo[u.pm] >> 8; return W + (size_t)e * (1024 * 512 * 2) + (size_t)u.pn * (256 * 512 * 2); }
    __device__ __forceinline__ const char* b_base2(const pg8::Unit& u) const { const int e = tinfo[u.pm] & 255; return W + (size_t)e * (1024 * 512 * 2) + (size_t)u.pn * (256 * 512 * 2); }
    __device__ __forceinline__ const unsigned* a_rowptr(const pg8::Unit&, int) const { return nullptr; }
};

#ifndef MK_LAST_PHASE
#define MK_LAST_PHASE 9
#endif
__global__ void __launch_bounds__(512, 2) hybrid_fwd(Args args) {
    extern __shared__ __attribute__((aligned(16))) unsigned char lds_raw[];
    Frame F;
    F.lds = (LAS unsigned char*)lds_raw;
    F.MISC = (volatile LAS unsigned*)(F.lds + MISC_OFF);
    F.tid = threadIdx.x; F.lane = F.tid & 63; F.wave = __builtin_amdgcn_readfirstlane(F.tid >> 6);
    F.G = gridDim.x; { const int bx = blockIdx.x; F.vcu = (F.G % 8 == 0) ? (bx % 8) * (F.G / 8) + bx / 8 : bx; }
    F.ws = args.ws; F.ctl = (unsigned*)(args.ws + WS_CTL);
    unsigned char* ws = args.ws;
    for (int u = F.tid; u < 128; u += 512) ((LAS unsigned*)(F.lds + MISC_OFF))[u] = 0u;
    __syncthreads();
    XcdBarrier bar = xcd_barrier_post(F.ctl + CW_BAR, F.MISC + 8);
    const int blk = (int)blockIdx.x;
    LAS unsigned char* ring = F.lds;

    p0_prologue(F, args);
    xcd_barrier(bar);
#if MK_LAST_PHASE >= 1
    {
        pg8::DenseSched S; S.init((const bf16_t*)(ws + WS_XN), (const bf16_t*)(ws + WS_WIN), M, INC_PAD, 1024, F.G, blk);
        EpiInProj E{(bf16_t*)(ws + WS_QA), (bf16_t*)(ws + WS_KA), (bf16_t*)(ws + WS_VA), (bf16_t*)(ws + WS_CQ), (bf16_t*)(ws + WS_CKV), (bf16_t*)(ws + WS_KROPE),
                    (float*)(ws + WS_SSQCQ), (float*)(ws + WS_SSQCKV), args.in[I_QNA], args.in[I_KNA], args.in[I_KNR], (const float*)(ws + WS_ROPE)};
        pg8::gemm_phase<EpiInProj, pg8::DenseSched, false, false>(ring, 1024, S, E);
    }
    {
        pg8::DenseSched S; S.init((const bf16_t*)(ws + WS_PB), (const bf16_t*)(ws + WS_WPP), M, 1024, 256, F.G, blk);
        EpiRawSsq E{(bf16_t*)(ws + WS_E), 1024, (float*)(ws + WS_SSQE)};
        pg8::gemm_phase<EpiRawSsq, pg8::DenseSched, false, false>(ring, 256, S, E);
    }
    xcd_barrier(bar);
#endif
#if MK_LAST_PHASE >= 2
    {
        pg8::DenseSched S; S.init((const bf16_t*)(ws + WS_CQ), (const bf16_t*)(ws + WS_WQUP), M, 768, 384, F.G, blk);
        EpiQup E{(bf16_t*)(ws + WS_QM), (const float*)(ws + WS_SSQCQ), args.in[I_QNN], args.in[I_QNR], (const float*)(ws + WS_ROPE)};
        pg8::gemm_phase<EpiQup, pg8::DenseSched, false, false>(ring, 384, S, E);
    }
    {
        pg8::DenseSched S; S.init((const bf16_t*)(ws + WS_CKV), (const bf16_t*)(ws + WS_WKVUP), M, 1024, 256, F.G, blk);
        EpiKVup E{(bf16_t*)(ws + WS_KN), (bf16_t*)(ws + WS_VM), (const float*)(ws + WS_SSQCKV), args.in[I_KNN]};
        pg8::gemm_phase<EpiKVup, pg8::DenseSched, false, false>(ring, 256, S, E);
    }
    xcd_barrier(bar);
#endif
#if MK_LAST_PHASE >= 3
    {
        LAS char* shm = (LAS char*)F.lds;
        LAS float* tbl = (LAS float*)(F.lds + TB_OFF);
        for (int bh = F.vcu; bh < BATCH * 8; bh += F.G) {
            const int b = bh >> 3, h = bh & 7;
            for (int i = F.tid; i < 960; i += 512) tbl[i] = ((const float*)(ws + WS_TBG))[(i / 320) * 2560 + h * 320 + (i % 320)];
            __syncthreads();
            for (int qb = 0; qb < 8; ++qb)
                att::mla_unit(b, h, qb, (const bf16_t*)(ws + WS_QM), (const bf16_t*)(ws + WS_KN), (const bf16_t*)(ws + WS_KROPE), (const bf16_t*)(ws + WS_VM), (bf16_t*)(ws + WS_MIX), shm);
            for (int uidx = 0; uidx < 24; ++uidx) {
                const int br = 2 - (uidx >> 3), uu = uidx & 7;
                if (uidx == 16) { VM_WAIT(); __syncthreads(); __builtin_amdgcn_fence(__ATOMIC_ACQUIRE, "agent"); VM_WAIT(); __syncthreads(); }
                att::dil_unit(b, h, br, uu, (const bf16_t*)(ws + WS_QA), (const bf16_t*)(ws + WS_KA), (const bf16_t*)(ws + WS_VA), (bf16_t*)(ws + WS_O2), (bf16_t*)(ws + WS_O3),
                              (float*)(ws + WS_LSE2), (float*)(ws + WS_LSE3), (bf16_t*)(ws + WS_MIX), shm, tbl);
            }
            __syncthreads();
        }
    }
    xcd_barrier(bar);
#endif
#if MK_LAST_PHASE >= 4
    {
        pg8::DenseSched S; S.init((const bf16_t*)(ws + WS_MIX), (const bf16_t*)(ws + WS_WOUT), M, 1024, 1024, F.G, blk);
        EpiWout E{args.in[I_X], (bf16_t*)(ws + WS_H1B), (float*)(ws + WS_SSQH1)};
        pg8::gemm_phase<EpiWout, pg8::DenseSched, false, false>(ring, 1024, S, E);
    }
    xcd_barrier(bar);
#endif
#if MK_LAST_PHASE >= 5
    {
        pg8::DenseSched S; S.init((const bf16_t*)(ws + WS_H1B), (const bf16_t*)(ws + WS_WR), M, 256, 1024, F.G, blk);
        EpiRoute E{(const float*)(ws + WS_SSQH1), args.in[I_BRG], args.in[I_BRE], (float*)(ws + WS_RSTD2), (i32x4*)(ws + WS_ROUTE), F.ctl + CW_CNT};
        pg8::gemm_phase<EpiRoute, pg8::DenseSched, false, false>(ring, 1024, S, E);
    }
    xcd_barrier(bar);
    LAS int* mo_cnt = (LAS int*)(F.lds + MOE_OFF); LAS int* mo_start = mo_cnt + 128; LAS int* tinfo = mo_cnt + 256;
    {
        if (F.tid < NPAIR) mo_cnt[F.tid] = (int)__hip_atomic_load(F.ctl + CW_CNT + 16 * F.tid, RLX_AGENT);
        __syncthreads();
        if (F.tid == 0) { int acc = 0; for (int p = 0; p < NPAIR; ++p) { mo_start[p] = acc; acc += (mo_cnt[p] + 255) >> 8; } mo_start[NPAIR] = acc; }
        __syncthreads();
        if (F.tid < NPAIR) { const int p = F.tid, g = p / 28, q = p % 28; int ea = 0; while (ea < 6 && ((ea + 1) * (14 - ea)) / 2 <= q) ++ea; const int eb = ea + 1 + (q - (ea * (15 - ea)) / 2);
            const int info = ((8 * g + ea) << 8) | (8 * g + eb); const int t0 = mo_start[p], t1 = mo_start[p + 1]; for (int t = t0; t < t1; ++t) tinfo[t] = info; }
        __syncthreads();
        const i32x4* route = (const i32x4*)(ws + WS_ROUTE); i32x4* rowrec = (i32x4*)(ws + WS_ROWREC); unsigned* rowoff = (unsigned*)(ws + WS_ROWOFF); const float* rstd2 = (const float*)(ws + WS_RSTD2);
        for (int tok = F.vcu * 512 + F.tid; tok < M; tok += F.G * 512) { const i32x4 r = route[tok]; const int row = (mo_start[r.x] << 8) + r.y;
            rowrec[row] = (i32x4){tok, (int)__float_as_uint(rstd2[tok]), r.z, r.w}; rowoff[row] = (unsigned)tok * 2048u; }
    }
    xcd_barrier(bar);
#endif
#if MK_LAST_PHASE >= 7
    const int T = mo_start[NPAIR];
    {
        MoeSchedUp S{tinfo, T, F.G, blk, (const char*)(ws + WS_H1B), (const char*)(ws + WS_WGU), (const unsigned*)(ws + WS_ROWOFF)};
        EpiGateUp E{(const i32x4*)(ws + WS_ROWREC), (bf16_t*)(ws + WS_HDN)};
        pg8::gemm_phase<EpiGateUp, MoeSchedUp, true, false>(ring, 1024, S, E);
    }
    xcd_barrier(bar);
#endif
#if MK_LAST_PHASE >= 8
    {
        MoeSchedDown S{tinfo, T, F.G, blk, (const char*)(ws + WS_HDN), (const char*)(ws + WS_WD)};
        EpiDown E{(const i32x4*)(ws + WS_ROWREC), (const bf16_t*)(ws + WS_H1B), (bf16_t*)(ws + WS_H2B)};
        pg8::gemm_phase<EpiDown, MoeSchedDown, false, true>(ring, 1024, S, E);
    }
    xcd_barrier(bar);
#endif
#if MK_LAST_PHASE >= 9
    {
        pg8::DenseSched S; S.init((const bf16_t*)(ws + WS_H2B), (const bf16_t*)(ws + WS_WPG), M, 1024, 1024, F.G, blk);
        EpiFinal E{(const bf16_t*)(ws + WS_H2B), (const bf16_t*)(ws + WS_E), (const float*)(ws + WS_SSQE), args.in[I_BPG], args.in[I_PNG], args.out};
        pg8::gemm_phase<EpiFinal, pg8::DenseSched, false, false>(ring, 1024, S, E);
    }
#else
    { const f32x4* x4 = (const f32x4*)args.in[I_X]; f32x4* o4 = (f32x4*)args.out; for (int i = F.vcu * 512 + F.tid; i < M * DM / 4; i += F.G * 512) o4[i] = x4[i]; }
#endif
}

extern "C" void kernel_launch(void* const* d_in, const int* in_sizes, int n_in, void* d_out, int out_size, void* d_ws, size_t ws_size, hipStream_t stream) {
    static int grid = 0;
    if (grid == 0) {
        if (n_in != 28 || in_sizes[0] != M * DM || out_size != M * DM || ws_size < WS_END) { fprintf(stderr, "kernel_launch: unexpected problem (n_in %d, in0 %d, out %d, ws %zu); nothing launched\n", n_in, n_in > 0 ? in_sizes[0] : -1, out_size, ws_size); grid = -1; return; }
        int dev = 0, cus = 0, per_cu = 0;
        if (hipGetDevice(&dev) != hipSuccess || hipDeviceGetAttribute(&cus, hipDeviceAttributeMultiprocessorCount, dev) != hipSuccess) { grid = -1; return; }
        if (hipFuncSetAttribute((const void*)hybrid_fwd, hipFuncAttributeMaxDynamicSharedMemorySize, LDS_BYTES) != hipSuccess) { fprintf(stderr, "kernel_launch: hipFuncSetAttribute failed\n"); grid = -1; return; }
        if (hipOccupancyMaxActiveBlocksPerMultiprocessor(&per_cu, (const void*)hybrid_fwd, 512, LDS_BYTES) != hipSuccess || per_cu < 1) { fprintf(stderr, "kernel_launch: occupancy query reports %d workgroups per CU\n", per_cu); }
        (void)hipGetLastError();
        grid = cus;
    }
    if (grid < 0) return;
    if (hipMemsetAsync((char*)d_ws + WS_CTL, 0, CTL_ZERO_BYTES, stream) != hipSuccess) return;
    Args a{};
    for (int i = 0; i < 28; ++i) a.in[i] = (const float*)d_in[i];
    a.out = (float*)d_out; a.ws = (unsigned char*)d_ws;
    hipLaunchKernelGGL(hybrid_fwd, dim3(grid), dim3(512), LDS_BYTES, stream, a);
}
```

```cpp
#define MK_REPEAT 0
#include <hip/hip_runtime.h>
#include <cstdio>
#include <cstdint>

#define LAS __attribute__((address_space(3)))
#define GAS __attribute__((address_space(1)))
typedef unsigned short bf16_t;
typedef short bf16x8 __attribute__((ext_vector_type(8)));
typedef short s16x4 __attribute__((ext_vector_type(4)));
typedef short v4i16_t __attribute__((ext_vector_type(4)));
typedef float f32x4 __attribute__((ext_vector_type(4)));
typedef float f32x2 __attribute__((ext_vector_type(2)));
typedef float f32x16 __attribute__((ext_vector_type(16)));
typedef unsigned u32x4 __attribute__((ext_vector_type(4)));
typedef unsigned u32x2 __attribute__((ext_vector_type(2)));
typedef int i32x4 __attribute__((ext_vector_type(4)));
typedef __bf16 bf16x2_t __attribute__((ext_vector_type(2)));

constexpr int BATCH = 32, SEQ = 2048, DM = 1024, M = BATCH * SEQ;
constexpr int PLE = 256;
constexpr int AW = 512, QLORA = 384, KVLORA = 256, ROPE = 32;
constexpr int INC = 2208, INC_PAD = 2304;
constexpr int NEXP = 32, EFF = 512, NPAIR = 112;
constexpr int MAXT = 368;
constexpr float EPS = 1e-6f;
constexpr float LOG2E = 1.4426950408889634f;
constexpr float C2A = 0.125f * LOG2E;
constexpr float C2M = 0.10206207261596575f * LOG2E;

constexpr size_t MiB = 1u << 20;
constexpr size_t WS_CTL = 0, CTL_ZERO_BYTES = 1 * MiB;
constexpr size_t WS_TBG = 1 * MiB;
constexpr size_t WS_ROPE = 1 * MiB + 65536;
constexpr size_t WS_ROWREC = 2 * MiB;
constexpr size_t WS_ROWOFF = 3 * MiB + 524288;
constexpr size_t WS_ROUTE = 4 * MiB;
constexpr size_t WS_RSTD2 = 5 * MiB;
constexpr size_t WS_SSQCQ = 6 * MiB;
constexpr size_t WS_SSQCKV = 8 * MiB;
constexpr size_t WS_SSQH1 = 9 * MiB;
constexpr size_t WS_SSQE = 13 * MiB;
constexpr size_t WS_LSE2 = 17 * MiB;
constexpr size_t WS_LSE3 = 19 * MiB;
constexpr size_t WS_KROPE = 21 * MiB;
constexpr size_t WS_WIN = 25 * MiB;
constexpr size_t WS_WQUP = 30 * MiB;
constexpr size_t WS_WKVUP = 31 * MiB;
constexpr size_t WS_WR = 32 * MiB;
constexpr size_t WS_WOUT = 33 * MiB;
constexpr size_t WS_WPP = 35 * MiB;
constexpr size_t WS_WPG = 36 * MiB;
constexpr size_t WS_WGU = 40 * MiB;
constexpr size_t WS_WD = 104 * MiB;
constexpr size_t WS_XN = 136 * MiB;
constexpr size_t WS_MIX = WS_XN;
constexpr size_t WS_QA = 264 * MiB, WS_KA = 328 * MiB, WS_VA = 392 * MiB;
constexpr size_t WS_HDN = 264 * MiB;
constexpr size_t WS_QM = 456 * MiB;
constexpr size_t WS_KN = 552 * MiB, WS_VM = 616 * MiB;
constexpr size_t WS_H2B = 456 * MiB;
constexpr size_t WS_PB = 680 * MiB;
constexpr size_t WS_CQ = 712 * MiB;
constexpr size_t WS_CKV = 760 * MiB;
constexpr size_t WS_O2 = 680 * MiB, WS_O3 = 744 * MiB;
constexpr size_t WS_H1B = 680 * MiB;
constexpr size_t WS_E = 808 * MiB;
constexpr size_t WS_END = 936 * MiB;
constexpr int CW_BAR = 4096;
constexpr int CW_CNT = 16384;

constexpr int RING_BYTES = 131072;
constexpr int ATT_WSF = 98304;
constexpr int ATT_OST = 102400;
constexpr int MISC_OFF = 135168;
constexpr int TB_OFF = MISC_OFF + 512;
constexpr int MOE_OFF = TB_OFF + 3840;
constexpr int LDS_BYTES = 147456;
static_assert(MOE_OFF + 128 * 4 * 2 + MAXT * 4 <= LDS_BYTES, "LDS map");

#define LDS_WAIT() asm volatile("s_waitcnt lgkmcnt(0)" ::: "memory")
#define VM_WAIT() asm volatile("s_waitcnt vmcnt(0)" ::: "memory")
#define RLX_AGENT __ATOMIC_RELAXED, __HIP_MEMORY_SCOPE_AGENT

__device__ __forceinline__ unsigned pk2(float lo, float hi) { f32x2 v = {lo, hi}; bf16x2_t b = __builtin_convertvector(v, bf16x2_t); return __builtin_bit_cast(unsigned, b); }
__device__ __forceinline__ float bflo(unsigned u) { return __uint_as_float(u << 16); }
__device__ __forceinline__ float bfhi(unsigned u) { return __uint_as_float(u & 0xffff0000u); }
__device__ __forceinline__ void st8(bf16_t* p, f32x4 a, f32x4 b) { u32x4 w; w.x = pk2(a[0], a[1]); w.y = pk2(a[2], a[3]); w.z = pk2(b[0], b[1]); w.w = pk2(b[2], b[3]); *(u32x4*)p = w; }
__device__ __forceinline__ void ld8(const bf16_t* p, f32x4& a, f32x4& b) { const u32x4 w = *(const u32x4*)p; a = (f32x4){bflo(w.x), bfhi(w.x), bflo(w.y), bfhi(w.y)}; b = (f32x4){bflo(w.z), bfhi(w.z), bflo(w.w), bfhi(w.w)}; }
__device__ __forceinline__ float dot4(f32x4 a) { return (a[0] * a[0] + a[1] * a[1]) + (a[2] * a[2] + a[3] * a[3]); }
__device__ __forceinline__ float red_fq(float s) { s += __shfl_xor(s, 16); s += __shfl_xor(s, 32); return s; }
__device__ __forceinline__ float rsq(float x) { return __builtin_amdgcn_rsqf(x); }
__device__ __forceinline__ float fexp2(float x) { return __builtin_amdgcn_exp2f(x); }
__device__ __forceinline__ float frcp(float x) { return __builtin_amdgcn_rcpf(x); }

namespace pg8 {
constexpr int BM = 256, BK = 64, HALF = 128, HTB = HALF * BK * 2, STAGE_BYTES = 8 * HTB, NXCD = 8, WGM = 8;
__host__ __device__ __forceinline__ int lds_byte(int r, int c) { const int st = (r >> 4) * 2 + (c >> 5), rr = r & 15, cc = c & 31, ob = rr * 64 + cc * 2; return st * 1024 + (ob ^ (((ob >> 9) & 1) << 5)); }
__host__ __device__ __forceinline__ void stage_rc(int b, int& R, int& C) { const int st = b / 1024, sb = b % 1024, swz = sb ^ (((sb >> 9) & 1) << 5); R = (st >> 1) * 16 + swz / 64; C = (st & 1) * 32 + (swz % 64) / 2; }
__host__ __device__ __forceinline__ int perm32(int rho) { const int n = rho >> 4, i = rho & 15; return 8 * (i >> 2) + 4 * n + (i & 3); }
struct Unit { int pm, pn; };

__device__ __forceinline__ int xcd_remap(int L, int nwg) { const int q = nwg / NXCD, r = nwg % NXCD, xcd = L % NXCD, off = L / NXCD; return (xcd < r ? xcd * (q + 1) : r * (q + 1) + (xcd - r) * q) + off; }
struct DenseSched {
    const char* A; const char* Bt; int K, nM, nN, nwg, G, c;
    __device__ __forceinline__ void init(const bf16_t* A_, const bf16_t* Bt_, int Mr, int N, int K_, int G_, int c_) { A = (const char*)A_; Bt = (const char*)Bt_; K = K_; nM = Mr / BM; nN = N / BM; nwg = nM * nN; G = G_; c = c_; }
    __device__ __forceinline__ bool next(int i, Unit& u) const {
        const int L = i * G + c; if (L >= nwg) return false;
        const int wgid = xcd_remap(L, nwg);
        const int nig = WGM * nN, gid = wgid / nig, fm = gid * WGM, gsz = (nM - fm) < WGM ? (nM - fm) : WGM;
        u.pm = fm + ((wgid % nig) % gsz); u.pn = (wgid % nig) / gsz; return true;
    }
    __device__ __forceinline__ const char* a_base(const Unit& u) const { return A + (size_t)u.pm * ((size_t)BM * K * 2); }
    __device__ __forceinline__ const char* b_base(const Unit& u) const { return Bt + (size_t)u.pn * ((size_t)BM * K * 2); }
    __device__ __forceinline__ const char* b_base2(const Unit& u) const { return b_base(u); }
    __device__ __forceinline__ const unsigned* a_rowptr(const Unit&, int) const { return nullptr; }
};
__device__ __forceinline__ unsigned gld_untracked(const unsigned* p) { unsigned r; asm volatile("global_load_dword %0, %1, off" : "=&v"(r) : "v"(p) : "memory"); return r; }

template <class Epi, class Sched, bool GATHER, bool BSPLIT>
__device__ __forceinline__ void gemm_phase(LAS unsigned char* lds, const int K_, const Sched& S, const Epi& E) {
    int K = K_; asm volatile("" : "+s"(K));
    int tid_ = threadIdx.x; asm volatile("" : "+v"(tid_));
    const int tid = tid_, wid = __builtin_amdgcn_readfirstlane(tid >> 6), lane = tid & 63, wr = wid >> 2, wc = wid & 3, fr = lane & 15, fq = lane >> 4;
    const int nt = K / BK, nth = BSPLIT ? nt / 2 : nt, ldb = BSPLIT ? K / 2 : K;
    int Rr[2], Cc[2]; unsigned voffB[2];
#pragma unroll
    for (int i = 0; i < 2; ++i) { stage_rc(tid * 16 + i * 8192, Rr[i], Cc[i]); const int Rb = (Rr[i] & ~31) + perm32(Rr[i] & 31); voffB[i] = (unsigned)(Rb * ldb + Cc[i]) * 2u; }
    const size_t kstep = (size_t)(BK * 2);
    const size_t hstepB = (size_t)HALF * ldb * 2;
    const unsigned hstepA = (unsigned)HALF * (unsigned)K * 2u;
    const unsigned ldsw = (unsigned)wid * 1024u;
    const int aoff = lds_byte(wr * 64 + fr, fq * 8), boff = lds_byte(wc * 32 + fr, fq * 8);
#define PG8_SA(b, h) (((b) * 2 + (h)) * HTB)
#define PG8_SB(b, h) ((4 + (b) * 2 + (h)) * HTB)
#define PG8_STAGE(bufoff, gbase, o0, o1) do { \
        __builtin_amdgcn_global_load_lds((const unsigned*)((const char*)(gbase) + (o0)), (LAS unsigned*)(lds + (bufoff) + ldsw), 16, 0, 0); \
        __builtin_amdgcn_global_load_lds((const unsigned*)((const char*)(gbase) + (o1)), (LAS unsigned*)(lds + (bufoff) + ldsw + 8192), 16, 0, 0); } while (0)
#define PG8_STAGE_B(bufoff, gbase) PG8_STAGE(bufoff, gbase, voffB[0], voffB[1])
#define PG8_LDA(dst, b, h) do { _Pragma("unroll") for (int m = 0; m < 4; ++m) _Pragma("unroll") for (int k = 0; k < 2; ++k) dst[m][k] = *(const LAS bf16x8*)(lds + PG8_SA(b, h) + aoff + m * 2048 + k * 1024); } while (0)
#define PG8_LDB(dst, b, h) do { _Pragma("unroll") for (int n = 0; n < 2; ++n) _Pragma("unroll") for (int k = 0; k < 2; ++k) dst[n][k] = *(const LAS bf16x8*)(lds + PG8_SB(b, h) + boff + n * 2048 + k * 1024); } while (0)
#define PG8_MMA(ai, bj, At, Bt) do { __builtin_amdgcn_s_setprio(1); _Pragma("unroll") for (int m = 0; m < 4; ++m) _Pragma("unroll") for (int n = 0; n < 2; ++n) _Pragma("unroll") for (int k = 0; k < 2; ++k) \
        acc[ai][bj][m][n] = __builtin_amdgcn_mfma_f32_16x16x32_bf16(Bt[n][k], At[m][k], acc[ai][bj][m][n], 0, 0, 0); __builtin_amdgcn_s_setprio(0); } while (0)
#define PG8_WAIT_V(n) asm volatile("s_waitcnt vmcnt(" #n ")" ::: "memory")
#define PG8_WAIT_L(n) asm volatile("s_waitcnt lgkmcnt(" #n ")" ::: "memory")
#define PG8_BAR __builtin_amdgcn_s_barrier()
#define PG8_SCHED __builtin_amdgcn_sched_barrier(0)
    Unit cur, nxt; int ui = 0;
    if (!S.next(0, cur)) return;
    f32x4 acc[2][2][4][2];
#pragma unroll
    for (int a = 0; a < 2; ++a)
#pragma unroll
        for (int b = 0; b < 2; ++b)
#pragma unroll
            for (int m = 0; m < 4; ++m)
#pragma unroll
                for (int n = 0; n < 2; ++n) acc[a][b][m][n] = (f32x4){0.f, 0.f, 0.f, 0.f};
    bf16x8 At[4][2], B0[2][2], B1[2][2];
    unsigned oC[2][2], oN[2][2], rawN[2][2];
    if (GATHER) {
#pragma unroll
        for (int h = 0; h < 2; ++h)
#pragma unroll
            for (int i = 0; i < 2; ++i) rawN[h][i] = gld_untracked(S.a_rowptr(cur, Rr[i] + HALF * h));
        asm volatile("s_waitcnt vmcnt(0)" ::: "memory");
#pragma unroll
        for (int h = 0; h < 2; ++h)
#pragma unroll
            for (int i = 0; i < 2; ++i) { asm volatile("" : "+v"(rawN[h][i])); oC[h][i] = rawN[h][i] + (unsigned)Cc[i] * 2u; oN[h][i] = oC[h][i]; }
    } else {
#pragma unroll
        for (int h = 0; h < 2; ++h)
#pragma unroll
            for (int i = 0; i < 2; ++i) { oC[h][i] = (unsigned)(Rr[i] * K + Cc[i]) * 2u + (unsigned)h * hstepA; oN[h][i] = oC[h][i]; rawN[h][i] = 0u; }
    }
    const char* cA = S.a_base(cur); const char* cB = S.b_base(cur); const char* cB2 = S.b_base2(cur);
    PG8_STAGE_B(PG8_SB(0, 0), cB); PG8_STAGE_B(PG8_SB(0, 1), cB + hstepB); PG8_STAGE(PG8_SA(0, 0), cA, oC[0][0], oC[0][1]); PG8_STAGE(PG8_SA(0, 1), cA, oC[1][0], oC[1][1]);
    if (wr == 1) PG8_BAR;
    PG8_WAIT_V(2); PG8_BAR;
    PG8_STAGE_B(PG8_SB(1, 0), cB + kstep); PG8_STAGE(PG8_SA(1, 0), cA + kstep, oC[0][0], oC[0][1]); PG8_STAGE_B(PG8_SB(1, 1), cB + hstepB + kstep);
    PG8_WAIT_V(6); PG8_BAR;
    for (;;) {
        const bool has_next = S.next(ui + 1, nxt);
        const char* nA = has_next ? S.a_base(nxt) : cA; const char* nB = has_next ? S.b_base(nxt) : cB;
        if (GATHER) {
            if (has_next) {
#pragma unroll
                for (int h = 0; h < 2; ++h)
#pragma unroll
                    for (int i = 0; i < 2; ++i) rawN[h][i] = gld_untracked(S.a_rowptr(nxt, Rr[i] + HALF * h));
            }
        }
        for (int t = 0; t < nt; t += 2) {
            const bool last = (t == nt - 2);
            const char* a1 = cA + (size_t)(t + 1) * kstep;
            const char* a2 = last ? nA : cA + (size_t)(t + 2) * kstep;
            const char* b2 = last ? nB : ((BSPLIT && t + 2 >= nth) ? cB2 + (size_t)(t + 2 - nth) * kstep : cB + (size_t)(t + 2) * kstep);
            const char* a3 = a2 + kstep; const char* b3 = b2 + kstep;
            unsigned o2[2][2];
            if (GATHER && last && has_next) {
#pragma unroll
                for (int h = 0; h < 2; ++h)
#pragma unroll
                    for (int i = 0; i < 2; ++i) { asm volatile("" : "+v"(rawN[h][i])); oN[h][i] = rawN[h][i] + (unsigned)Cc[i] * 2u; }
            }
#pragma unroll
            for (int h = 0; h < 2; ++h)
#pragma unroll
                for (int i = 0; i < 2; ++i) o2[h][i] = (GATHER && last && has_next) ? oN[h][i] : oC[h][i];
            PG8_LDB(B0, 0, 0); PG8_LDB(B1, 0, 1); PG8_SCHED; PG8_LDA(At, 0, 0); PG8_STAGE(PG8_SA(1, 1), a1, oC[1][0], oC[1][1]);
            PG8_WAIT_V(8); PG8_WAIT_L(0); PG8_BAR; PG8_MMA(0, 0, At, B0); PG8_MMA(0, 1, At, B1); PG8_BAR; PG8_SCHED;
            PG8_LDA(At, 0, 1); PG8_STAGE_B(PG8_SB(0, 0), b2); PG8_STAGE_B(PG8_SB(0, 1), b2 + hstepB); PG8_STAGE(PG8_SA(0, 0), a2, o2[0][0], o2[0][1]);
            PG8_WAIT_V(8); PG8_WAIT_L(0); PG8_BAR; PG8_MMA(1, 0, At, B0); PG8_MMA(1, 1, At, B1); PG8_BAR; PG8_SCHED;
            PG8_LDB(B0, 1, 0); PG8_LDB(B1, 1, 1); PG8_SCHED; PG8_LDA(At, 1, 0); PG8_STAGE(PG8_SA(0, 1), a2, o2[1][0], o2[1][1]);
            PG8_WAIT_V(8); PG8_WAIT_L(0); PG8_BAR; PG8_MMA(0, 0, At, B0); PG8_MMA(0, 1, At, B1); PG8_BAR; PG8_SCHED;
            PG8_LDA(At, 1, 1); PG8_STAGE_B(PG8_SB(1, 0), b3); PG8_STAGE_B(PG8_SB(1, 1), b3 + hstepB); PG8_STAGE(PG8_SA(1, 0), a3, o2[0][0], o2[0][1]);
            PG8_WAIT_V(8); PG8_WAIT_L(0); PG8_BAR; PG8_MMA(1, 0, At, B0); PG8_MMA(1, 1, At, B1); PG8_BAR; PG8_SCHED;
        }
        if (wr == 0) PG8_BAR;
        E(acc, cur, wr, wc, fr, fq);
        if (!has_next) break;
#pragma unroll
        for (int a = 0; a < 2; ++a)
#pragma unroll
            for (int b = 0; b < 2; ++b)
#pragma unroll
                for (int m = 0; m < 4; ++m)
#pragma unroll
                    for (int n = 0; n < 2; ++n) acc[a][b][m][n] = (f32x4){0.f, 0.f, 0.f, 0.f};
        cur = nxt; cA = nA; cB = nB; cB2 = S.b_base2(cur); ++ui;
        if (GATHER) {
#pragma unroll
            for (int h = 0; h < 2; ++h)
#pragma unroll
                for (int i = 0; i < 2; ++i) oC[h][i] = oN[h][i];
        }
        if (wr == 1) PG8_BAR;
    }
    PG8_WAIT_V(0);
    PG8_BAR;
#undef PG8_SA
#undef PG8_SB
#undef PG8_STAGE
#undef PG8_STAGE_B
#undef PG8_LDA
#undef PG8_LDB
#undef PG8_MMA
#undef PG8_WAIT_V
#undef PG8_WAIT_L
#undef PG8_BAR
#undef PG8_SCHED
}
}

namespace att {
#define SBAR() __builtin_amdgcn_sched_barrier(0)
typedef LAS const char* lds_cptr;
__device__ __forceinline__ int crow(int r, int hi) { return (r & 3) + 8 * (r >> 2) + 4 * hi; }
__device__ __forceinline__ void glds16(const void* gsrc, unsigned lds_dst) { unsigned keep;
    asm volatile("s_mov_b32 %0, m0\n\ts_mov_b32 m0, %2\n\ts_nop 0\n\tglobal_load_lds_dwordx4 %1, off\n\ts_mov_b32 m0, %0" : "=&s"(keep) : "v"(gsrc), "s"(lds_dst) : "memory"); }
__device__ __forceinline__ float max3f(float a, float b, float c) { return __builtin_fmaxf(__builtin_fmaxf(a, b), c); }
__device__ __forceinline__ float rowmax(const f32x16& p0, const f32x16& p1) {
    float a = max3f(p0[0], p0[1], p1[0]), b = max3f(p0[2], p0[3], p1[1]); a = max3f(a, p1[2], p1[3]);
#pragma unroll
    for (int r = 4; r < 16; r += 4) { a = max3f(a, p0[r], p0[r + 1]); b = max3f(b, p0[r + 2], p0[r + 3]); a = max3f(a, p1[r], p1[r + 1]); b = max3f(b, p1[r + 2], p1[r + 3]); }
    const float m = __builtin_fmaxf(a, b);
    auto rr = __builtin_amdgcn_permlane32_swap(__float_as_uint(m), __float_as_uint(m), false, false);
    return __builtin_fmaxf(__uint_as_float(rr[0]), __uint_as_float(rr[1]));
}
template <int ND> __device__ __forceinline__ void qkt(f32x16& p0, f32x16& p1, lds_cptr Kslot, const bf16x8* qr, const f32x16& negm, int r32, int hi) {
    lds_cptr kb = Kslot + hi * 1024 + r32 * 16;
#pragma unroll
    for (int d0 = 0; d0 < ND; ++d0) {
        const bf16x8 b0 = *(const LAS bf16x8*)(kb + d0 * 2048);
        const bf16x8 b1 = *(const LAS bf16x8*)(kb + d0 * 2048 + 512);
        if (d0 == 0) { p0 = __builtin_amdgcn_mfma_f32_32x32x16_bf16(b0, qr[0], negm, 0, 0, 0); p1 = __builtin_amdgcn_mfma_f32_32x32x16_bf16(b1, qr[0], negm, 0, 0, 0); }
        else { p0 = __builtin_amdgcn_mfma_f32_32x32x16_bf16(b0, qr[d0], p0, 0, 0, 0); p1 = __builtin_amdgcn_mfma_f32_32x32x16_bf16(b1, qr[d0], p1, 0, 0, 0); }
    }
}
__device__ __forceinline__ void pv(f32x16* o, int vb, bf16x8 pa0, bf16x8 pa1, bf16x8 pa2, bf16x8 pa3) {
#pragma unroll
    for (int d0 = 0; d0 < 2; ++d0) { s16x4 lo[4], hi[4];
#pragma unroll
        for (int ks = 0; ks < 4; ++ks) {
            asm volatile("ds_read_b64_tr_b16 %0,%1 offset:%c2" : "=&v"(lo[ks]) : "v"(vb), "i"(d0 * 4096 + ks * 1024) : "memory");
            asm volatile("ds_read_b64_tr_b16 %0,%1 offset:%c2" : "=&v"(hi[ks]) : "v"(vb), "i"(d0 * 4096 + ks * 1024 + 512) : "memory"); }
        asm volatile("s_waitcnt lgkmcnt(0)" ::: "memory"); SBAR();
#define PK(k) (bf16x8){lo[k][0], lo[k][1], lo[k][2], lo[k][3], hi[k][0], hi[k][1], hi[k][2], hi[k][3]}
        o[d0] = __builtin_amdgcn_mfma_f32_32x32x16_bf16(pa0, PK(0), o[d0], 0, 0, 0);
        o[d0] = __builtin_amdgcn_mfma_f32_32x32x16_bf16(pa1, PK(1), o[d0], 0, 0, 0);
        o[d0] = __builtin_amdgcn_mfma_f32_32x32x16_bf16(pa2, PK(2), o[d0], 0, 0, 0);
        o[d0] = __builtin_amdgcn_mfma_f32_32x32x16_bf16(pa3, PK(3), o[d0], 0, 0, 0);
#undef PK
    }
}
constexpr float THR = 8.0f;
struct SoftState { float mhat, l; f32x16 negm; f32x16 o[2]; };
__device__ __forceinline__ void softmax_pv(SoftState& st, f32x16& p0, f32x16& p1, LAS float* wsf, int vb, int r32, int hi) {
    const float rm = rowmax(p0, p1);
    if (__any(rm > THR)) {
        const float dl = __builtin_fmaxf(rm, 0.f);
        st.mhat += dl;
#pragma unroll
        for (int r = 0; r < 16; ++r) { p0[r] -= dl; p1[r] -= dl; }
#pragma unroll
        for (int r = 0; r < 16; ++r) st.negm[r] = -st.mhat;
        const float f = fexp2(-dl); st.l *= f;
        if (hi == 0) wsf[r32] = f;
        LDS_WAIT();
#pragma unroll
        for (int r = 0; r < 16; ++r) { const float fr_ = wsf[crow(r, hi)]; st.o[0][r] *= fr_; st.o[1][r] *= fr_; }
        LDS_WAIT();
    }
    float sacc = 0.f;
#pragma unroll
    for (int r = 0; r < 16; ++r) { p0[r] = fexp2(p0[r]); p1[r] = fexp2(p1[r]); sacc += p0[r] + p1[r]; }
    st.l += sacc;
    u32x4 w0, w1, w2, w3;
    w0 = (u32x4){pk2(p0[0], p0[1]), pk2(p0[2], p0[3]), pk2(p0[4], p0[5]), pk2(p0[6], p0[7])};
    w1 = (u32x4){pk2(p0[8], p0[9]), pk2(p0[10], p0[11]), pk2(p0[12], p0[13]), pk2(p0[14], p0[15])};
    w2 = (u32x4){pk2(p1[0], p1[1]), pk2(p1[2], p1[3]), pk2(p1[4], p1[5]), pk2(p1[6], p1[7])};
    w3 = (u32x4){pk2(p1[8], p1[9]), pk2(p1[10], p1[11]), pk2(p1[12], p1[13]), pk2(p1[14], p1[15])};
    pv(st.o, vb, __builtin_bit_cast(bf16x8, w0), __builtin_bit_cast(bf16x8, w1), __builtin_bit_cast(bf16x8, w2), __builtin_bit_cast(bf16x8, w3));
}
__device__ __forceinline__ void finish_rows(SoftState& st, LAS float* wsf, LAS bf16_t* stg, int r32, int hi) {
    float l = st.l;
    { auto rr = __builtin_amdgcn_permlane32_swap(__float_as_uint(l), __float_as_uint(l), false, false); l = __uint_as_float(rr[0]) + __uint_as_float(rr[1]); }
    if (hi == 0) { wsf[32 + r32] = l; wsf[64 + r32] = st.mhat + __builtin_amdgcn_logf(l); }
    LDS_WAIT();
#pragma unroll
    for (int r = 0; r < 16; ++r) { const int orow = crow(r, hi); const float rl = frcp(wsf[32 + orow]);
#pragma unroll
        for (int d0 = 0; d0 < 2; ++d0) stg[orow * 64 + d0 * 32 + r32] = (bf16_t)(pk2(st.o[d0][r] * rl, 0.f) & 0xffffu); }
    LDS_WAIT();
}

constexpr int MK_SLOT = 12288, MV_SLOT = 8192, M_LK = 0, M_LV = 3 * MK_SLOT;
__device__ __forceinline__ void mla_unit(int b, int h, int qb, const bf16_t* QM, const bf16_t* KN, const bf16_t* KR, const bf16_t* VM, bf16_t* MIX, LAS char* shm) {
    int tid_ = threadIdx.x; asm volatile("" : "+v"(tid_)); const int tid = tid_, lane = tid & 63, r32 = lane & 31, hi = lane >> 5; const int wid = __builtin_amdgcn_readfirstlane(tid >> 6);
    const long rowbase = (long)b * SEQ; const int q0 = qb * 256;
    const unsigned lds0 = (unsigned)(uintptr_t)shm;
    LAS float* wsf = (LAS float*)(shm + ATT_WSF) + wid * 128;
    LAS bf16_t* stg = (LAS bf16_t*)(shm + ATT_OST) + wid * 2048;
    const bf16_t* ksrc0 = KN + (rowbase + lane) * 512 + h * 64 + wid * 8;
    const bf16_t* ksrc1 = KR + (rowbase + lane) * 32 + (wid & 3) * 8;
    const bf16_t* vsrc = VM + (rowbase + 16 * (wid & 3) + (lane >> 2)) * 512 + h * 64 + (wid >> 2) * 32 + (lane & 3) * 8;
    const unsigned kdst0 = lds0 + M_LK + wid * 1024, kdst1 = lds0 + M_LK + (8 + (wid & 3)) * 1024, vdst = lds0 + M_LV + wid * 1024;
#define MLA_DMA(t, s) do { glds16(ksrc0 + (long)(t) * 64 * 512, (unsigned)__builtin_amdgcn_readfirstlane(kdst0 + (s) * MK_SLOT)); \
        glds16(ksrc1 + (long)(t) * 64 * 32, (unsigned)__builtin_amdgcn_readfirstlane(kdst1 + (s) * MK_SLOT)); \
        glds16(vsrc + (long)(t) * 64 * 512, (unsigned)__builtin_amdgcn_readfirstlane(vdst + (s) * MV_SLOT)); } while (0)
    const int NT = (q0 + 256) / 64;
    MLA_DMA(0, 0); MLA_DMA(1, 1);
    const bf16_t* Qw = QM + (rowbase + q0 + wid * 32 + r32) * 768 + h * 96 + hi * 8;
    bf16x8 qr[6];
#pragma unroll
    for (int d0 = 0; d0 < 6; ++d0) qr[d0] = *(const bf16x8*)(Qw + d0 * 16);
    SoftState st; st.mhat = 0.f; st.l = 0.f; st.negm = f32x16{}; st.o[0] = f32x16{}; st.o[1] = f32x16{};
    const int qw0 = q0 + wid * 32, qrel = qw0 + r32;
    const int vb0 = (int)(lds0 + M_LV) + ((lane >> 4) & 1) * 32 + (lane & 3) * 8 + (4 * hi + ((lane & 15) >> 2)) * 64;
    int slot = 0;
    for (int t = 0; t < NT; ++t) {
        if (t + 1 < NT) asm volatile("s_waitcnt vmcnt(3) lgkmcnt(0)\n\ts_barrier" ::: "memory");
        else asm volatile("s_waitcnt vmcnt(0) lgkmcnt(0)\n\ts_barrier" ::: "memory");
        if (t + 2 < NT) { const int s2 = slot == 0 ? 2 : slot - 1; MLA_DMA(t + 2, s2); }
        if (64 * t <= qw0 + 31) {
            f32x16 p0, p1;
            qkt<6>(p0, p1, (lds_cptr)(shm + M_LK + slot * MK_SLOT), qr, st.negm, r32, hi);
            if (64 * t + 63 > qw0) {
                const int kb = 64 * t + 4 * hi;
#pragma unroll
                for (int r = 0; r < 16; ++r) { const int kv = kb + (r & 3) + 8 * (r >> 2); if (kv > qrel) p0[r] = -INFINITY; if (kv + 32 > qrel) p1[r] = -INFINITY; }
            }
            softmax_pv(st, p0, p1, wsf, vb0 + slot * MV_SLOT, r32, hi);
        }
        slot = slot == 2 ? 0 : slot + 1;
    }
    finish_rows(st, wsf, stg, r32, hi);
    bf16_t* Ow = MIX + (rowbase + q0 + wid * 32) * 1024 + 512 + h * 64;
#pragma unroll
    for (int i = 0; i < 4; ++i) { const int row = i * 8 + (lane >> 3), ch = lane & 7; const u32x4 v = *(const LAS u32x4*)(stg + row * 64 + ch * 8); *(u32x4*)(Ow + (long)row * 1024 + ch * 8) = v; }
    asm volatile("s_waitcnt lgkmcnt(0)\n\ts_barrier" ::: "memory");
#undef MLA_DMA
}

constexpr int D_LK = 0, D_LV = 49152;
__device__ __forceinline__ void dil_unit(int b, int h, int br, int uu, const bf16_t* QA, const bf16_t* KA, const bf16_t* VA, bf16_t* O2, bf16_t* O3, float* LSE2, float* LSE3, bf16_t* MIX,
                                         LAS char* shm, const LAS float* tbl) {
    int tid_ = threadIdx.x; asm volatile("" : "+v"(tid_)); const int tid = tid_, lane = tid & 63, r32 = lane & 31, hi = lane >> 5; const int wid = __builtin_amdgcn_readfirstlane(tid >> 6);
    const long rowbase = (long)b * SEQ;
    const unsigned lds0 = (unsigned)(uintptr_t)shm;
    LAS float* wsf = (LAS float*)(shm + ATT_WSF) + wid * 128;
    LAS bf16_t* stg = (LAS bf16_t*)(shm + ATT_OST) + wid * 2048;
    const int dsh = 2 * br, d = 1 << dsh;
    int res0, tb, nslot;
    if (br == 2) { res0 = 2 * uu; tb = 0; nslot = 4; }
    else { res0 = (br == 0) ? 0 : (uu >> 1); const int Q0 = (br == 0) ? 256 * uu : 256 * (uu & 1); tb = Q0 / 64 - 2; nslot = 6; }
    int wres, qs, j0, nj;
    if (br == 2) { wres = res0 + (wid >> 2); qs = 32 * (wid & 3); j0 = 2 * (wid >> 2); nj = (wid & 3) < 2 ? 1 : 2; }
    else { wres = res0; qs = (tb + 2) * 64 + 32 * wid; j0 = wid >> 1; nj = 3; }
    for (int j = 0; j < nslot; ++j) {
        const int tile = (br == 2) ? (j & 1) : tb + j; const int res = (br == 2) ? res0 + (j >> 1) : res0;
        if (tile < 0) continue;
        const long krow = rowbase + res + (long)d * (64 * tile + lane);
        const long vrow = rowbase + res + (long)d * (64 * tile + 16 * (wid & 3) + (lane >> 2));
        glds16(KA + krow * 512 + h * 64 + wid * 8, (unsigned)__builtin_amdgcn_readfirstlane(lds0 + D_LK + j * 8192 + wid * 1024));
        glds16(VA + vrow * 512 + h * 64 + (wid >> 2) * 32 + (lane & 3) * 8, (unsigned)__builtin_amdgcn_readfirstlane(lds0 + D_LV + j * 8192 + wid * 1024));
    }
    const bf16_t* Qw = QA + (rowbase + wres + (long)d * (qs + r32)) * 512 + h * 64 + hi * 8;
    bf16x8 qr[4];
#pragma unroll
    for (int d0 = 0; d0 < 4; ++d0) qr[d0] = *(const bf16x8*)(Qw + d0 * 16);
    asm volatile("s_waitcnt vmcnt(0) lgkmcnt(0)\n\ts_barrier" ::: "memory");
    SoftState st; st.mhat = 0.f; st.l = 0.f; st.negm = f32x16{}; st.o[0] = f32x16{}; st.o[1] = f32x16{};
    const int vb0 = (int)(lds0 + D_LV) + ((lane >> 4) & 1) * 32 + (lane & 3) * 8 + (4 * hi + ((lane & 15) >> 2)) * 64;
    const LAS float* tbr = tbl + br * 320;
    for (int jj = 0; jj < nj; ++jj) {
        const int j = j0 + jj; const int tile = (br == 2) ? jj : tb + j;
        if (tile < 0) continue;
        f32x16 p0, p1;
        qkt<4>(p0, p1, (lds_cptr)(shm + D_LK + j * 8192), qr, st.negm, r32, hi);
        const LAS float* tp = tbr + (qs + r32 - 64 * tile + 33 - 4 * hi);
#pragma unroll
        for (int r = 0; r < 16; ++r) { const int c0 = (r & 3) + 8 * (r >> 2); p0[r] += tp[63 - c0]; p1[r] += tp[31 - c0]; }
        softmax_pv(st, p0, p1, wsf, vb0 + j * 8192, r32, hi);
    }
    finish_rows(st, wsf, stg, r32, hi);
    const long trow0 = rowbase + wres + (long)d * qs;
    if (br != 0) {
        bf16_t* Ob = (br == 1) ? O2 : O3; float* Lb = (br == 1) ? LSE2 : LSE3;
#pragma unroll
        for (int i = 0; i < 4; ++i) { const int row = i * 8 + (lane >> 3), ch = lane & 7; const long tr = trow0 + (long)d * row;
            const u32x4 v = *(const LAS u32x4*)(stg + row * 64 + ch * 8); *(u32x4*)(Ob + tr * 512 + h * 64 + ch * 8) = v;
            if (ch == 0) Lb[tr * 8 + h] = wsf[64 + row]; }
    } else {
#pragma unroll
        for (int i = 0; i < 4; ++i) { const int row = i * 8 + (lane >> 3), ch = lane & 7; const long tr = trow0 + row;
            f32x4 a1, b1, a2, b2, a3, b3;
            { const u32x4 w = *(const LAS u32x4*)(stg + row * 64 + ch * 8); a1 = (f32x4){bflo(w.x), bfhi(w.x), bflo(w.y), bfhi(w.y)}; b1 = (f32x4){bflo(w.z), bfhi(w.z), bflo(w.w), bfhi(w.w)}; }
            ld8(O2 + tr * 512 + h * 64 + ch * 8, a2, b2); ld8(O3 + tr * 512 + h * 64 + ch * 8, a3, b3);
            const float l1 = wsf[64 + row], l2 = LSE2[tr * 8 + h], l3 = LSE3[tr * 8 + h];
            const float mx = max3f(l1, l2, l3); const float e1 = fexp2(l1 - mx), e2 = fexp2(l2 - mx), e3 = fexp2(l3 - mx); const float inv = frcp(e1 + e2 + e3);
            const float w1 = e1 * inv, w2 = e2 * inv, w3 = e3 * inv;
            st8(MIX + tr * 1024 + h * 64 + ch * 8, a1 * w1 + a2 * w2 + a3 * w3, b1 * w1 + b2 * w2 + b3 * w3); }
    }
    asm volatile("s_waitcnt lgkmcnt(0)\n\ts_barrier" ::: "memory");
}
#undef SBAR
}

#define XB_TMO      128
#define XB_XCNT(j)  (256  + 64 * (j))
#define XB_XSUB(j)  (1280 + 64 * (j))
#define XB_XGEN(j)  (2304 + 64 * (j))
#define XB_TOP      3328
#define XB_TOPGEN   3392
#define XCD_BAR_WORDS 3456
#define XB_SPIN_CAP (1u << 18)

__device__ __forceinline__ unsigned xb_ld(unsigned* p)              { return __hip_atomic_load(p, __ATOMIC_RELAXED, __HIP_MEMORY_SCOPE_AGENT); }
__device__ __forceinline__ unsigned xb_add(unsigned* p, unsigned v) { return __hip_atomic_fetch_add(p, v, __ATOMIC_RELAXED, __HIP_MEMORY_SCOPE_AGENT); }
__device__ __forceinline__ unsigned xb_xcc_id() { return (unsigned)__builtin_amdgcn_s_getreg((3 << 11) | 20) & 0xFu; }
#define XB_SPIN(cond, bar) do { unsigned _sp = 0; while (cond) { __builtin_amdgcn_s_sleep(1); \
    if ((++_sp & 255u) == 0u) { if (xb_ld(&(bar)[XB_TMO])) break; if (_sp > XB_SPIN_CAP) { atomicAdd(&(bar)[XB_TMO], 1u); break; } } } } while (0)

struct XcdBarrier {
    unsigned* bar; unsigned x;
    volatile LAS unsigned* st;
};

__device__ __forceinline__ XcdBarrier xcd_barrier_post(unsigned* bar, volatile LAS unsigned* st) {
    XcdBarrier b; b.bar = bar; b.x = xb_xcc_id(); b.st = st;
    if (threadIdx.x == 0) (void)xb_add(&bar[XB_XCNT(b.x)], 1u);
    return b;
}
__device__ __forceinline__ void xcd_barrier_complete(unsigned* bar, unsigned x, unsigned& nloc, unsigned& nx) {
    const unsigned G = gridDim.x * gridDim.y * gridDim.z;
    unsigned sum, cnt, mine, sp = 0u;
    for (;;) {
        sum = 0u; cnt = 0u; mine = 0u;
#pragma unroll
        for (unsigned j = 0; j < 16; ++j) { const unsigned c = xb_ld(&bar[XB_XCNT(j)]); sum += c; cnt += (c > 0u) ? 1u : 0u; mine = (j == x) ? c : mine; }
        if (sum == G) break;
        __builtin_amdgcn_s_sleep(1);
        if ((++sp & 255u) == 0u) { if (xb_ld(&bar[XB_TMO])) break; if (sp > XB_SPIN_CAP) { atomicAdd(&bar[XB_TMO], 1u); break; } }
    }
    nloc = mine > 0u ? mine : 1u; nx = cnt > 0u ? cnt : 1u;
}

__device__ __forceinline__ void xcd_barrier(const XcdBarrier& b) {
    asm volatile("s_waitcnt vmcnt(0)" ::: "memory");
    __syncthreads();
    if (threadIdx.x == 0) {
        unsigned* bar = b.bar;
        __builtin_amdgcn_s_waitcnt(0);
        unsigned nloc = b.st[0], nx = b.st[1];
        if (nloc == 0u) { xcd_barrier_complete(bar, b.x, nloc, nx); b.st[0] = nloc; b.st[1] = nx; }
        const unsigned old = xb_add(&bar[XB_XSUB(b.x)], 1u);
        const unsigned gen = old / nloc;
        if (old + 1u == (gen + 1u) * nloc) {
            __builtin_amdgcn_fence(__ATOMIC_RELEASE, "agent");
            asm volatile("s_waitcnt vmcnt(0)" ::: "memory");
            const unsigned og = xb_add(&bar[XB_TOP], 1u);
            const unsigned tg = og / nx;
            if (og + 1u == (tg + 1u) * nx) xb_add(&bar[XB_TOPGEN], 1u);
            else XB_SPIN(xb_ld(&bar[XB_TOPGEN]) == tg, bar);
            __builtin_amdgcn_fence(__ATOMIC_ACQUIRE, "agent");
            xb_add(&bar[XB_XGEN(b.x)], 1u);
            asm volatile("s_waitcnt vmcnt(0)" ::: "memory");
        } else {
            XB_SPIN(xb_ld(&bar[XB_XGEN(b.x)]) == gen, bar);
            __builtin_amdgcn_fence(__ATOMIC_ACQUIRE, "agent");
            asm volatile("s_waitcnt vmcnt(0)" ::: "memory");
        }
    }
    __syncthreads();
}

struct Frame {
    LAS unsigned char* lds; volatile LAS unsigned* MISC; unsigned* ctl; unsigned char* ws;
    int tid, lane, wave, vcu, G;
};
struct Args {
    const float* in[28]; float* out; unsigned char* ws;
};
enum { I_X = 0, I_P, I_RELB, I_NMG, I_WIN, I_QNA, I_KNA, I_QAG, I_WQUP, I_KVAG, I_WKVUP, I_QNN, I_QNR, I_KNN, I_KNR, I_WOUT, I_NFG, I_WRG, I_BRG, I_WRE, I_BRE, I_WEG, I_WEU, I_WED, I_WPP, I_PNG, I_WPG, I_BPG };

__device__ __forceinline__ float wave_sum(float v) {
#pragma unroll
    for (int o = 1; o < 64; o <<= 1) v += __shfl_xor(v, o);
    return v;
}

template <class RowMap>
__device__ __forceinline__ void tr_item(const float* __restrict__ W, int N, const float* __restrict__ kscale, bf16_t* WT, int ldt, RowMap map, LAS float* scr, int k0, int n0, int lane) {
    float tv[32];
#pragma unroll
    for (int i = 0; i < 32; ++i) { const int kk = 2 * i + (lane >> 5); tv[i] = W[(size_t)(k0 + kk) * N + n0 + (lane & 31)]; }
    if (kscale) {
#pragma unroll
        for (int i = 0; i < 32; ++i) tv[i] *= kscale[k0 + 2 * i + (lane >> 5)];
    }
#pragma unroll
    for (int i = 0; i < 32; ++i) scr[(2 * i + (lane >> 5)) * 33 + (lane & 31)] = tv[i];
    LDS_WAIT(); asm volatile("" ::: "memory");
    const int c = lane & 7;
#pragma unroll
    for (int j = 0; j < 4; ++j) { const int n = (lane >> 3) + 8 * j; const LAS float* s = scr + (8 * c) * 33 + n;
        u32x4 o; o.x = pk2(s[0 * 33], s[1 * 33]); o.y = pk2(s[2 * 33], s[3 * 33]); o.z = pk2(s[4 * 33], s[5 * 33]); o.w = pk2(s[6 * 33], s[7 * 33]);
        const int dr = map(n0 + n);
        if (dr >= 0) *(u32x4*)(WT + (size_t)dr * ldt + k0 + 8 * c) = o; }
    LDS_WAIT(); asm volatile("" ::: "memory");
}
struct MapId { int off; __device__ __forceinline__ int operator()(int n) const { return off + n; } };
__device__ __forceinline__ int slot_row(int s, int c64) { return 256 * (s >> 2) + 128 * (c64 >> 5) + 32 * (s & 3) + (c64 & 31); }
__device__ __forceinline__ int rope_j(int dim) { return 8 * ((dim & 15) >> 2) + 4 * (dim >> 4) + (dim & 3); }
struct MapWin { __device__ __forceinline__ int operator()(int L) const {
    if (L < 1024) return slot_row(L >> 6, L & 63);
    if (L < 1536) return L;
    if (L < 2176) return 1536 + slot_row((L - 1536) >> 6, (L - 1536) & 63);
    return 1536 + slot_row(10, rope_j(L - 2176));
} };
struct MapQup { __device__ __forceinline__ int operator()(int L) const { const int hd = L / 96, dd = L % 96;
    if (dd < 64) return slot_row(hd, dd);
    return 512 + slot_row(hd >> 1, 32 * (hd & 1) + rope_j(dd - 64));
} };
struct MapKVup { __device__ __forceinline__ int operator()(int L) const { const int hd = L >> 7, dd = L & 127;
    if (dd < 64) return slot_row(hd, dd);
    return 512 + hd * 64 + (dd - 64);
} };
struct MapGU { int up; __device__ __forceinline__ int operator()(int c) const { return (c >> 7) * 256 + up * 128 + (c & 127); } };

__device__ __forceinline__ int t5_bucket(int n) {
    if (n < 16) return n;
    int lg = 16 + (int)(__builtin_amdgcn_logf((float)n * 0.0625f) * (16.0f / 7.0f));
    return lg < 31 ? lg : 31;
}

__device__ __forceinline__ void p0_prologue(Frame& F, const Args& a) {
    LAS float* scr = (LAS float*)(F.lds + F.wave * 16384);
    const int gw = F.vcu * 8 + F.wave, NGW = F.G * 8, lane = F.lane;
    unsigned char* ws = F.ws;
    constexpr int I0 = 16 * 69, I1 = 6 * 24, I2 = 4 * 32, I3 = 16 * 32, I4 = 16, I5 = NEXP * 256, I6 = NEXP * 256, I7 = NEXP * 256, I8 = 4 * 32, I9 = 16 * 32;
    constexpr int NITEMS = I0 + I1 + I2 + I3 + I4 + I5 + I6 + I7 + I8 + I9;
    for (int it = gw; it < NITEMS; it += NGW) {
        int r = it;
        if (r < I0) { tr_item(a.in[I_WIN], INC, nullptr, (bf16_t*)(ws + WS_WIN), 1024, MapWin{}, scr, 64 * (r / 69), 32 * (r % 69), lane); continue; } r -= I0;
        if (r < I1) { tr_item(a.in[I_WQUP], 768, a.in[I_QAG], (bf16_t*)(ws + WS_WQUP), 384, MapQup{}, scr, 64 * (r / 24), 32 * (r % 24), lane); continue; } r -= I1;
        if (r < I2) { tr_item(a.in[I_WKVUP], 1024, a.in[I_KVAG], (bf16_t*)(ws + WS_WKVUP), 256, MapKVup{}, scr, 64 * (r / 32), 32 * (r % 32), lane); continue; } r -= I2;
        if (r < I3) { tr_item(a.in[I_WOUT], 1024, nullptr, (bf16_t*)(ws + WS_WOUT), 1024, MapId{0}, scr, 64 * (r / 32), 32 * (r % 32), lane); continue; } r -= I3;
        if (r < I4) { tr_item(a.in[I_WRE], 32, a.in[I_NFG], (bf16_t*)(ws + WS_WR), 1024, MapId{0}, scr, 64 * r, 0, lane); continue; } r -= I4;
        if (r < I5) { const int e = r >> 8, q = r & 255; tr_item(a.in[I_WEG] + (size_t)e * 1024 * 512, 512, a.in[I_NFG], (bf16_t*)(ws + WS_WGU) + (size_t)e * 1024 * 1024, 1024, MapGU{0}, scr, 64 * (q >> 4), 32 * (q & 15), lane); continue; } r -= I5;
        if (r < I6) { const int e = r >> 8, q = r & 255; tr_item(a.in[I_WEU] + (size_t)e * 1024 * 512, 512, a.in[I_NFG], (bf16_t*)(ws + WS_WGU) + (size_t)e * 1024 * 1024, 1024, MapGU{1}, scr, 64 * (q >> 4), 32 * (q & 15), lane); continue; } r -= I6;
        if (r < I7) { const int e = r >> 8, q = r & 255; tr_item(a.in[I_WED] + (size_t)e * 512 * 1024, 1024, nullptr, (bf16_t*)(ws + WS_WD) + (size_t)e * 1024 * 512, 512, MapId{0}, scr, 64 * (q >> 5), 32 * (q & 31), lane); continue; } r -= I7;
        if (r < I8) { tr_item(a.in[I_WPP], 1024, nullptr, (bf16_t*)(ws + WS_WPP), 256, MapId{0}, scr, 64 * (r / 32), 32 * (r % 32), lane); continue; } r -= I8;
        tr_item(a.in[I_WPG], 1024, nullptr, (bf16_t*)(ws + WS_WPG), 1024, MapId{0}, scr, 64 * (r / 32), 32 * (r % 32), lane);
    }
    const int gt = F.vcu * 512 + F.tid, NGT = F.G * 512;
    { bf16_t* WR = (bf16_t*)(ws + WS_WR); const float* wrg = a.in[I_WRG]; const float* nfg = a.in[I_NFG];
      for (int i = gt; i < 224 * 1024; i += NGT) { const int rr = 32 + (i >> 10), k = i & 1023; float v = 0.f; if (rr >= 128 && rr < 132) v = wrg[k * 4 + (rr - 128)] * nfg[k]; WR[(size_t)rr * 1024 + k] = (bf16_t)(pk2(v, 0.f) & 0xffffu); }
      bf16_t* WI = (bf16_t*)(ws + WS_WIN);
      for (int i = gt; i < 96 * 1024; i += NGT) { const int q = i >> 10, k = i & 1023; const int rr = (q < 32) ? 1536 + slot_row(10, 32 + q) : 1536 + slot_row(11, q - 32); WI[(size_t)rr * 1024 + k] = 0; } }
    { float* cs = (float*)(ws + WS_ROPE);
      for (int i = gt; i < 2048 * 16; i += NGT) { const int pos = i >> 4, k = i & 15; const float inv = __builtin_amdgcn_exp2f(-(float)k * (13.287712379549449f / 16.0f));
          const float ang = (float)pos * inv; double rv = (double)ang * 0.15915494309189535; rv -= __builtin_floor(rv); const float rf = (float)rv;
          cs[pos * 32 + k] = __builtin_amdgcn_cosf(rf); cs[pos * 32 + 16 + k] = __builtin_amdgcn_sinf(rf); }
      float* tb = (float*)(ws + WS_TBG); const float* relb = a.in[I_RELB];
      for (int i = gt; i < 3 * 8 * 320; i += NGT) { const int br = i / 2560, hh = (i / 320) & 7, idx = i % 320, delta = idx - 96;
          float v = -1e30f; if (delta >= 0 && delta <= 128) v = relb[t5_bucket(delta << (2 * br)) * 8 + hh] * LOG2E; tb[i] = v; }
      i32x4* rr4 = (i32x4*)(ws + WS_ROWREC); unsigned* ro = (unsigned*)(ws + WS_ROWOFF);
      for (int i = gt; i < MAXT * 256; i += NGT) { rr4[i] = (i32x4){-1, 0, 0, 0}; ro[i] = 0u; } }
    { const f32x4* p4 = (const f32x4*)a.in[I_P]; u32x4* pb = (u32x4*)(ws + WS_PB);
      for (int i0 = gt; i0 < M * PLE / 8; i0 += 4 * NGT) { f32x4 u[4], v[4];
#pragma unroll
          for (int j = 0; j < 4; ++j) { const int i = i0 + j * NGT; if (i < M * PLE / 8) { u[j] = p4[2 * i]; v[j] = p4[2 * i + 1]; } }
#pragma unroll
          for (int j = 0; j < 4; ++j) { const int i = i0 + j * NGT; if (i < M * PLE / 8) { u32x4 o; o.x = pk2(u[j][0], u[j][1]); o.y = pk2(u[j][2], u[j][3]); o.z = pk2(v[j][0], v[j][1]); o.w = pk2(v[j][2], v[j][3]); pb[i] = o; } } } }
    { const float* x = a.in[I_X]; const f32x4* g4 = (const f32x4*)a.in[I_NMG]; bf16_t* XN = (bf16_t*)(ws + WS_XN);
      f32x4 gv[4];
#pragma unroll
      for (int j = 0; j < 4; ++j) gv[j] = g4[lane + 64 * j];
      for (int m0 = gw; m0 < M; m0 += 4 * NGW) {
          f32x4 v[4][4];
#pragma unroll
          for (int q = 0; q < 4; ++q) { const int m = m0 + q * NGW; if (m < M) { const f32x4* xr = (const f32x4*)(x + (size_t)m * DM) + lane;
#pragma unroll
              for (int j = 0; j < 4; ++j) v[q][j] = xr[64 * j]; } }
#pragma unroll
          for (int q = 0; q < 4; ++q) { const int m = m0 + q * NGW; if (m < M) { float s = 0.f;
#pragma unroll
              for (int j = 0; j < 4; ++j) s += dot4(v[q][j]);
              const float rstd = rsq(wave_sum(s) * (1.f / DM) + EPS);
              u32x2* o8 = (u32x2*)(XN + (size_t)m * DM) + lane;
#pragma unroll
              for (int j = 0; j < 4; ++j) { const f32x4 y = v[q][j] * rstd * gv[j]; u32x2 o; o.x = pk2(y[0], y[1]); o.y = pk2(y[2], y[3]); o8[64 * j] = o; } } }
      } }
}

typedef f32x4 AccT[2][2][4][2];
#define EPI_ROWS for (int ai = 0; ai < 2; ++ai) _Pragma("unroll") for (int m = 0; m < 4; ({ if (m & 1) asm volatile("" ::: "memory"); }), ++m)
#define EPI_ROW(u) ((u).pm * 256 + ai * 128 + wr * 64 + m * 16 + fr)
#define EPI_FENCE() asm volatile("" ::: "memory")

struct EpiInProj {
    bf16_t *QA, *KA, *VA, *CQ, *CKV, *KR; float *ssq_cq, *ssq_ckv; const float *qn_gain, *kn_gain, *knr_gain, *rope_cs;
    __device__ __forceinline__ void operator()(const AccT& acc, const pg8::Unit& u, int wr, int wc, int fr, int fq) const {
        const int pn = u.pn;
        if (pn < 4) {
            const bool isq = pn < 2; const int head = (pn & 1) * 4 + wc; const float* gain = isq ? qn_gain : kn_gain; bf16_t* dst = isq ? QA : KA; const float sc = isq ? C2A : 1.0f;
            f32x4 g[2][2];
#pragma unroll
            for (int bj = 0; bj < 2; ++bj)
#pragma unroll
                for (int n = 0; n < 2; ++n) g[bj][n] = *(const f32x4*)(gain + 32 * bj + 8 * fq + 4 * n) * sc;
#pragma unroll
            EPI_ROWS { const size_t row = EPI_ROW(u);
                float ss = dot4(acc[ai][0][m][0]) + dot4(acc[ai][0][m][1]) + dot4(acc[ai][1][m][0]) + dot4(acc[ai][1][m][1]); ss = red_fq(ss);
                const float rn = rsq(ss * (1.f / 64.f) + EPS);
#pragma unroll
                for (int bj = 0; bj < 2; ++bj) st8(dst + row * 512 + head * 64 + 32 * bj + 8 * fq, acc[ai][bj][m][0] * rn * g[bj][0], acc[ai][bj][m][1] * rn * g[bj][1]); }
        } else if (pn < 6) {
#pragma unroll
            EPI_ROWS { const size_t row = EPI_ROW(u);
#pragma unroll
                for (int bj = 0; bj < 2; ++bj) st8(VA + row * 512 + (pn - 4) * 256 + 128 * bj + 32 * wc + 8 * fq, acc[ai][bj][m][0], acc[ai][bj][m][1]); }
        } else {
            const int s = 4 * (pn - 6) + wc;
            if (s < 10) {
                const bool iscq = s < 6; bf16_t* dst = iscq ? CQ : CKV; const int ld = iscq ? 384 : 256; const int col = iscq ? 64 * s : 64 * (s - 6);
                float* sq = iscq ? ssq_cq : ssq_ckv; const int sld = iscq ? 8 : 4, sidx = iscq ? s : s - 6;
#pragma unroll
                EPI_ROWS { const size_t row = EPI_ROW(u);
                    float ss = dot4(acc[ai][0][m][0]) + dot4(acc[ai][0][m][1]) + dot4(acc[ai][1][m][0]) + dot4(acc[ai][1][m][1]); ss = red_fq(ss);
                    if (fq == 0) sq[row * sld + sidx] = ss;
#pragma unroll
                    for (int bj = 0; bj < 2; ++bj) st8(dst + row * ld + col + 32 * bj + 8 * fq, acc[ai][bj][m][0], acc[ai][bj][m][1]); }
            } else if (s == 10) {
                const f32x4 g1 = *(const f32x4*)(knr_gain + 4 * fq), g2 = *(const f32x4*)(knr_gain + 16 + 4 * fq);
#pragma unroll
                EPI_ROWS { const size_t row = EPI_ROW(u);
                    f32x4 x1 = acc[ai][0][m][0], x2 = acc[ai][0][m][1];
                    float ss = red_fq(dot4(x1) + dot4(x2)); const float rn = rsq(ss * (1.f / 32.f) + EPS);
                    x1 = x1 * rn * g1; x2 = x2 * rn * g2;
                    const int pos = (int)(row & (SEQ - 1)); const f32x4 c = *(const f32x4*)(rope_cs + pos * 32 + 4 * fq), sn = *(const f32x4*)(rope_cs + pos * 32 + 16 + 4 * fq);
                    const f32x4 o1 = x1 * c - x2 * sn, o2 = x2 * c + x1 * sn;
                    u32x2 w1, w2; w1.x = pk2(o1[0], o1[1]); w1.y = pk2(o1[2], o1[3]); w2.x = pk2(o2[0], o2[1]); w2.y = pk2(o2[2], o2[3]);
                    *(u32x2*)(KR + row * 32 + 4 * fq) = w1; *(u32x2*)(KR + row * 32 + 16 + 4 * fq) = w2; }
            }
        }
    }
};
struct EpiRawSsq {
    bf16_t* O; int ld; float* ssq;
    __device__ __forceinline__ void operator()(const AccT& acc, const pg8::Unit& u, int wr, int wc, int fr, int fq) const {
#pragma unroll
        EPI_ROWS { const size_t row = EPI_ROW(u);
            float ss = dot4(acc[ai][0][m][0]) + dot4(acc[ai][0][m][1]) + dot4(acc[ai][1][m][0]) + dot4(acc[ai][1][m][1]); ss = red_fq(ss);
            if (fq == 0) ssq[row * 16 + 4 * u.pn + wc] = ss;
#pragma unroll
            for (int bj = 0; bj < 2; ++bj) st8(O + row * ld + 256 * u.pn + 128 * bj + 32 * wc + 8 * fq, acc[ai][bj][m][0], acc[ai][bj][m][1]); }
    }
};
struct EpiQup {
    bf16_t* QM; const float *ssq_cq, *nope_gain, *rope_gain, *rope_cs;
    __device__ __forceinline__ void operator()(const AccT& acc, const pg8::Unit& u, int wr, int wc, int fr, int fq) const {
        const int pn = u.pn;
        if (pn < 2) {
            const int head = 4 * pn + wc; f32x4 g[2][2];
#pragma unroll
            for (int bj = 0; bj < 2; ++bj)
#pragma unroll
                for (int n = 0; n < 2; ++n) g[bj][n] = *(const f32x4*)(nope_gain + 32 * bj + 8 * fq + 4 * n) * C2M;
#pragma unroll
            EPI_ROWS { const size_t row = EPI_ROW(u);
                const f32x4 s0 = *(const f32x4*)(ssq_cq + row * 8), s1 = *(const f32x4*)(ssq_cq + row * 8 + 4);
                const float rq = rsq(((s0[0] + s0[1]) + (s0[2] + s0[3]) + (s1[0] + s1[1])) * (1.f / 384.f) + EPS);
                f32x4 v[2][2]; float ss = 0.f;
#pragma unroll
                for (int bj = 0; bj < 2; ++bj)
#pragma unroll
                    for (int n = 0; n < 2; ++n) { v[bj][n] = acc[ai][bj][m][n] * rq; ss += dot4(v[bj][n]); }
                ss = red_fq(ss); const float rn = rsq(ss * (1.f / 64.f) + EPS);
#pragma unroll
                for (int bj = 0; bj < 2; ++bj) st8(QM + row * 768 + head * 96 + 32 * bj + 8 * fq, v[bj][0] * rn * g[bj][0], v[bj][1] * rn * g[bj][1]); }
        } else {
            const f32x4 g1 = *(const f32x4*)(rope_gain + 4 * fq) * C2M, g2 = *(const f32x4*)(rope_gain + 16 + 4 * fq) * C2M;
#pragma unroll
            EPI_ROWS { const size_t row = EPI_ROW(u);
                const f32x4 s0 = *(const f32x4*)(ssq_cq + row * 8), s1 = *(const f32x4*)(ssq_cq + row * 8 + 4);
                const float rq = rsq(((s0[0] + s0[1]) + (s0[2] + s0[3]) + (s1[0] + s1[1])) * (1.f / 384.f) + EPS);
                const int pos = (int)(row & (SEQ - 1)); const f32x4 c = *(const f32x4*)(rope_cs + pos * 32 + 4 * fq), sn = *(const f32x4*)(rope_cs + pos * 32 + 16 + 4 * fq);
#pragma unroll
                for (int bj = 0; bj < 2; ++bj) { const int head = 2 * wc + bj;
                    f32x4 x1 = acc[ai][bj][m][0] * rq, x2 = acc[ai][bj][m][1] * rq;
                    float ss = red_fq(dot4(x1) + dot4(x2)); const float rn = rsq(ss * (1.f / 32.f) + EPS);
                    x1 = x1 * rn * g1; x2 = x2 * rn * g2;
                    const f32x4 o1 = x1 * c - x2 * sn, o2 = x2 * c + x1 * sn;
                    u32x2 w1, w2; w1.x = pk2(o1[0], o1[1]); w1.y = pk2(o1[2], o1[3]); w2.x = pk2(o2[0], o2[1]); w2.y = pk2(o2[2], o2[3]);
                    *(u32x2*)(QM + row * 768 + head * 96 + 64 + 4 * fq) = w1; *(u32x2*)(QM + row * 768 + head * 96 + 80 + 4 * fq) = w2; } }
        }
    }
};
struct EpiKVup {
    bf16_t *KN, *VM; const float *ssq_ckv, *nope_gain;
    __device__ __forceinline__ void operator()(const AccT& acc, const pg8::Unit& u, int wr, int wc, int fr, int fq) const {
        const int pn = u.pn;
        if (pn < 2) {
            const int head = 4 * pn + wc; f32x4 g[2][2];
#pragma unroll
            for (int bj = 0; bj < 2; ++bj)
#pragma unroll
                for (int n = 0; n < 2; ++n) g[bj][n] = *(const f32x4*)(nope_gain + 32 * bj + 8 * fq + 4 * n);
#pragma unroll
            EPI_ROWS { const size_t row = EPI_ROW(u);
                const f32x4 s0 = *(const f32x4*)(ssq_ckv + row * 4);
                const float rk = rsq(((s0[0] + s0[1]) + (s0[2] + s0[3])) * (1.f / 256.f) + EPS);
                f32x4 v[2][2]; float ss = 0.f;
#pragma unroll
                for (int bj = 0; bj < 2; ++bj)
#pragma unroll
                    for (int n = 0; n < 2; ++n) { v[bj][n] = acc[ai][bj][m][n] * rk; ss += dot4(v[bj][n]); }
                ss = red_fq(ss); const float rn = rsq(ss * (1.f / 64.f) + EPS);
#pragma unroll
                for (int bj = 0; bj < 2; ++bj) st8(KN + row * 512 + head * 64 + 32 * bj + 8 * fq, v[bj][0] * rn * g[bj][0], v[bj][1] * rn * g[bj][1]); }
        } else {
#pragma unroll
            EPI_ROWS { const size_t row = EPI_ROW(u);
                const f32x4 s0 = *(const f32x4*)(ssq_ckv + row * 4);
                const float rk = rsq(((s0[0] + s0[1]) + (s0[2] + s0[3])) * (1.f / 256.f) + EPS);
#pragma unroll
                for (int bj = 0; bj < 2; ++bj) st8(VM + row * 512 + (pn - 2) * 256 + 128 * bj + 32 * wc + 8 * fq, acc[ai][bj][m][0] * rk, acc[ai][bj][m][1] * rk); }
        }
    }
};
struct EpiWout {
    const float* x; bf16_t* H1B; float* ssq;
    __device__ __forceinline__ void operator()(const AccT& acc, const pg8::Unit& u, int wr, int wc, int fr, int fq) const {
#pragma unroll
        EPI_ROWS { const size_t row = EPI_ROW(u); float ss = 0.f;
#pragma unroll
            for (int bj = 0; bj < 2; ++bj) { const size_t off = row * 1024 + 256 * u.pn + 128 * bj + 32 * wc + 8 * fq;
                const f32x4 h0 = acc[ai][bj][m][0] + *(const f32x4*)(x + off), h1 = acc[ai][bj][m][1] + *(const f32x4*)(x + off + 4);
                ss += dot4(h0) + dot4(h1); st8(H1B + off, h0, h1); }
            ss = red_fq(ss); if (fq == 0) ssq[row * 16 + 4 * u.pn + wc] = ss;
            }
    }
};
struct EpiRoute {
    const float *ssq_h1, *b_rg, *b_re; float* rstd2; i32x4* route; unsigned* cnt;
    __device__ __forceinline__ void operator()(const AccT& acc, const pg8::Unit& u, int wr, int wc, int fr, int fq) const {
        if (wc != 0) return;
        const f32x4 be0 = *(const f32x4*)(b_re + 8 * fq), be1 = *(const f32x4*)(b_re + 8 * fq + 4), bg = *(const f32x4*)b_rg;
#pragma unroll
        EPI_ROWS { const size_t row = EPI_ROW(u);
            float s = 0.f;
#pragma unroll
            for (int q = 0; q < 4; ++q) { const f32x4 t = *(const f32x4*)(ssq_h1 + row * 16 + 4 * q); s += (t[0] + t[1]) + (t[2] + t[3]); }
            const float r2 = rsq(s * (1.f / 1024.f) + EPS);
            if (fq == 0) rstd2[row] = r2;
            const f32x4 e0 = acc[ai][0][m][0] * r2 + be0, e1 = acc[ai][0][m][1] * r2 + be1;
            const f32x4 gloc = acc[ai][1][m][0] * r2 + bg;
            float gl[4];
#pragma unroll
            for (int j = 0; j < 4; ++j) gl[j] = __shfl(gloc[j], fr);
            int gi = 0; float gm = gl[0];
#pragma unroll
            for (int j = 1; j < 4; ++j) if (gl[j] > gm) { gm = gl[j]; gi = j; }
            float den = 0.f;
#pragma unroll
            for (int j = 0; j < 4; ++j) den += __expf(gl[j] - gm);
            const float gate = 1.0f / den;
            if (fq == gi) {
                float el[8] = {e0[0], e0[1], e0[2], e0[3], e1[0], e1[1], e1[2], e1[3]};
                int i1 = 0; float l1 = el[0];
#pragma unroll
                for (int j = 1; j < 8; ++j) if (el[j] > l1) { l1 = el[j]; i1 = j; }
                int i2 = -1; float l2 = -INFINITY;
#pragma unroll
                for (int j = 0; j < 8; ++j) if (j != i1 && el[j] > l2) { l2 = el[j]; i2 = j; }
                const float w1 = gate / (1.0f + __expf(l2 - l1)), w2 = gate - w1;
                const int ea = i1 < i2 ? i1 : i2, eb = i1 < i2 ? i2 : i1; const float wa = i1 < i2 ? w1 : w2, wb = i1 < i2 ? w2 : w1;
                const int pair = gi * 28 + (ea * (15 - ea)) / 2 + (eb - ea - 1);
                const unsigned pos = __hip_atomic_fetch_add(cnt + 16 * pair, 1u, RLX_AGENT);
                route[row] = (i32x4){pair, (int)pos, (int)__float_as_uint(wa), (int)__float_as_uint(wb)};
            }
            }
    }
};
struct EpiGateUp {
    const i32x4* rowrec; bf16_t* HDN;
    __device__ __forceinline__ void operator()(const AccT& acc, const pg8::Unit& u, int wr, int wc, int fr, int fq) const {
        const int slot = u.pn >> 2, cc = u.pn & 3;
#pragma unroll
        for (int ai = 0; ai < 2; ++ai) {
            i32x4 rec[4];
#pragma unroll
            for (int m = 0; m < 4; ++m) rec[m] = rowrec[EPI_ROW(u)];
#pragma unroll
            for (int m = 0; m < 4; ++m) { const size_t rr = EPI_ROW(u);
                const float r2 = __uint_as_float((unsigned)rec[m].y), w = __uint_as_float((unsigned)(slot ? rec[m].w : rec[m].z));
                f32x4 hd[2];
#pragma unroll
                for (int n = 0; n < 2; ++n)
#pragma unroll
                    for (int e = 0; e < 4; ++e) { const float g = acc[ai][0][m][n][e] * r2, up = acc[ai][1][m][n][e] * r2; hd[n][e] = g * frcp(1.0f + fexp2(-g * LOG2E)) * up * w; }
                st8(HDN + rr * 1024 + slot * 512 + cc * 128 + 32 * wc + 8 * fq, hd[0], hd[1]); }
            EPI_FENCE();
        }
    }
};
struct EpiDown {
    const i32x4* rowrec; const bf16_t* H1B; bf16_t* H2B;
    __device__ __forceinline__ void operator()(const AccT& acc, const pg8::Unit& u, int wr, int wc, int fr, int fq) const {
        int tk[2][4];
#pragma unroll
        for (int ai = 0; ai < 2; ++ai)
#pragma unroll
            for (int m = 0; m < 4; ++m) tk[ai][m] = ((const int*)rowrec)[(size_t)EPI_ROW(u) * 4];
#pragma unroll
        EPI_ROWS { const int tok = tk[ai][m];
            if (tok >= 0) {
#pragma unroll
                for (int bj = 0; bj < 2; ++bj) { const size_t off = (size_t)tok * 1024 + 256 * u.pn + 128 * bj + 32 * wc + 8 * fq; f32x4 a, b; ld8(H1B + off, a, b);
                    st8(H2B + off, a + acc[ai][bj][m][0], b + acc[ai][bj][m][1]); } }
            }
    }
};
struct EpiFinal {
    const bf16_t *H2B, *E; const float *ssq_e, *b_pg, *gain; float* out;
    __device__ __forceinline__ void operator()(const AccT& acc, const pg8::Unit& u, int wr, int wc, int fr, int fq) const {
#pragma unroll
        EPI_ROWS { const size_t row = EPI_ROW(u);
            float s = 0.f;
#pragma unroll
            for (int q = 0; q < 4; ++q) { const f32x4 t = *(const f32x4*)(ssq_e + row * 16 + 4 * q); s += (t[0] + t[1]) + (t[2] + t[3]); }
            const float re = rsq(s * (1.f / 1024.f) + EPS);
#pragma unroll
            for (int bj = 0; bj < 2; ++bj) { const int col = 256 * u.pn + 128 * bj + 32 * wc + 8 * fq; const size_t off = row * 1024 + col;
                f32x4 h0, h1, e0, e1; ld8(H2B + off, h0, h1); ld8(E + off, e0, e1);
                const f32x4 z0 = acc[ai][bj][m][0] + *(const f32x4*)(b_pg + col), z1 = acc[ai][bj][m][1] + *(const f32x4*)(b_pg + col + 4);
                const f32x4 g0 = *(const f32x4*)(gain + col) * re, g1 = *(const f32x4*)(gain + col + 4) * re;
                f32x4 o0, o1;
#pragma unroll
                for (int e = 0; e < 4; ++e) { o0[e] = h0[e] + frcp(1.0f + fexp2(-z0[e] * LOG2E)) * e0[e] * g0[e]; o1[e] = h1[e] + frcp(1.0f + fexp2(-z1[e] * LOG2E)) * e1[e] * g1[e]; }
                *(f32x4*)(out + off) = o0; *(f32x4*)(out + off + 4) = o1; }
            }
    }
};

struct MoeSchedUp {
    const LAS int* tinfo; int T, G, c; const char* A; const char* W; const unsigned* rowoff;
    __device__ __forceinline__ bool next(int i, pg8::Unit& u) const { const int nun = T * 8, L = i * G + c; if (L >= nun) return false; const int w = pg8::xcd_remap(L, nun); u.pm = w >> 3; u.pn = w & 7; return true; }
    __device__ __forceinline__ const char* a_base(const pg8::Unit&) const { return A; }
    __device__ __forceinline__ const char* b_base(const pg8::Unit& u) const { const int ti = tinfo[u.pm]; const int e = (u.pn < 4) ? (ti >> 8) : (ti & 255); return W + (size_t)e * (1024 * 1024 * 2) + (size_t)(u.pn & 3) * (256 * 1024 * 2); }
    __device__ __forceinline__ const char* b_base2(const pg8::Unit& u) const { return b_base(u); }
    __device__ __forceinline__ const unsigned* a_rowptr(const pg8::Unit& u, int r) const { return rowoff + u.pm * 256 + r; }
};
struct MoeSchedDown {
    const LAS int* tinfo; int T, G, c; const char* A; const char* W;
    __device__ __forceinline__ bool next(int i, pg8::Unit& u) const { const int nun = T * 4, L = i * G + c; if (L >= nun) return false; const int w = pg8::xcd_remap(L, nun); u.pm = w >> 2; u.pn = w & 3; return true; }
    __device__ __forceinline__ const char* a_base(const pg8::Unit& u) const { return A + (size_t)u.pm * (256 * 1024 * 2); }
    __device__ __forceinline__ const char* b_base(const pg8::Unit& u) const { const int e = tinfo[u.pm] >> 8; return W + (size_t)e * (1024 * 512 * 2) + (size_t)u.pn * (256 * 512 * 2); }
    __device__ __forceinline__ const char* b_base2(const pg8::Unit& u) const { const int e = tinfo[u.pm] & 255; return W + (size_t)e * (1024 * 512 * 2) + (size_t)u.pn * (256 * 512 * 2); }
    __device__ __forceinline__ const unsigned* a_rowptr(const pg8::Unit&, int) const { return nullptr; }
};

#ifndef MK_REPEAT
#define MK_REPEAT 0
#endif
#define WSP(T, off) ((T*)(F.ws + (off)))
__device__ __forceinline__ void phase1(Frame& F, const Args& args) {
    {
        pg8::DenseSched S; S.init(WSP(const bf16_t, WS_XN), WSP(const bf16_t, WS_WIN), M, INC_PAD, 1024, F.G, (int)blockIdx.x);
        EpiInProj E{WSP(bf16_t, WS_QA), WSP(bf16_t, WS_KA), WSP(bf16_t, WS_VA), WSP(bf16_t, WS_CQ), WSP(bf16_t, WS_CKV), WSP(bf16_t, WS_KROPE),
                    WSP(float, WS_SSQCQ), WSP(float, WS_SSQCKV), args.in[I_QNA], args.in[I_KNA], args.in[I_KNR], WSP(const float, WS_ROPE)};
        pg8::gemm_phase<EpiInProj, pg8::DenseSched, false, false>(F.lds, 1024, S, E);
    }
    {
        pg8::DenseSched S; S.init(WSP(const bf16_t, WS_PB), WSP(const bf16_t, WS_WPP), M, 1024, 256, F.G, (int)blockIdx.x);
        EpiRawSsq E{WSP(bf16_t, WS_E), 1024, WSP(float, WS_SSQE)};
        pg8::gemm_phase<EpiRawSsq, pg8::DenseSched, false, false>(F.lds, 256, S, E);
    }
}
__device__ __forceinline__ void phase2(Frame& F, const Args& args) {
    {
        pg8::DenseSched S; S.init(WSP(const bf16_t, WS_CQ), WSP(const bf16_t, WS_WQUP), M, 768, 384, F.G, (int)blockIdx.x);
        EpiQup E{WSP(bf16_t, WS_QM), WSP(const float, WS_SSQCQ), args.in[I_QNN], args.in[I_QNR], WSP(const float, WS_ROPE)};
        pg8::gemm_phase<EpiQup, pg8::DenseSched, false, false>(F.lds, 384, S, E);
    }
    {
        pg8::DenseSched S; S.init(WSP(const bf16_t, WS_CKV), WSP(const bf16_t, WS_WKVUP), M, 1024, 256, F.G, (int)blockIdx.x);
        EpiKVup E{WSP(bf16_t, WS_KN), WSP(bf16_t, WS_VM), WSP(const float, WS_SSQCKV), args.in[I_KNN]};
        pg8::gemm_phase<EpiKVup, pg8::DenseSched, false, false>(F.lds, 256, S, E);
    }
}
__device__ __forceinline__ void phase3(Frame& F, const Args& args) {
    LAS char* shm = (LAS char*)F.lds;
    LAS float* tbl = (LAS float*)(F.lds + TB_OFF);
    for (int bh = F.vcu; bh < BATCH * 8; bh += F.G) {
        const int b = bh >> 3, h = bh & 7;
        for (int i = F.tid; i < 960; i += 512) tbl[i] = WSP(const float, WS_TBG)[(i / 320) * 2560 + h * 320 + (i % 320)];
        __syncthreads();
        for (int qb = 0; qb < (((MK_REPEAT >> 10) & 1) ? 16 : 8); ++qb)
            att::mla_unit(b, h, qb & 7, WSP(const bf16_t, WS_QM), WSP(const bf16_t, WS_KN), WSP(const bf16_t, WS_KROPE), WSP(const bf16_t, WS_VM), WSP(bf16_t, WS_MIX), shm);
        for (int uidx2 = 0; uidx2 < (((MK_REPEAT >> 11) & 1) ? 48 : 24); ++uidx2) {
            const int uidx = uidx2 % 24; const int br = 2 - (uidx >> 3), uu = uidx & 7;
            if (uidx == 16) { VM_WAIT(); __syncthreads(); __builtin_amdgcn_fence(__ATOMIC_ACQUIRE, "agent"); VM_WAIT(); __syncthreads(); }
            att::dil_unit(b, h, br, uu, WSP(const bf16_t, WS_QA), WSP(const bf16_t, WS_KA), WSP(const bf16_t, WS_VA), WSP(bf16_t, WS_O2), WSP(bf16_t, WS_O3),
                          WSP(float, WS_LSE2), WSP(float, WS_LSE3), WSP(bf16_t, WS_MIX), shm, tbl);
        }
        __syncthreads();
    }
}
__device__ __forceinline__ void phase4(Frame& F, const Args& args) {
    pg8::DenseSched S; S.init(WSP(const bf16_t, WS_MIX), WSP(const bf16_t, WS_WOUT), M, 1024, 1024, F.G, (int)blockIdx.x);
    EpiWout E{args.in[I_X], WSP(bf16_t, WS_H1B), WSP(float, WS_SSQH1)};
    pg8::gemm_phase<EpiWout, pg8::DenseSched, false, false>(F.lds, 1024, S, E);
}
__device__ __forceinline__ void phase5(Frame& F, const Args& args) {
    pg8::DenseSched S; S.init(WSP(const bf16_t, WS_H1B), WSP(const bf16_t, WS_WR), M, 256, 1024, F.G, (int)blockIdx.x);
    EpiRoute E{WSP(const float, WS_SSQH1), args.in[I_BRG], args.in[I_BRE], WSP(float, WS_RSTD2), WSP(i32x4, WS_ROUTE), F.ctl + CW_CNT};
    pg8::gemm_phase<EpiRoute, pg8::DenseSched, false, false>(F.lds, 1024, S, E);
}
__device__ __forceinline__ void phase6(Frame& F, const Args& args) {
    LAS int* mo_cnt = (LAS int*)(F.lds + MOE_OFF); LAS int* mo_start = mo_cnt + 128; LAS int* tinfo = mo_cnt + 256;
    if (F.tid < NPAIR) mo_cnt[F.tid] = (int)__hip_atomic_load(F.ctl + CW_CNT + 16 * F.tid, RLX_AGENT);
    __syncthreads();
    if (F.tid == 0) { int acc = 0; for (int p = 0; p < NPAIR; ++p) { mo_start[p] = acc; acc += (mo_cnt[p] + 255) >> 8; } mo_start[NPAIR] = acc; }
    __syncthreads();
    if (F.tid < NPAIR) { const int p = F.tid, g = p / 28, q = p % 28; int ea = 0; while (ea < 6 && ((ea + 1) * (14 - ea)) / 2 <= q) ++ea; const int eb = ea + 1 + (q - (ea * (15 - ea)) / 2);
        const int info = ((8 * g + ea) << 8) | (8 * g + eb); const int t0 = mo_start[p], t1 = mo_start[p + 1]; for (int t = t0; t < t1; ++t) tinfo[t] = info; }
    __syncthreads();
    const i32x4* route = WSP(const i32x4, WS_ROUTE); i32x4* rowrec = WSP(i32x4, WS_ROWREC); unsigned* rowoff = WSP(unsigned, WS_ROWOFF); const float* rstd2 = WSP(const float, WS_RSTD2);
    for (int tok = F.vcu * 512 + F.tid; tok < M; tok += F.G * 512) { const i32x4 r = route[tok]; const int row = (mo_start[r.x] << 8) + r.y;
        rowrec[row] = (i32x4){tok, (int)__float_as_uint(rstd2[tok]), r.z, r.w}; rowoff[row] = (unsigned)tok * 2048u; }
}
__device__ __forceinline__ void phase7(Frame& F, const Args& args) {
    const LAS int* mo_start = (const LAS int*)(F.lds + MOE_OFF) + 128; const LAS int* tinfo = (const LAS int*)(F.lds + MOE_OFF) + 256;
    MoeSchedUp S{tinfo, mo_start[NPAIR], F.G, (int)blockIdx.x, WSP(const char, WS_H1B), WSP(const char, WS_WGU), WSP(const unsigned, WS_ROWOFF)};
    EpiGateUp E{WSP(const i32x4, WS_ROWREC), WSP(bf16_t, WS_HDN)};
    pg8::gemm_phase<EpiGateUp, MoeSchedUp, true, false>(F.lds, 1024, S, E);
}
__device__ __forceinline__ void phase8(Frame& F, const Args& args) {
    const LAS int* mo_start = (const LAS int*)(F.lds + MOE_OFF) + 128; const LAS int* tinfo = (const LAS int*)(F.lds + MOE_OFF) + 256;
    MoeSchedDown S{tinfo, mo_start[NPAIR], F.G, (int)blockIdx.x, WSP(const char, WS_HDN), WSP(const char, WS_WD)};
    EpiDown E{WSP(const i32x4, WS_ROWREC), WSP(const bf16_t, WS_H1B), WSP(bf16_t, WS_H2B)};
    pg8::gemm_phase<EpiDown, MoeSchedDown, false, true>(F.lds, 1024, S, E);
}
__device__ __forceinline__ void phase9(Frame& F, const Args& args) {
    pg8::DenseSched S; S.init(WSP(const bf16_t, WS_H2B), WSP(const bf16_t, WS_WPG), M, 1024, 1024, F.G, (int)blockIdx.x);
    EpiFinal E{WSP(const bf16_t, WS_H2B), WSP(const bf16_t, WS_E), WSP(const float, WS_SSQE), args.in[I_BPG], args.in[I_PNG], args.out};
    pg8::gemm_phase<EpiFinal, pg8::DenseSched, false, false>(F.lds, 1024, S, E);
}

__global__ void __launch_bounds__(512, 2) hybrid_fwd(Args args) {
    extern __shared__ __attribute__((aligned(16))) unsigned char lds_raw[];
    Frame F;
    F.lds = (LAS unsigned char*)lds_raw;
    F.MISC = (volatile LAS unsigned*)(F.lds + MISC_OFF);
    F.tid = threadIdx.x; F.lane = F.tid & 63; F.wave = __builtin_amdgcn_readfirstlane(F.tid >> 6);
    F.G = gridDim.x; { const int bx = blockIdx.x; F.vcu = (F.G % 8 == 0) ? (bx % 8) * (F.G / 8) + bx / 8 : bx; }
    F.ws = args.ws; F.ctl = (unsigned*)(args.ws + WS_CTL);
    for (int u = F.tid; u < 128; u += 512) ((LAS unsigned*)(F.lds + MISC_OFF))[u] = 0u;
    __syncthreads();
    XcdBarrier bar = xcd_barrier_post(F.ctl + CW_BAR, F.MISC + 8);
#define RUN(k, call) do { call; if ((MK_REPEAT >> (k)) & 1) { xcd_barrier(bar); call; } } while (0)
    RUN(0, p0_prologue(F, args)); xcd_barrier(bar);
    RUN(1, phase1(F, args)); xcd_barrier(bar);
    RUN(2, phase2(F, args)); xcd_barrier(bar);
    RUN(3, phase3(F, args)); xcd_barrier(bar);
    RUN(4, phase4(F, args)); xcd_barrier(bar);
    phase5(F, args); xcd_barrier(bar);
    phase6(F, args); xcd_barrier(bar);
    RUN(7, phase7(F, args)); xcd_barrier(bar);
    RUN(8, phase8(F, args)); xcd_barrier(bar);
    RUN(9, phase9(F, args));
#undef RUN
}

extern "C" void kernel_launch(void* const* d_in, const int* in_sizes, int n_in, void* d_out, int out_size, void* d_ws, size_t ws_size, hipStream_t stream) {
    static int grid = 0;
    if (grid == 0) {
        if (n_in != 28 || in_sizes[0] != M * DM || out_size != M * DM || ws_size < WS_END) { fprintf(stderr, "kernel_launch: unexpected problem (n_in %d, in0 %d, out %d, ws %zu); nothing launched\n", n_in, n_in > 0 ? in_sizes[0] : -1, out_size, ws_size); grid = -1; return; }
        int dev = 0, cus = 0, per_cu = 0;
        if (hipGetDevice(&dev) != hipSuccess || hipDeviceGetAttribute(&cus, hipDeviceAttributeMultiprocessorCount, dev) != hipSuccess) { grid = -1; return; }
        if (hipFuncSetAttribute((const void*)hybrid_fwd, hipFuncAttributeMaxDynamicSharedMemorySize, LDS_BYTES) != hipSuccess) { fprintf(stderr, "kernel_launch: hipFuncSetAttribute failed\n"); grid = -1; return; }
        if (hipOccupancyMaxActiveBlocksPerMultiprocessor(&per_cu, (const void*)hybrid_fwd, 512, LDS_BYTES) != hipSuccess || per_cu < 1) { fprintf(stderr, "kernel_launch: occupancy query reports %d workgroups per CU\n", per_cu); }
        (void)hipGetLastError();
        grid = cus;
    }
    if (grid < 0) return;
    if (hipMemsetAsync((char*)d_ws + WS_CTL, 0, CTL_ZERO_BYTES, stream) != hipSuccess) return;
    Args a{};
    for (int i = 0; i < 28; ++i) a.in[i] = (const float*)d_in[i];
    a.out = (float*)d_out; a.ws = (unsigned char*)d_ws;
    hipLaunchKernelGGL(hybrid_fwd, dim3(grid), dim3(512), LDS_BYTES, stream, a);
}
```

```cpp
#ifndef MK_REPEAT
#define MK_REPEAT 0
#endif
#ifndef WGM_INPROJ
#define WGM_INPROJ 8
#endif
#include <hip/hip_runtime.h>
#include <cstdio>
#include <cstdint>

#define LAS __attribute__((address_space(3)))
#define GAS __attribute__((address_space(1)))
typedef unsigned short bf16_t;
typedef short bf16x8 __attribute__((ext_vector_type(8)));
typedef short s16x4 __attribute__((ext_vector_type(4)));
typedef short v4i16_t __attribute__((ext_vector_type(4)));
typedef float f32x4 __attribute__((ext_vector_type(4)));
typedef float f32x2 __attribute__((ext_vector_type(2)));
typedef float f32x16 __attribute__((ext_vector_type(16)));
typedef unsigned u32x4 __attribute__((ext_vector_type(4)));
typedef unsigned u32x2 __attribute__((ext_vector_type(2)));
typedef int i32x4 __attribute__((ext_vector_type(4)));
typedef __bf16 bf16x2_t __attribute__((ext_vector_type(2)));

constexpr int BATCH = 32, SEQ = 2048, DM = 1024, M = BATCH * SEQ;
constexpr int PLE = 256;
constexpr int AW = 512, QLORA = 384, KVLORA = 256, ROPE = 32;
constexpr int INC = 2208, INC_PAD = 2304;
constexpr int NEXP = 32, EFF = 512, NPAIR = 112;
constexpr int MAXT = 368;
constexpr int MAXTE = 544;
constexpr float EPS = 1e-6f;
constexpr float LOG2E = 1.4426950408889634f;
constexpr float C2A = 0.125f * LOG2E;
constexpr float C2M = 0.10206207261596575f * LOG2E;

constexpr size_t MiB = 1u << 20;
constexpr size_t WS_CTL = 0, CTL_ZERO_BYTES = 1 * MiB;
constexpr size_t WS_TBG = 1 * MiB;
constexpr size_t WS_ROPE = 1 * MiB + 65536;
constexpr size_t WS_ROWREC = 2 * MiB;
constexpr size_t WS_ROWOFF = 3 * MiB + 524288;
constexpr size_t WS_ROUTE = 4 * MiB;
constexpr size_t WS_RSTD2 = 5 * MiB;
constexpr size_t WS_RSTD1 = 5 * MiB + 524288;
constexpr size_t WS_SSQCQ = 6 * MiB;
constexpr size_t WS_SSQCKV = 8 * MiB;
constexpr size_t WS_SSQH1 = 9 * MiB;
constexpr size_t WS_SSQE = 13 * MiB;
constexpr size_t WS_LSE2 = 17 * MiB;
constexpr size_t WS_LSE3 = 19 * MiB;
constexpr size_t WS_ROWREC2 = 13 * MiB + 524288;
constexpr size_t WS_ROWOFF2 = 16 * MiB;
constexpr size_t WS_KROPE = 21 * MiB;
constexpr size_t WS_WIN = 25 * MiB;
constexpr size_t WS_WQUP = 30 * MiB;
constexpr size_t WS_WKVUP = 31 * MiB;
constexpr size_t WS_WR = 32 * MiB;
constexpr size_t WS_WOUT = 33 * MiB;
constexpr size_t WS_WPP = 35 * MiB;
constexpr size_t WS_WPG = 36 * MiB;
constexpr size_t WS_WGU = 40 * MiB;
constexpr size_t WS_WD = 104 * MiB;
constexpr size_t WS_XB = 136 * MiB;
constexpr size_t WS_QA = 264 * MiB, WS_KA = 328 * MiB, WS_VA = 392 * MiB;
constexpr size_t WS_HDN = 264 * MiB;
constexpr size_t WS_QM = 456 * MiB;
constexpr size_t WS_KN = 552 * MiB, WS_VM = 616 * MiB;
constexpr size_t WS_H2B = 456 * MiB;
constexpr size_t PB_IN_OUT = 128 * MiB;
constexpr size_t WS_CQ = 712 * MiB;
constexpr size_t WS_CKV = 760 * MiB;
constexpr size_t WS_O2 = 680 * MiB, WS_O3 = 744 * MiB;
constexpr size_t WS_H1B = 680 * MiB;
constexpr size_t WS_E = 808 * MiB;
constexpr size_t WS_DUMMY = 936 * MiB;
constexpr size_t WS_END = 937 * MiB;
constexpr int CW_BAR = 4096;
constexpr int CW_CNT = 16384;

constexpr int RING_BYTES = 131072;
constexpr int ATT_WSF = 102400;
constexpr int ATT_OST = 106496;
constexpr int MISC_OFF = 139264;
constexpr int TB_OFF = MISC_OFF + 512;
constexpr int MOE_OFF = TB_OFF + 3840;
constexpr int LDS_BYTES = 151552;
constexpr int MOE_E_OFF = MOE_OFF + 128 * 4 * 2 + MAXT * 4;
constexpr int MOE_O_OFF = MOE_E_OFF + 96 * 4 + MAXTE * 4;
static_assert(MOE_O_OFF + 256 * 4 <= LDS_BYTES && TB_OFF + 8192 <= LDS_BYTES, "LDS map");

#define LDS_WAIT() asm volatile("s_waitcnt lgkmcnt(0)" ::: "memory")
#define VM_WAIT() asm volatile("s_waitcnt vmcnt(0)" ::: "memory")
#define RLX_AGENT __ATOMIC_RELAXED, __HIP_MEMORY_SCOPE_AGENT

__device__ __forceinline__ unsigned pk2(float lo, float hi) { f32x2 v = {lo, hi}; bf16x2_t b = __builtin_convertvector(v, bf16x2_t); return __builtin_bit_cast(unsigned, b); }
__device__ __forceinline__ float bflo(unsigned u) { return __uint_as_float(u << 16); }
__device__ __forceinline__ float bfhi(unsigned u) { return __uint_as_float(u & 0xffff0000u); }
__device__ __forceinline__ void st8(bf16_t* p, f32x4 a, f32x4 b) { u32x4 w; w.x = pk2(a[0], a[1]); w.y = pk2(a[2], a[3]); w.z = pk2(b[0], b[1]); w.w = pk2(b[2], b[3]); *(u32x4*)p = w; }
__device__ __forceinline__ void ld8(const bf16_t* p, f32x4& a, f32x4& b) { const u32x4 w = *(const u32x4*)p; a = (f32x4){bflo(w.x), bfhi(w.x), bflo(w.y), bfhi(w.y)}; b = (f32x4){bflo(w.z), bfhi(w.z), bflo(w.w), bfhi(w.w)}; }
__device__ __forceinline__ float dot4(f32x4 a) { return (a[0] * a[0] + a[1] * a[1]) + (a[2] * a[2] + a[3] * a[3]); }
__device__ __forceinline__ float red_fq(float s) { s += __shfl_xor(s, 16); s += __shfl_xor(s, 32); return s; }
__device__ __forceinline__ float rsq(float x) { return __builtin_amdgcn_rsqf(x); }
__device__ __forceinline__ float fexp2(float x) { return __builtin_amdgcn_exp2f(x); }
__device__ __forceinline__ float frcp(float x) { return __builtin_amdgcn_rcpf(x); }

namespace pg8 {
constexpr int BM = 256, BK = 64, HALF = 128, HTB = HALF * BK * 2, STAGE_BYTES = 8 * HTB, NXCD = 8, WGM = 8;
__host__ __device__ __forceinline__ int lds_byte(int r, int c) { const int st = (r >> 4) * 2 + (c >> 5), rr = r & 15, cc = c & 31, ob = rr * 64 + cc * 2; return st * 1024 + (ob ^ (((ob >> 9) & 1) << 5)); }
__host__ __device__ __forceinline__ void stage_rc(int b, int& R, int& C) { const int st = b / 1024, sb = b % 1024, swz = sb ^ (((sb >> 9) & 1) << 5); R = (st >> 1) * 16 + swz / 64; C = (st & 1) * 32 + (swz % 64) / 2; }
__host__ __device__ __forceinline__ int perm32(int rho) { const int n = rho >> 4, i = rho & 15; return 8 * (i >> 2) + 4 * n + (i & 3); }
struct Unit { int pm, pn; };

__device__ __forceinline__ int xcd_remap(int L, int nwg) { const int q = nwg / NXCD, r = nwg % NXCD, xcd = L % NXCD, off = L / NXCD; return (xcd < r ? xcd * (q + 1) : r * (q + 1) + (xcd - r) * q) + off; }
struct DenseSched {
    const char* A; const char* Bt; const float* rs = nullptr; int K, nM, nN, nwg, G, c, wgm;
    __device__ __forceinline__ void init(const bf16_t* A_, const bf16_t* Bt_, int Mr, int N, int K_, int G_, int c_, int wgm_ = WGM) { A = (const char*)A_; Bt = (const char*)Bt_; K = K_; nM = Mr / BM; nN = N / BM; nwg = nM * nN; G = G_; c = c_; wgm = wgm_; }
    __device__ __forceinline__ bool next(int i, Unit& u) const {
        const int L = i * G + c; if (L >= nwg) return false;
        const int wgid = xcd_remap(L, nwg);
        const int nig = wgm * nN, gid = wgid / nig, fm = gid * wgm, gsz = (nM - fm) < wgm ? (nM - fm) : wgm;
        u.pm = fm + ((wgid % nig) % gsz); u.pn = (wgid % nig) / gsz; return true;
    }
    __device__ __forceinline__ const char* a_base(const Unit& u) const { return A + (size_t)u.pm * ((size_t)BM * K * 2); }
    __device__ __forceinline__ const char* b_base(const Unit& u) const { return Bt + (size_t)u.pn * ((size_t)BM * K * 2); }
    __device__ __forceinline__ const char* b_base2(const Unit& u) const { return b_base(u); }
    __device__ __forceinline__ const unsigned* a_rowptr(const Unit&, int) const { return nullptr; }
};
__device__ __forceinline__ unsigned gld_untracked(const unsigned* p) { unsigned r; asm volatile("global_load_dword %0, %1, off" : "=&v"(r) : "v"(p) : "memory"); return r; }

template <class Epi, class Sched, bool GATHER, bool BSPLIT, bool PRESCALE = false>
__device__ __forceinline__ void gemm_phase(LAS unsigned char* lds, const int K_, const Sched& S, const Epi& E) {
    int K = K_; asm volatile("" : "+s"(K));
    int tid_ = threadIdx.x; asm volatile("" : "+v"(tid_));
    const int tid = tid_, wid = __builtin_amdgcn_readfirstlane(tid >> 6), lane = tid & 63, wr = wid >> 2, wc = wid & 3, fr = lane & 15, fq = lane >> 4;
    const int nt = K / BK, nth = BSPLIT ? nt / 2 : nt, ldb = BSPLIT ? K / 2 : K;
    int Rr[2], Cc[2]; unsigned voffB[2];
#pragma unroll
    for (int i = 0; i < 2; ++i) { stage_rc(tid * 16 + i * 8192, Rr[i], Cc[i]); const int Rb = (Rr[i] & ~31) + perm32(Rr[i] & 31); voffB[i] = (unsigned)(Rb * ldb + Cc[i]) * 2u; }
    const size_t kstep = (size_t)(BK * 2);
    const size_t hstepB = (size_t)HALF * ldb * 2;
    const unsigned hstepA = (unsigned)HALF * (unsigned)K * 2u;
    const unsigned ldsw = (unsigned)wid * 1024u;
    const int aoff = lds_byte(wr * 64 + fr, fq * 8), boff = lds_byte(wc * 32 + fr, fq * 8);
#define PG8_SA(b, h) (((b) * 2 + (h)) * HTB)
#define PG8_SB(b, h) ((4 + (b) * 2 + (h)) * HTB)
#define PG8_STAGE(bufoff, gbase, o0, o1) do { \
        __builtin_amdgcn_global_load_lds((const unsigned*)((const char*)(gbase) + (o0)), (LAS unsigned*)(lds + (bufoff) + ldsw), 16, 0, 0); \
        __builtin_amdgcn_global_load_lds((const unsigned*)((const char*)(gbase) + (o1)), (LAS unsigned*)(lds + (bufoff) + ldsw + 8192), 16, 0, 0); } while (0)
#define PG8_STAGE_B(bufoff, gbase) PG8_STAGE(bufoff, gbase, voffB[0], voffB[1])
#define PG8_LDA(dst, b, h) do { _Pragma("unroll") for (int m = 0; m < 4; ++m) _Pragma("unroll") for (int k = 0; k < 2; ++k) dst[m][k] = *(const LAS bf16x8*)(lds + PG8_SA(b, h) + aoff + m * 2048 + k * 1024); } while (0)
#define PG8_LDB(dst, b, h) do { _Pragma("unroll") for (int n = 0; n < 2; ++n) _Pragma("unroll") for (int k = 0; k < 2; ++k) dst[n][k] = *(const LAS bf16x8*)(lds + PG8_SB(b, h) + boff + n * 2048 + k * 1024); } while (0)
#define PG8_MMA(ai, bj, At, Bt) do { __builtin_amdgcn_s_setprio(1); _Pragma("unroll") for (int m = 0; m < 4; ++m) _Pragma("unroll") for (int n = 0; n < 2; ++n) _Pragma("unroll") for (int k = 0; k < 2; ++k) \
        acc[ai][bj][m][n] = __builtin_amdgcn_mfma_f32_16x16x32_bf16(Bt[n][k], At[m][k], acc[ai][bj][m][n], 0, 0, 0); __builtin_amdgcn_s_setprio(0); } while (0)
#define PG8_WAIT_V(n) asm volatile("s_waitcnt vmcnt(" #n ")" ::: "memory")
#define PG8_WAIT_L(n) asm volatile("s_waitcnt lgkmcnt(" #n ")" ::: "memory")
#define PG8_BAR __builtin_amdgcn_s_barrier()
#define PG8_SCHED __builtin_amdgcn_sched_barrier(0)
    Unit cur, nxt; int ui = 0;
    if (!S.next(0, cur)) return;
    f32x4 acc[2][2][4][2];
#pragma unroll
    for (int a = 0; a < 2; ++a)
#pragma unroll
        for (int b = 0; b < 2; ++b)
#pragma unroll
            for (int m = 0; m < 4; ++m)
#pragma unroll
                for (int n = 0; n < 2; ++n) acc[a][b][m][n] = (f32x4){0.f, 0.f, 0.f, 0.f};
    bf16x8 At[4][2], B0[2][2], B1[2][2];
    unsigned oC[2][2], oN[2][2], rawN[2][2];
    if (GATHER) {
#pragma unroll
        for (int h = 0; h < 2; ++h)
#pragma unroll
            for (int i = 0; i < 2; ++i) rawN[h][i] = gld_untracked(S.a_rowptr(cur, Rr[i] + HALF * h));
        asm volatile("s_waitcnt vmcnt(0)" ::: "memory");
#pragma unroll
        for (int h = 0; h < 2; ++h)
#pragma unroll
            for (int i = 0; i < 2; ++i) { asm volatile("" : "+v"(rawN[h][i])); oC[h][i] = rawN[h][i] + (unsigned)Cc[i] * 2u; oN[h][i] = oC[h][i]; }
    } else {
#pragma unroll
        for (int h = 0; h < 2; ++h)
#pragma unroll
            for (int i = 0; i < 2; ++i) { oC[h][i] = (unsigned)(Rr[i] * K + Cc[i]) * 2u + (unsigned)h * hstepA; oN[h][i] = oC[h][i]; rawN[h][i] = 0u; }
    }
    const char* cA = S.a_base(cur); const char* cB = S.b_base(cur); const char* cB2 = S.b_base2(cur);
    PG8_STAGE_B(PG8_SB(0, 0), cB); PG8_STAGE_B(PG8_SB(0, 1), cB + hstepB); PG8_STAGE(PG8_SA(0, 0), cA, oC[0][0], oC[0][1]); PG8_STAGE(PG8_SA(0, 1), cA, oC[1][0], oC[1][1]);
    if (wr == 1) PG8_BAR;
    PG8_WAIT_V(2); PG8_BAR;
    PG8_STAGE_B(PG8_SB(1, 0), cB + kstep); PG8_STAGE(PG8_SA(1, 0), cA + kstep, oC[0][0], oC[0][1]); PG8_STAGE_B(PG8_SB(1, 1), cB + hstepB + kstep);
    PG8_WAIT_V(6); PG8_BAR;
    for (;;) {
        const bool has_next = S.next(ui + 1, nxt);
        const char* nA = has_next ? S.a_base(nxt) : cA; const char* nB = has_next ? S.b_base(nxt) : cB;
        if (GATHER) {
            if (has_next) {
#pragma unroll
                for (int h = 0; h < 2; ++h)
#pragma unroll
                    for (int i = 0; i < 2; ++i) rawN[h][i] = gld_untracked(S.a_rowptr(nxt, Rr[i] + HALF * h));
            }
        }
        for (int t = 0; t < nt; t += 2) {
            const bool last = (t == nt - 2);
            const char* a1 = cA + (size_t)(t + 1) * kstep;
            const char* a2 = last ? nA : cA + (size_t)(t + 2) * kstep;
            const char* b2 = last ? nB : ((BSPLIT && t + 2 >= nth) ? cB2 + (size_t)(t + 2 - nth) * kstep : cB + (size_t)(t + 2) * kstep);
            const char* a3 = a2 + kstep; const char* b3 = b2 + kstep;
            unsigned o2[2][2];
            if (GATHER && last && has_next) {
#pragma unroll
                for (int h = 0; h < 2; ++h)
#pragma unroll
                    for (int i = 0; i < 2; ++i) { asm volatile("" : "+v"(rawN[h][i])); oN[h][i] = rawN[h][i] + (unsigned)Cc[i] * 2u; }
            }
#pragma unroll
            for (int h = 0; h < 2; ++h)
#pragma unroll
                for (int i = 0; i < 2; ++i) o2[h][i] = (GATHER && last && has_next) ? oN[h][i] : oC[h][i];
            PG8_LDB(B0, 0, 0); PG8_LDB(B1, 0, 1); PG8_SCHED; PG8_LDA(At, 0, 0); PG8_STAGE(PG8_SA(1, 1), a1, oC[1][0], oC[1][1]);
            PG8_WAIT_V(8); PG8_WAIT_L(0); PG8_BAR; PG8_MMA(0, 0, At, B0); PG8_MMA(0, 1, At, B1); PG8_BAR; PG8_SCHED;
            PG8_LDA(At, 0, 1); PG8_STAGE_B(PG8_SB(0, 0), b2); PG8_STAGE_B(PG8_SB(0, 1), b2 + hstepB); PG8_STAGE(PG8_SA(0, 0), a2, o2[0][0], o2[0][1]);
            PG8_WAIT_V(8); PG8_WAIT_L(0); PG8_BAR; PG8_MMA(1, 0, At, B0); PG8_MMA(1, 1, At, B1); PG8_BAR; PG8_SCHED;
            PG8_LDB(B0, 1, 0); PG8_LDB(B1, 1, 1); PG8_SCHED; PG8_LDA(At, 1, 0); PG8_STAGE(PG8_SA(0, 1), a2, o2[1][0], o2[1][1]);
            PG8_WAIT_V(8); PG8_WAIT_L(0); PG8_BAR; PG8_MMA(0, 0, At, B0); PG8_MMA(0, 1, At, B1); PG8_BAR; PG8_SCHED;
            PG8_LDA(At, 1, 1); PG8_STAGE_B(PG8_SB(1, 0), b3); PG8_STAGE_B(PG8_SB(1, 1), b3 + hstepB); PG8_STAGE(PG8_SA(1, 0), a3, o2[0][0], o2[0][1]);
            PG8_WAIT_V(8); PG8_WAIT_L(0); PG8_BAR; PG8_MMA(1, 0, At, B0); PG8_MMA(1, 1, At, B1); PG8_BAR; PG8_SCHED;
        }
        float rsv[2][4];
        if constexpr (PRESCALE) {
#pragma unroll
            for (int a = 0; a < 2; ++a)
#pragma unroll
                for (int m = 0; m < 4; ++m) rsv[a][m] = *(const float*)((const char*)S.rs + (unsigned)(cur.pm * 256 + a * 128 + wr * 64 + m * 16 + fr) * 4u);
        }
        if (wr == 0) PG8_BAR;
        if constexpr (PRESCALE) {
#pragma unroll
            for (int a = 0; a < 2; ++a)
#pragma unroll
                for (int m = 0; m < 4; ++m)
#pragma unroll
                    for (int b = 0; b < 2; ++b)
#pragma unroll
                        for (int n = 0; n < 2; ++n) acc[a][b][m][n] *= rsv[a][m];
        }
        E(acc, cur, wr, wc, fr, fq);
        if (!has_next) break;
#pragma unroll
        for (int a = 0; a < 2; ++a)
#pragma unroll
            for (int b = 0; b < 2; ++b)
#pragma unroll
                for (int m = 0; m < 4; ++m)
#pragma unroll
                    for (int n = 0; n < 2; ++n) acc[a][b][m][n] = (f32x4){0.f, 0.f, 0.f, 0.f};
        cur = nxt; cA = nA; cB = nB; cB2 = S.b_base2(cur); ++ui;
        if (GATHER) {
#pragma unroll
            for (int h = 0; h < 2; ++h)
#pragma unroll
                for (int i = 0; i < 2; ++i) oC[h][i] = oN[h][i];
        }
        if (wr == 1) PG8_BAR;
    }
    PG8_WAIT_V(0);
    PG8_BAR;
#undef PG8_SA
#undef PG8_SB
#undef PG8_STAGE
#undef PG8_STAGE_B
#undef PG8_LDA
#undef PG8_LDB
#undef PG8_MMA
#undef PG8_WAIT_V
#undef PG8_WAIT_L
#undef PG8_BAR
#undef PG8_SCHED
}
}

namespace att {
#define SBAR() __builtin_amdgcn_sched_barrier(0)
typedef LAS const char* lds_cptr;
__device__ __forceinline__ int crow(int r, int hi) { return (r & 3) + 8 * (r >> 2) + 4 * hi; }
__device__ __forceinline__ int dslot(int rot, int j) { const int s = rot + j; return s >= 6 ? s - 6 : s; }
__device__ __forceinline__ void glds16(const void* gsrc, unsigned lds_dst) { unsigned keep;
    asm volatile("s_mov_b32 %0, m0\n\ts_mov_b32 m0, %2\n\ts_nop 0\n\tglobal_load_lds_dwordx4 %1, off\n\ts_mov_b32 m0, %0" : "=&s"(keep) : "v"(gsrc), "s"(lds_dst) : "memory"); }
__device__ __forceinline__ float max3f(float a, float b, float c) { return __builtin_fmaxf(__builtin_fmaxf(a, b), c); }
__device__ __forceinline__ float rowmax(const f32x16& p0, const f32x16& p1) {
    float a = max3f(p0[0], p0[1], p1[0]), b = max3f(p0[2], p0[3], p1[1]); a = max3f(a, p1[2], p1[3]);
#pragma unroll
    for (int r = 4; r < 16; r += 4) { a = max3f(a, p0[r], p0[r + 1]); b = max3f(b, p0[r + 2], p0[r + 3]); a = max3f(a, p1[r], p1[r + 1]); b = max3f(b, p1[r + 2], p1[r + 3]); }
    const float m = __builtin_fmaxf(a, b);
    auto rr = __builtin_amdgcn_permlane32_swap(__float_as_uint(m), __float_as_uint(m), false, false);
    return __builtin_fmaxf(__uint_as_float(rr[0]), __uint_as_float(rr[1]));
}
template <int ND, bool NOLDS = false> __device__ __forceinline__ void qkt(f32x16& p0, f32x16& p1, lds_cptr Kslot, const bf16x8* qr, const f32x16& negm, int r32, int hi) {
    lds_cptr kb = Kslot + r32 * 128; const int sw = (r32 & 7) ^ ((r32 >> 3) & 1); lds_cptr kr = Kslot + 8192 + r32 * 64; const int swr = (r32 >> 2) & 3;
    bf16x8 kf[2 * ND];
#pragma unroll
    for (int d0 = 0; d0 < ND; ++d0) {
        if (NOLDS) { kf[2 * d0] = qr[d0]; kf[2 * d0 + 1] = qr[ND - 1 - d0]; }
        else if (d0 < 4) { const int o = ((2 * d0 + hi) ^ sw) * 16; kf[2 * d0] = *(const LAS bf16x8*)(kb + o); kf[2 * d0 + 1] = *(const LAS bf16x8*)(kb + o + 4096); }
        else { const int o = ((2 * (d0 - 4) + hi) ^ swr) * 16; kf[2 * d0] = *(const LAS bf16x8*)(kr + o); kf[2 * d0 + 1] = *(const LAS bf16x8*)(kr + o + 2048); }
    }
    __builtin_amdgcn_sched_barrier(0);
#pragma unroll
    for (int d0 = 0; d0 < ND; ++d0) {
        if (d0 == 0) { p0 = __builtin_amdgcn_mfma_f32_32x32x16_bf16(kf[0], qr[0], negm, 0, 0, 0); p1 = __builtin_amdgcn_mfma_f32_32x32x16_bf16(kf[1], qr[0], negm, 0, 0, 0); }
        else { p0 = __builtin_amdgcn_mfma_f32_32x32x16_bf16(kf[2 * d0], qr[d0], p0, 0, 0, 0); p1 = __builtin_amdgcn_mfma_f32_32x32x16_bf16(kf[2 * d0 + 1], qr[d0], p1, 0, 0, 0); }
    }
    __builtin_amdgcn_sched_barrier(0);
}
template <int ND> __device__ __forceinline__ void qkt_acc(f32x16& p0, f32x16& p1, lds_cptr Kslot, const bf16x8* qr, int r32, int hi) {
    lds_cptr kb = Kslot + r32 * 128; const int sw = (r32 & 7) ^ ((r32 >> 3) & 1);
    bf16x8 kf[2 * ND];
#pragma unroll
    for (int d0 = 0; d0 < ND; ++d0) { const int o = ((2 * d0 + hi) ^ sw) * 16; kf[2 * d0] = *(const LAS bf16x8*)(kb + o); kf[2 * d0 + 1] = *(const LAS bf16x8*)(kb + o + 4096); }
    __builtin_amdgcn_sched_barrier(0);
#pragma unroll
    for (int d0 = 0; d0 < ND; ++d0) { p0 = __builtin_amdgcn_mfma_f32_32x32x16_bf16(kf[2 * d0], qr[d0], p0, 0, 0, 0); p1 = __builtin_amdgcn_mfma_f32_32x32x16_bf16(kf[2 * d0 + 1], qr[d0], p1, 0, 0, 0); }
    __builtin_amdgcn_sched_barrier(0);
}
template <int ND, int HALF> __device__ __forceinline__ void qkt_half_acc(f32x16& p, lds_cptr Kslot, const bf16x8* qr, int r32, int hi) {
    lds_cptr kb = Kslot + r32 * 128 + HALF * 4096; const int sw = (r32 & 7) ^ ((r32 >> 3) & 1);
    bf16x8 kf[ND];
#pragma unroll
    for (int d0 = 0; d0 < ND; ++d0) kf[d0] = *(const LAS bf16x8*)(kb + ((2 * d0 + hi) ^ sw) * 16);
    __builtin_amdgcn_sched_barrier(0);
#pragma unroll
    for (int d0 = 0; d0 < ND; ++d0) p = __builtin_amdgcn_mfma_f32_32x32x16_bf16(kf[d0], qr[d0], p, 0, 0, 0);
    __builtin_amdgcn_sched_barrier(0);
}
template <int HALF> __device__ __forceinline__ void pv_half(f32x16* o, int vb, bf16x8 pa0, bf16x8 pa1) {
#pragma unroll
    for (int d0 = 0; d0 < 2; ++d0) { s16x4 lo[2], hi[2];
#pragma unroll
        for (int ks = 0; ks < 2; ++ks) {
            asm volatile("ds_read_b64_tr_b16 %0,%1 offset:%c2" : "=&v"(lo[ks]) : "v"(vb), "i"(d0 * 512 + (2 * HALF + ks) * 2048) : "memory");
            asm volatile("ds_read_b64_tr_b16 %0,%1 offset:%c2" : "=&v"(hi[ks]) : "v"(vb), "i"(d0 * 512 + (2 * HALF + ks) * 2048 + 1024) : "memory"); }
        asm volatile("s_waitcnt lgkmcnt(0)" ::: "memory"); SBAR();
#define PK(k) (bf16x8){lo[k][0], lo[k][1], lo[k][2], lo[k][3], hi[k][0], hi[k][1], hi[k][2], hi[k][3]}
        o[d0] = __builtin_amdgcn_mfma_f32_32x32x16_bf16(pa0, PK(0), o[d0], 0, 0, 0);
        o[d0] = __builtin_amdgcn_mfma_f32_32x32x16_bf16(pa1, PK(1), o[d0], 0, 0, 0);
#undef PK
    }
}
__device__ __forceinline__ void pv(f32x16* o, int vb, bf16x8 pa0, bf16x8 pa1, bf16x8 pa2, bf16x8 pa3) {
#pragma unroll
    for (int d0 = 0; d0 < 2; ++d0) { s16x4 lo[4], hi[4];
#pragma unroll
        for (int ks = 0; ks < 4; ++ks) {
            asm volatile("ds_read_b64_tr_b16 %0,%1 offset:%c2" : "=&v"(lo[ks]) : "v"(vb), "i"(d0 * 512 + ks * 2048) : "memory");
            asm volatile("ds_read_b64_tr_b16 %0,%1 offset:%c2" : "=&v"(hi[ks]) : "v"(vb), "i"(d0 * 512 + ks * 2048 + 1024) : "memory"); }
        asm volatile("s_waitcnt lgkmcnt(0)" ::: "memory"); SBAR();
#define PK(k) (bf16x8){lo[k][0], lo[k][1], lo[k][2], lo[k][3], hi[k][0], hi[k][1], hi[k][2], hi[k][3]}
        o[d0] = __builtin_amdgcn_mfma_f32_32x32x16_bf16(pa0, PK(0), o[d0], 0, 0, 0);
        o[d0] = __builtin_amdgcn_mfma_f32_32x32x16_bf16(pa1, PK(1), o[d0], 0, 0, 0);
        o[d0] = __builtin_amdgcn_mfma_f32_32x32x16_bf16(pa2, PK(2), o[d0], 0, 0, 0);
        o[d0] = __builtin_amdgcn_mfma_f32_32x32x16_bf16(pa3, PK(3), o[d0], 0, 0, 0);
#undef PK
    }
}
constexpr float THR = 8.0f;
struct SoftState { float mhat, l; f32x16 negm; f32x16 o[2]; };
struct SoftStateD { float mhat, l; f32x16 o[2]; };
__device__ __forceinline__ void softmax_pv(SoftState& st, f32x16& p0, f32x16& p1, LAS float* wsf, int vb, int r32, int hi) {
    const float rm = rowmax(p0, p1);
    if (__any(rm > THR)) {
        const float dl = __builtin_fmaxf(rm, 0.f);
        st.mhat += dl;
#pragma unroll
        for (int r = 0; r < 16; ++r) { p0[r] -= dl; p1[r] -= dl; }
#pragma unroll
        for (int r = 0; r < 16; ++r) st.negm[r] = -st.mhat;
        const float f = fexp2(-dl); st.l *= f;
        if (hi == 0) wsf[r32] = f;
        LDS_WAIT();
#pragma unroll
        for (int r = 0; r < 16; ++r) { const float fr_ = wsf[crow(r, hi)]; st.o[0][r] *= fr_; st.o[1][r] *= fr_; }
        LDS_WAIT();
    }
    float sacc = 0.f;
#pragma unroll
    for (int r = 0; r < 16; ++r) { p0[r] = fexp2(p0[r]); p1[r] = fexp2(p1[r]); sacc += p0[r] + p1[r]; }
    st.l += sacc;
    u32x4 w0, w1, w2, w3;
    w0 = (u32x4){pk2(p0[0], p0[1]), pk2(p0[2], p0[3]), pk2(p0[4], p0[5]), pk2(p0[6], p0[7])};
    w1 = (u32x4){pk2(p0[8], p0[9]), pk2(p0[10], p0[11]), pk2(p0[12], p0[13]), pk2(p0[14], p0[15])};
    w2 = (u32x4){pk2(p1[0], p1[1]), pk2(p1[2], p1[3]), pk2(p1[4], p1[5]), pk2(p1[6], p1[7])};
    w3 = (u32x4){pk2(p1[8], p1[9]), pk2(p1[10], p1[11]), pk2(p1[12], p1[13]), pk2(p1[14], p1[15])};
    pv(st.o, vb, __builtin_bit_cast(bf16x8, w0), __builtin_bit_cast(bf16x8, w1), __builtin_bit_cast(bf16x8, w2), __builtin_bit_cast(bf16x8, w3));
}
template <class ST, bool NOEXP = false> __device__ __forceinline__ void exp_pv(ST& st, f32x16& p0, f32x16& p1, int vb) {
    float sacc = 0.f;
#pragma unroll
    for (int r = 0; r < 16; ++r) { if (!NOEXP) { p0[r] = fexp2(p0[r]); p1[r] = fexp2(p1[r]); } sacc += p0[r] + p1[r]; }
    st.l += sacc;
    u32x4 w0, w1, w2, w3;
    w0 = (u32x4){pk2(p0[0], p0[1]), pk2(p0[2], p0[3]), pk2(p0[4], p0[5]), pk2(p0[6], p0[7])};
    w1 = (u32x4){pk2(p0[8], p0[9]), pk2(p0[10], p0[11]), pk2(p0[12], p0[13]), pk2(p0[14], p0[15])};
    w2 = (u32x4){pk2(p1[0], p1[1]), pk2(p1[2], p1[3]), pk2(p1[4], p1[5]), pk2(p1[6], p1[7])};
    w3 = (u32x4){pk2(p1[8], p1[9]), pk2(p1[10], p1[11]), pk2(p1[12], p1[13]), pk2(p1[14], p1[15])};
    pv(st.o, vb, __builtin_bit_cast(bf16x8, w0), __builtin_bit_cast(bf16x8, w1), __builtin_bit_cast(bf16x8, w2), __builtin_bit_cast(bf16x8, w3));
}
template <class ST> __device__ __forceinline__ void exp_pv2(ST& st, f32x16& p0, f32x16& p1, int vb) {
    s16x4 lo[2][4], hi[2][4];
#pragma unroll
    for (int d0 = 0; d0 < 2; ++d0)
#pragma unroll
        for (int ks = 0; ks < 4; ++ks) {
            asm volatile("ds_read_b64_tr_b16 %0,%1 offset:%c2" : "=&v"(lo[d0][ks]) : "v"(vb), "i"(d0 * 512 + ks * 2048) : "memory");
            asm volatile("ds_read_b64_tr_b16 %0,%1 offset:%c2" : "=&v"(hi[d0][ks]) : "v"(vb), "i"(d0 * 512 + ks * 2048 + 1024) : "memory"); }
    float sacc = 0.f;
#pragma unroll
    for (int r = 0; r < 16; ++r) { p0[r] = fexp2(p0[r]); p1[r] = fexp2(p1[r]); sacc += p0[r] + p1[r]; }
    st.l += sacc;
    u32x4 w0, w1, w2, w3;
    w0 = (u32x4){pk2(p0[0], p0[1]), pk2(p0[2], p0[3]), pk2(p0[4], p0[5]), pk2(p0[6], p0[7])};
    w1 = (u32x4){pk2(p0[8], p0[9]), pk2(p0[10], p0[11]), pk2(p0[12], p0[13]), pk2(p0[14], p0[15])};
    w2 = (u32x4){pk2(p1[0], p1[1]), pk2(p1[2], p1[3]), pk2(p1[4], p1[5]), pk2(p1[6], p1[7])};
    w3 = (u32x4){pk2(p1[8], p1[9]), pk2(p1[10], p1[11]), pk2(p1[12], p1[13]), pk2(p1[14], p1[15])};
    asm volatile("s_waitcnt lgkmcnt(0)" ::: "memory");
#pragma unroll
    for (int d0 = 0; d0 < 2; ++d0)
#pragma unroll
        for (int ks = 0; ks < 4; ++ks) { asm volatile("" : "+v"(lo[d0][ks]), "+v"(hi[d0][ks])); }
    SBAR();
    const bf16x8 pa[4] = {__builtin_bit_cast(bf16x8, w0), __builtin_bit_cast(bf16x8, w1), __builtin_bit_cast(bf16x8, w2), __builtin_bit_cast(bf16x8, w3)};
#pragma unroll
    for (int d0 = 0; d0 < 2; ++d0)
#pragma unroll
        for (int ks = 0; ks < 4; ++ks)
            st.o[d0] = __builtin_amdgcn_mfma_f32_32x32x16_bf16(pa[ks], (bf16x8){lo[d0][ks][0], lo[d0][ks][1], lo[d0][ks][2], lo[d0][ks][3], hi[d0][ks][0], hi[d0][ks][1], hi[d0][ks][2], hi[d0][ks][3]}, st.o[d0], 0, 0, 0);
}
template <class ST> __device__ __forceinline__ void finish_rows(ST& st, LAS float* wsf, LAS bf16_t* stg, int r32, int hi) {
    float l = st.l;
    { auto rr = __builtin_amdgcn_permlane32_swap(__float_as_uint(l), __float_as_uint(l), false, false); l = __uint_as_float(rr[0]) + __uint_as_float(rr[1]); }
    if (hi == 0) { wsf[32 + r32] = l; wsf[64 + r32] = st.mhat + __builtin_amdgcn_logf(l); }
    LDS_WAIT();
#pragma unroll
    for (int r = 0; r < 16; ++r) { const int orow = crow(r, hi); const float rl = frcp(wsf[32 + orow]);
#pragma unroll
        for (int d0 = 0; d0 < 2; ++d0) stg[orow * 64 + d0 * 32 + r32] = (bf16_t)(pk2(st.o[d0][r] * rl, 0.f) & 0xffffu); }
    LDS_WAIT();
}

constexpr int MK_SLOT = 12288, MV_SLOT = 8192, M_NSLOT = 5, M_LK = 0, M_LV = M_NSLOT * MK_SLOT;
template <int MODE  > __device__ __forceinline__ void mla_unit(int b, int h, int qb, const bf16_t* QM, const bf16_t* KN, const bf16_t* KR, const bf16_t* VM, bf16_t* MIX, LAS char* shm) {
    int tid_ = threadIdx.x; asm volatile("" : "+v"(tid_)); const int tid = tid_, lane = tid & 63, r32 = lane & 31, hi = lane >> 5; const int wid = __builtin_amdgcn_readfirstlane(tid >> 6);
    const long rowbase = (long)b * SEQ; const int q0 = qb * 256;
    const unsigned lds0 = (unsigned)(uintptr_t)shm;
    LAS float* wsf = (LAS float*)(shm + ATT_WSF) + wid * 128;
    LAS bf16_t* stg = (LAS bf16_t*)(shm + ATT_OST) + wid * 2048;
    const long hb = ((long)b * 8 + h) * SEQ;
    const bf16_t* ksrc0 = KN + (hb + 8 * wid + (lane >> 3)) * 64 + (((lane & 7) ^ (lane >> 3) ^ (wid & 1)) * 8);
    const bf16_t* ksrc1 = KR + (rowbase + 16 * (wid & 3) + (lane >> 2)) * 32 + (((lane & 3) ^ ((lane >> 4) & 3)) * 8);
    const bf16_t* vsrc = VM + (hb + 8 * wid + ((lane >> 2) & 7)) * 64 + (lane >> 5) * 32 + (lane & 3) * 8;
    const unsigned kdst0 = lds0 + M_LK + wid * 1024, kdst1 = lds0 + M_LK + (8 + (wid & 3)) * 1024, vdst = lds0 + M_LV + wid * 1024;
#define MLA_DMA(t, s) do { glds16(ksrc0 + (long)(t) * 64 * 64, (unsigned)__builtin_amdgcn_readfirstlane(kdst0 + (s) * MK_SLOT)); \
        glds16(ksrc1 + (long)(t) * 64 * 32, (unsigned)__builtin_amdgcn_readfirstlane(kdst1 + (s) * MK_SLOT)); \
        glds16(vsrc + (long)(t) * 64 * 64, (unsigned)__builtin_amdgcn_readfirstlane(vdst + (s) * MV_SLOT)); } while (0)
    const int NT = (q0 + 256) / 64;
    if (MODE != 2) { MLA_DMA(0, 0); MLA_DMA(1, 1); MLA_DMA(2, 2); }
    const bf16_t* Qw = QM + (hb + q0 + wid * 32 + r32) * 96 + hi * 8;
    bf16x8 qr[6];
#pragma unroll
    for (int d0 = 0; d0 < 6; ++d0) qr[d0] = *(const bf16x8*)(Qw + d0 * 16);
#pragma unroll
    for (int d0 = 0; d0 < 6; ++d0) asm volatile("" : "+v"(qr[d0]));
    SoftStateD st; st.mhat = 0.f; st.l = 0.f; st.o[0] = f32x16{}; st.o[1] = f32x16{}; const f32x16 zc = f32x16{};
    const int qw0 = q0 + wid * 32, qrel = qw0 + r32;
    const int vb0 = (int)(lds0 + M_LV) + ((lane >> 4) & 1) * 32 + (lane & 3) * 8 + (4 * hi + ((lane & 15) >> 2)) * 64;
    f32x16 p0, p1;
#define MLA_QK(t) do { qkt<6, MODE == 7>(p0, p1, (lds_cptr)(shm + M_LK + sl * MK_SLOT), qr, zc, r32, hi); \
        if (64 * (t) + 63 > qw0) { const int kb = 64 * (t) + 4 * hi; \
            _Pragma("unroll") for (int r = 0; r < 16; ++r) { const int kv = kb + (r & 3) + 8 * (r >> 2); if (kv > qrel) p0[r] = -INFINITY; if (kv + 32 > qrel) p1[r] = -INFINITY; } } } while (0)
    int sl = 0, slp = 4, sln = 3;
    for (int t = 0; t < NT; ++t) {
        if (MODE == 2) asm volatile("s_waitcnt lgkmcnt(0)\n\ts_barrier" ::: "memory");
        else if (MODE == 5) asm volatile("s_waitcnt vmcnt(0) lgkmcnt(0)" ::: "memory");
        else if (t + 2 < NT) asm volatile("s_waitcnt vmcnt(6) lgkmcnt(0)\n\ts_barrier" ::: "memory");
        else if (t + 1 < NT) asm volatile("s_waitcnt vmcnt(3) lgkmcnt(0)\n\ts_barrier" ::: "memory");
        else asm volatile("s_waitcnt vmcnt(0) lgkmcnt(0)\n\ts_barrier" ::: "memory");
        if (MODE != 2 && t + 3 < NT) MLA_DMA(t + 3, sln);
        const bool valid = (MODE != 1) && (64 * t <= qw0 + 31);
        if (valid) { MLA_QK(t); if (MODE == 6) exp_pv<SoftStateD, true>(st, p0, p1, vb0 + sl * MV_SLOT); else if (MODE != 3) exp_pv2(st, p0, p1, vb0 + sl * MV_SLOT); else { st.o[0] += p0; st.o[1] += p1; } }
        slp = sl; sl = (sl == 4) ? 0 : sl + 1; sln = (sln == 4) ? 0 : sln + 1;
    }
    finish_rows(st, wsf, stg, r32, hi);
    bf16_t* Ow = MIX + (rowbase + q0 + wid * 32) * 1024 + 512 + h * 64;
#pragma unroll
    for (int i = 0; i < 4; ++i) { const int row = i * 8 + (lane >> 3), ch = lane & 7; const u32x4 v = *(const LAS u32x4*)(stg + row * 64 + ch * 8); *(u32x4*)(Ow + (long)row * 1024 + ch * 8) = v; }
    asm volatile("s_waitcnt lgkmcnt(0)\n\ts_barrier" ::: "memory");
#undef MLA_DMA
#undef MLA_QK
}

constexpr int D_LK = 0, D_LV = 49152;
struct DilGeom { int br, uu, d, res0, tb, nslot, rot; };
__device__ __forceinline__ DilGeom dil_geom(int uidx) {
    DilGeom g; g.br = 2 - (uidx >> 3); g.uu = uidx & 7; g.d = 1 << (2 * g.br);
    if (g.br == 2) { g.res0 = 2 * g.uu; g.tb = 0; g.nslot = 4; }
    else { g.res0 = (g.br == 0) ? 0 : (g.uu >> 1); const int Q0 = (g.br == 0) ? 256 * g.uu : 256 * (g.uu & 1); g.tb = Q0 / 64 - 2; g.nslot = 6; }
    g.rot = (g.br == 2) ? 0 : (4 * ((g.br == 0) ? g.uu : (g.uu & 1))) % 6;
    return g;
}
template <bool ISV, int MODE = 0> __device__ __forceinline__ void dil_issue_tiles(const DilGeom& g, long hb, const bf16_t* KA, const bf16_t* VA, unsigned lds0, int lane, int wid) {
    if (MODE == 4) return;
    for (int j = (g.br == 2) ? 0 : 2; j < g.nslot; ++j) {
        const int tile = (g.br == 2) ? (j & 1) : g.tb + j; const int res = (g.br == 2) ? g.res0 + (j >> 1) : g.res0; const int sj = dslot(g.rot, j);
        if (!ISV) { const long krow = res + (long)g.d * (64 * tile + 8 * wid + (lane >> 3));
            glds16(KA + (hb + krow) * 64 + (((lane & 7) ^ (lane >> 3) ^ (wid & 1)) * 8), (unsigned)__builtin_amdgcn_readfirstlane(lds0 + D_LK + sj * 8192 + wid * 1024)); }
        else { const long vrow = res + (long)g.d * (64 * tile + 8 * wid + ((lane >> 2) & 7));
            glds16(VA + (hb + vrow) * 64 + (lane >> 5) * 32 + (lane & 3) * 8, (unsigned)__builtin_amdgcn_readfirstlane(lds0 + D_LV + sj * 8192 + wid * 1024)); }
    }
}
template <int MODE  > __device__ __forceinline__ void dil_phase2(int b, int h, const bf16_t* QA, const bf16_t* KA, const bf16_t* VA, bf16_t* O2, bf16_t* O3, float* LSE2, float* LSE3, bf16_t* MIX, LAS char* shm, const LAS float* tbl) {
    int tid_ = threadIdx.x; asm volatile("" : "+v"(tid_)); const int tid = tid_, lane = tid & 63, r32 = lane & 31, hi = lane >> 5; const int wid = __builtin_amdgcn_readfirstlane(tid >> 6);
    const long rowbase = (long)b * SEQ; const long hb = ((long)b * 8 + h) * SEQ;
    const unsigned lds0 = (unsigned)(uintptr_t)shm;
    LAS float* wsf = (LAS float*)(shm + ATT_WSF) + wid * 128;
    LAS bf16_t* stg = (LAS bf16_t*)(shm + ATT_OST) + wid * 2048;
    const int vb0 = (int)(lds0 + D_LV) + ((lane >> 4) & 1) * 32 + (lane & 3) * 8 + (4 * hi + ((lane & 15) >> 2)) * 64;
    dil_issue_tiles<false, MODE>(dil_geom(0), hb, KA, VA, lds0, lane, wid);
    bf16x8 qn[4];
    { const DilGeom g0 = dil_geom(0); const int wres0 = g0.res0 + (wid >> 2), qs0 = 32 * (wid & 3);
      const bf16_t* Qw0 = QA + (hb + wres0 + (long)g0.d * (qs0 + r32)) * 64 + hi * 8;
#pragma unroll
      for (int d0 = 0; d0 < 4; ++d0) qn[d0] = *(const bf16x8*)(Qw0 + d0 * 16); }
    for (int uidx = 0; uidx < 24; ++uidx) {
        const DilGeom g = dil_geom(uidx); const int br = g.br, d = g.d;
        if (uidx == 16) { VM_WAIT(); __syncthreads(); __builtin_amdgcn_fence(__ATOMIC_ACQUIRE, "agent"); VM_WAIT(); }
        int wres, qs, j0, nj;
        if (br == 2) { wres = g.res0 + (wid >> 2); qs = 32 * (wid & 3); j0 = 2 * (wid >> 2); nj = (wid & 3) < 2 ? 1 : 2; }
        else { wres = g.res0; qs = (g.tb + 2) * 64 + 32 * wid; j0 = wid >> 1; nj = 3; }
        if (uidx == 0 || uidx == 16) asm volatile("s_waitcnt vmcnt(0) lgkmcnt(0)\n\ts_barrier" ::: "memory");
        else asm volatile("s_waitcnt vmcnt(8) lgkmcnt(0)\n\ts_barrier" ::: "memory");
        bf16x8 qr[4];
#pragma unroll
        for (int d0 = 0; d0 < 4; ++d0) { qr[d0] = qn[d0]; asm volatile("" : "+v"(qr[d0])); }
        dil_issue_tiles<true, MODE>(g, hb, KA, VA, lds0, lane, wid);
        u32x2 o2v[4], o3v[4]; float l2v[4], l3v[4];
        if (br == 0) {
#pragma unroll
            for (int i = 0; i < 4; ++i) { const int row = i * 8 + (lane >> 3), ch = lane & 7; const long hr = hb + qs + row;
                o2v[i] = *(const u32x2*)((const char*)O2 + hr * 64 + ch * 8); o3v[i] = *(const u32x2*)((const char*)O3 + hr * 64 + ch * 8); l2v[i] = LSE2[hr]; l3v[i] = LSE3[hr]; }
            asm volatile("" ::: "memory");
        }
        const LAS float* tbr = tbl + br * 320;
        SoftStateD st; st.mhat = 0.f; st.l = 0.f; st.o[0] = f32x16{}; st.o[1] = f32x16{};
        u32x4 pw[3][4]; int hmask = 0;
#pragma unroll
        for (int jj = 0; jj < 3; ++jj) {
            const int j = j0 + jj; const int tile = (br == 2) ? jj : g.tb + j; const int sj = dslot(g.rot, j);
            const bool live = (MODE != 1) && jj < nj && tile >= 0;
            const bool h0 = live && !(64 * tile > qs + 31) && !(64 * tile + 31 < qs - 128);
            const bool h1 = live && !(64 * tile + 32 > qs + 31) && !(64 * tile + 63 < qs - 128);
            const LAS float* tp = tbr + (qs + r32 - 64 * tile + 33 - 4 * hi);
            if (h0) { f32x16 s0;
#pragma unroll
                for (int r = 0; r < 16; ++r) { const int c0 = (r & 3) + 8 * (r >> 2); s0[r] = tp[63 - c0]; }
                qkt_half_acc<4, 0>(s0, (lds_cptr)(shm + D_LK + sj * 8192), qr, r32, hi);
                float sacc = 0.f;
#pragma unroll
                for (int r = 0; r < 16; ++r) { s0[r] = fexp2(s0[r]); sacc += s0[r]; }
                st.l += sacc;
                pw[jj][0] = (u32x4){pk2(s0[0], s0[1]), pk2(s0[2], s0[3]), pk2(s0[4], s0[5]), pk2(s0[6], s0[7])};
                pw[jj][1] = (u32x4){pk2(s0[8], s0[9]), pk2(s0[10], s0[11]), pk2(s0[12], s0[13]), pk2(s0[14], s0[15])}; }
            if (h1) { f32x16 s1;
#pragma unroll
                for (int r = 0; r < 16; ++r) { const int c0 = (r & 3) + 8 * (r >> 2); s1[r] = tp[31 - c0]; }
                qkt_half_acc<4, 1>(s1, (lds_cptr)(shm + D_LK + sj * 8192), qr, r32, hi);
                float sacc = 0.f;
#pragma unroll
                for (int r = 0; r < 16; ++r) { s1[r] = fexp2(s1[r]); sacc += s1[r]; }
                st.l += sacc;
                pw[jj][2] = (u32x4){pk2(s1[0], s1[1]), pk2(s1[2], s1[3]), pk2(s1[4], s1[5]), pk2(s1[6], s1[7])};
                pw[jj][3] = (u32x4){pk2(s1[8], s1[9]), pk2(s1[10], s1[11]), pk2(s1[12], s1[13]), pk2(s1[14], s1[15])}; }
            hmask |= (h0 ? 1 : 0) << (2 * jj) | (h1 ? 2 : 0) << (2 * jj);
        }
        asm volatile("s_waitcnt vmcnt(0) lgkmcnt(0)\n\ts_barrier" ::: "memory");
        if (uidx + 1 < 24) { const DilGeom gn = dil_geom(uidx + 1);
            dil_issue_tiles<false, MODE>(gn, hb, KA, VA, lds0, lane, wid);
            int wresn, qsn;
            if (gn.br == 2) { wresn = gn.res0 + (wid >> 2); qsn = 32 * (wid & 3); } else { wresn = gn.res0; qsn = (gn.tb + 2) * 64 + 32 * wid; }
            const bf16_t* Qwn = QA + (hb + wresn + (long)gn.d * (qsn + r32)) * 64 + hi * 8;
#pragma unroll
            for (int d0 = 0; d0 < 4; ++d0) qn[d0] = *(const bf16x8*)(Qwn + d0 * 16);
            asm volatile("" ::: "memory"); }
#pragma unroll
        for (int jj = 0; jj < 3; ++jj) {
            const int sj = dslot(g.rot, j0 + jj);
            if ((hmask >> (2 * jj)) & 1) pv_half<0>(st.o, vb0 + sj * 8192, __builtin_bit_cast(bf16x8, pw[jj][0]), __builtin_bit_cast(bf16x8, pw[jj][1]));
            if ((hmask >> (2 * jj)) & 2) pv_half<1>(st.o, vb0 + sj * 8192, __builtin_bit_cast(bf16x8, pw[jj][2]), __builtin_bit_cast(bf16x8, pw[jj][3]));
        }
        if (MODE != 3) finish_rows(st, wsf, stg, r32, hi);
        const long trow0 = rowbase + wres + (long)d * qs;
        if (MODE == 2 || MODE == 3) { } else
        if (br != 0) {
            bf16_t* Ob = (br == 1) ? O2 : O3; float* Lb = (br == 1) ? LSE2 : LSE3;
#pragma unroll
            for (int i = 0; i < 4; ++i) { const int row = i * 8 + (lane >> 3), ch = lane & 7; const long tr = trow0 + (long)d * row;
                const u32x4 v = *(const LAS u32x4*)(stg + row * 64 + ch * 8); u32x2 q8;
                q8.x = (unsigned)__builtin_amdgcn_cvt_pk_fp8_f32(bflo(v.y), bfhi(v.y), __builtin_amdgcn_cvt_pk_fp8_f32(bflo(v.x), bfhi(v.x), 0, false), true);
                q8.y = (unsigned)__builtin_amdgcn_cvt_pk_fp8_f32(bflo(v.w), bfhi(v.w), __builtin_amdgcn_cvt_pk_fp8_f32(bflo(v.z), bfhi(v.z), 0, false), true);
                *(u32x2*)((char*)Ob + (hb + tr - rowbase) * 64 + ch * 8) = q8;
                if (ch == 0) Lb[7 * rowbase + (long)h * SEQ + tr] = wsf[64 + row]; }
        } else {
#pragma unroll
            for (int i = 0; i < 4; ++i) { const int row = i * 8 + (lane >> 3), ch = lane & 7; const long tr = trow0 + row;
                f32x4 a1, b1, a2, b2, a3, b3;
                { const u32x4 w = *(const LAS u32x4*)(stg + row * 64 + ch * 8); a1 = (f32x4){bflo(w.x), bfhi(w.x), bflo(w.y), bfhi(w.y)}; b1 = (f32x4){bflo(w.z), bfhi(w.z), bflo(w.w), bfhi(w.w)}; }
                { const u32x2 w = o2v[i]; const f32x2 c0 = __builtin_amdgcn_cvt_pk_f32_fp8((int)w.x, false), c1 = __builtin_amdgcn_cvt_pk_f32_fp8((int)w.x, true), c2 = __builtin_amdgcn_cvt_pk_f32_fp8((int)w.y, false), c3 = __builtin_amdgcn_cvt_pk_f32_fp8((int)w.y, true); a2 = (f32x4){c0[0], c0[1], c1[0], c1[1]}; b2 = (f32x4){c2[0], c2[1], c3[0], c3[1]}; }
                { const u32x2 w = o3v[i]; const f32x2 c0 = __builtin_amdgcn_cvt_pk_f32_fp8((int)w.x, false), c1 = __builtin_amdgcn_cvt_pk_f32_fp8((int)w.x, true), c2 = __builtin_amdgcn_cvt_pk_f32_fp8((int)w.y, false), c3 = __builtin_amdgcn_cvt_pk_f32_fp8((int)w.y, true); a3 = (f32x4){c0[0], c0[1], c1[0], c1[1]}; b3 = (f32x4){c2[0], c2[1], c3[0], c3[1]}; }
                const float l1 = wsf[64 + row], l2 = l2v[i], l3 = l3v[i];
                const float mm = max3f(l1, l2, l3); const float e1 = fexp2(l1 - mm), e2 = fexp2(l2 - mm), e3 = fexp2(l3 - mm); const float inv = frcp(e1 + e2 + e3);
                const float w1 = e1 * inv, w2 = e2 * inv, w3 = e3 * inv;
                st8(MIX + tr * 1024 + h * 64 + ch * 8, a1 * w1 + a2 * w2 + a3 * w3, b1 * w1 + b2 * w2 + b3 * w3); }
        }
        LDS_WAIT();
    }
    VM_WAIT(); __syncthreads();
}
#undef SBAR
}

#define XB_TMO      128
#define XB_XCNT(j)  (256  + 64 * (j))
#define XB_XSUB(j)  (1280 + 64 * (j))
#define XB_XGEN(j)  (2304 + 64 * (j))
#define XB_TOP      3328
#define XB_TOPGEN   3392
#define XCD_BAR_WORDS 3456
#define XB_SPIN_CAP (1u << 18)

__device__ __forceinline__ unsigned xb_ld(unsigned* p)              { return __hip_atomic_load(p, __ATOMIC_RELAXED, __HIP_MEMORY_SCOPE_AGENT); }
__device__ __forceinline__ unsigned xb_add(unsigned* p, unsigned v) { return __hip_atomic_fetch_add(p, v, __ATOMIC_RELAXED, __HIP_MEMORY_SCOPE_AGENT); }
__device__ __forceinline__ unsigned xb_xcc_id() { return (unsigned)__builtin_amdgcn_s_getreg((3 << 11) | 20) & 0xFu; }
#define XB_SPIN(cond, bar) do { unsigned _sp = 0; while (cond) { __builtin_amdgcn_s_sleep(1); \
    if ((++_sp & 255u) == 0u) { if (xb_ld(&(bar)[XB_TMO])) break; if (_sp > XB_SPIN_CAP) { atomicAdd(&(bar)[XB_TMO], 1u); break; } } } } while (0)

struct XcdBarrier {
    unsigned* bar; unsigned x;
    volatile LAS unsigned* st;
};

__device__ __forceinline__ XcdBarrier xcd_barrier_post(unsigned* bar, volatile LAS unsigned* st) {
    XcdBarrier b; b.bar = bar; b.x = xb_xcc_id(); b.st = st;
    if (threadIdx.x == 0) (void)xb_add(&bar[XB_XCNT(b.x)], 1u);
    return b;
}
__device__ __forceinline__ void xcd_barrier_complete(unsigned* bar, unsigned x, unsigned& nloc, unsigned& nx) {
    const unsigned G = gridDim.x * gridDim.y * gridDim.z;
    unsigned sum, cnt, mine, sp = 0u;
    for (;;) {
        sum = 0u; cnt = 0u; mine = 0u;
#pragma unroll
        for (unsigned j = 0; j < 16; ++j) { const unsigned c = xb_ld(&bar[XB_XCNT(j)]); sum += c; cnt += (c > 0u) ? 1u : 0u; mine = (j == x) ? c : mine; }
        if (sum == G) break;
        __builtin_amdgcn_s_sleep(1);
        if ((++sp & 255u) == 0u) { if (xb_ld(&bar[XB_TMO])) break; if (sp > XB_SPIN_CAP) { atomicAdd(&bar[XB_TMO], 1u); break; } }
    }
    nloc = mine > 0u ? mine : 1u; nx = cnt > 0u ? cnt : 1u;
}

__device__ __forceinline__ void xcd_barrier(const XcdBarrier& b) {
    asm volatile("s_waitcnt vmcnt(0)" ::: "memory");
    __syncthreads();
    if (threadIdx.x == 0) {
        unsigned* bar = b.bar;
        __builtin_amdgcn_s_waitcnt(0);
        unsigned nloc = b.st[0], nx = b.st[1];
        if (nloc == 0u) { xcd_barrier_complete(bar, b.x, nloc, nx); b.st[0] = nloc; b.st[1] = nx; }
        const unsigned old = xb_add(&bar[XB_XSUB(b.x)], 1u);
        const unsigned gen = old / nloc;
        if (old + 1u == (gen + 1u) * nloc) {
            __builtin_amdgcn_fence(__ATOMIC_RELEASE, "agent");
            asm volatile("s_waitcnt vmcnt(0)" ::: "memory");
            const unsigned og = xb_add(&bar[XB_TOP], 1u);
            const unsigned tg = og / nx;
            if (og + 1u == (tg + 1u) * nx) xb_add(&bar[XB_TOPGEN], 1u);
            else XB_SPIN(xb_ld(&bar[XB_TOPGEN]) == tg, bar);
            __builtin_amdgcn_fence(__ATOMIC_ACQUIRE, "agent");
            xb_add(&bar[XB_XGEN(b.x)], 1u);
            asm volatile("s_waitcnt vmcnt(0)" ::: "memory");
        } else {
            XB_SPIN(xb_ld(&bar[XB_XGEN(b.x)]) == gen, bar);
            __builtin_amdgcn_fence(__ATOMIC_ACQUIRE, "agent");
            asm volatile("s_waitcnt vmcnt(0)" ::: "memory");
        }
    }
    __syncthreads();
}

struct Frame {
    LAS unsigned char* lds; volatile LAS unsigned* MISC; unsigned* ctl; unsigned char* ws;
    int tid, lane, wave, vcu, G;
};
struct Args {
    const float* in[28]; float* out; unsigned char* ws;
};
enum { I_X = 0, I_P, I_RELB, I_NMG, I_WIN, I_QNA, I_KNA, I_QAG, I_WQUP, I_KVAG, I_WKVUP, I_QNN, I_QNR, I_KNN, I_KNR, I_WOUT, I_NFG, I_WRG, I_BRG, I_WRE, I_BRE, I_WEG, I_WEU, I_WED, I_WPP, I_PNG, I_WPG, I_BPG };

__device__ __forceinline__ float wave_sum(float v) {
#pragma unroll
    for (int o = 1; o < 64; o <<= 1) v += __shfl_xor(v, o);
    return v;
}

template <class RowMap>
__device__ __forceinline__ void tr_item(const float* __restrict__ W, int N, const float* __restrict__ kscale, bf16_t* WT, int ldt, RowMap map, LAS float* scr, int k0, int n0, int lane) {
    float tv[32];
#pragma unroll
    for (int i = 0; i < 32; ++i) { const int kk = 2 * i + (lane >> 5); tv[i] = __builtin_nontemporal_load(W + (size_t)(k0 + kk) * N + n0 + (lane & 31)); }
    if (kscale) {
#pragma unroll
        for (int i = 0; i < 32; ++i) tv[i] *= kscale[k0 + 2 * i + (lane >> 5)];
    }
#pragma unroll
    for (int i = 0; i < 32; ++i) scr[(2 * i + (lane >> 5)) * 33 + (lane & 31)] = tv[i];
    LDS_WAIT(); asm volatile("" ::: "memory");
    const int c = lane & 7;
#pragma unroll
    for (int j = 0; j < 4; ++j) { const int n = (lane >> 3) + 8 * j; const LAS float* s = scr + (8 * c) * 33 + n;
        u32x4 o; o.x = pk2(s[0 * 33], s[1 * 33]); o.y = pk2(s[2 * 33], s[3 * 33]); o.z = pk2(s[4 * 33], s[5 * 33]); o.w = pk2(s[6 * 33], s[7 * 33]);
        const int dr = map(n0 + n);
        if (dr >= 0) *(u32x4*)(WT + (size_t)dr * ldt + k0 + 8 * c) = o; }
    LDS_WAIT(); asm volatile("" ::: "memory");
}
struct MapId { int off; __device__ __forceinline__ int operator()(int n) const { return off + n; } };
struct MapSlot { __device__ __forceinline__ int operator()(int L) const { return 256 * (L >> 8) + 128 * ((L >> 5) & 1) + 32 * ((L >> 6) & 3) + (L & 31); } };
__device__ __forceinline__ int slot_row(int s, int c64) { return 256 * (s >> 2) + 128 * (c64 >> 5) + 32 * (s & 3) + (c64 & 31); }
__device__ __forceinline__ int rope_j(int dim) { return 8 * ((dim & 15) >> 2) + 4 * (dim >> 4) + (dim & 3); }
struct MapWin { __device__ __forceinline__ int operator()(int L) const {
    if (L < 1024) return slot_row(L >> 6, L & 63);
    if (L < 1536) return 1024 + slot_row((L - 1024) >> 6, (L - 1024) & 63);
    if (L < 2176) return 1536 + slot_row((L - 1536) >> 6, (L - 1536) & 63);
    return 1536 + slot_row(10, rope_j(L - 2176));
} };
struct MapQup { __device__ __forceinline__ int operator()(int L) const { const int hd = L / 96, dd = L % 96;
    if (dd < 64) return slot_row(hd, dd);
    return 512 + slot_row(hd >> 1, 32 * (hd & 1) + rope_j(dd - 64));
} };
struct MapKVup { __device__ __forceinline__ int operator()(int L) const { const int hd = L >> 7, dd = L & 127;
    if (dd < 64) return slot_row(hd, dd);
    return 512 + slot_row(hd, dd - 64);
} };
struct MapGU { int up; __device__ __forceinline__ int operator()(int c) const { return (c >> 7) * 256 + up * 128 + (c & 127); } };

__device__ __forceinline__ int t5_bucket(int n) {
    if (n < 16) return n;
    int lg = 16 + (int)(__builtin_amdgcn_logf((float)n * 0.0625f) * (16.0f / 7.0f));
    return lg < 31 ? lg : 31;
}

#ifndef WD_IN_P0
#define WD_IN_P0 0
#endif
__device__ __forceinline__ void convert_wd(Frame& F, const Args& a, int rank, int count) {
    LAS float* scr = (LAS float*)(F.lds + F.wave * 16384);
    for (int r = rank * 8 + F.wave; r < NEXP * 256; r += count * 8) { const int e = r >> 8, q = r & 255;
        tr_item(a.in[I_WED] + (size_t)e * 512 * 1024, 1024, nullptr, (bf16_t*)(F.ws + WS_WD) + (size_t)e * 1024 * 512, 512, MapSlot{}, scr, 64 * (q >> 5), 32 * (q & 31), F.lane); }
}
__device__ __forceinline__ void p0_prologue(Frame& F, const Args& a) {
    LAS float* scr = (LAS float*)(F.lds + F.wave * 16384);
    const int gw = F.vcu * 8 + F.wave, NGW = F.G * 8, lane = F.lane;
    unsigned char* ws = F.ws;
    constexpr int I0 = 16 * 69, I1 = 6 * 24, I2 = 4 * 32, I3 = 16 * 32, I4 = 16, I5 = NEXP * 256, I6 = NEXP * 256, I7 = WD_IN_P0 ? NEXP * 256 : 0, I8 = 4 * 32, I9 = 16 * 32;
    constexpr int NITEMS = I0 + I1 + I2 + I3 + I4 + I5 + I6 + I7 + I8 + I9;
    for (int it = gw; it < NITEMS; it += NGW) {
        int r = it;
        if (r < I0) { tr_item(a.in[I_WIN], INC, a.in[I_NMG], (bf16_t*)(ws + WS_WIN), 1024, MapWin{}, scr, 64 * (r / 69), 32 * (r % 69), lane); continue; } r -= I0;
        if (r < I1) { tr_item(a.in[I_WQUP], 768, a.in[I_QAG], (bf16_t*)(ws + WS_WQUP), 384, MapQup{}, scr, 64 * (r / 24), 32 * (r % 24), lane); continue; } r -= I1;
        if (r < I2) { tr_item(a.in[I_WKVUP], 1024, a.in[I_KVAG], (bf16_t*)(ws + WS_WKVUP), 256, MapKVup{}, scr, 64 * (r / 32), 32 * (r % 32), lane); continue; } r -= I2;
        if (r < I3) { tr_item(a.in[I_WOUT], 1024, nullptr, (bf16_t*)(ws + WS_WOUT), 1024, MapSlot{}, scr, 64 * (r / 32), 32 * (r % 32), lane); continue; } r -= I3;
        if (r < I4) { tr_item(a.in[I_WRE], 32, a.in[I_NFG], (bf16_t*)(ws + WS_WR), 1024, MapId{0}, scr, 64 * r, 0, lane); continue; } r -= I4;
        if (r < I5) { const int e = r >> 8, q = r & 255; tr_item(a.in[I_WEG] + (size_t)e * 1024 * 512, 512, a.in[I_NFG], (bf16_t*)(ws + WS_WGU) + (size_t)e * 1024 * 1024, 1024, MapGU{0}, scr, 64 * (q >> 4), 32 * (q & 15), lane); continue; } r -= I5;
        if (r < I6) { const int e = r >> 8, q = r & 255; tr_item(a.in[I_WEU] + (size_t)e * 1024 * 512, 512, a.in[I_NFG], (bf16_t*)(ws + WS_WGU) + (size_t)e * 1024 * 1024, 1024, MapGU{1}, scr, 64 * (q >> 4), 32 * (q & 15), lane); continue; } r -= I6;
        if (r < I7) { const int e = r >> 8, q = r & 255; tr_item(a.in[I_WED] + (size_t)e * 512 * 1024, 1024, nullptr, (bf16_t*)(ws + WS_WD) + (size_t)e * 1024 * 512, 512, MapSlot{}, scr, 64 * (q >> 5), 32 * (q & 31), lane); continue; } r -= I7;
        if (r < I8) { tr_item(a.in[I_WPP], 1024, nullptr, (bf16_t*)(ws + WS_WPP), 256, MapSlot{}, scr, 64 * (r / 32), 32 * (r % 32), lane); continue; } r -= I8;
        tr_item(a.in[I_WPG], 1024, nullptr, (bf16_t*)(ws + WS_WPG), 1024, MapSlot{}, scr, 64 * (r / 32), 32 * (r % 32), lane);
    }
    const int gt = F.vcu * 512 + F.tid, NGT = F.G * 512;
    { bf16_t* WR = (bf16_t*)(ws + WS_WR); const float* wrg = a.in[I_WRG]; const float* nfg = a.in[I_NFG];
      for (int i = gt; i < 224 * 1024; i += NGT) { const int rr = 32 + (i >> 10), k = i & 1023; float v = 0.f; if (rr >= 128 && rr < 132) v = wrg[k * 4 + (rr - 128)] * nfg[k]; WR[(size_t)rr * 1024 + k] = (bf16_t)(pk2(v, 0.f) & 0xffffu); }
      bf16_t* WI = (bf16_t*)(ws + WS_WIN);
      for (int i = gt; i < 96 * 1024; i += NGT) { const int q = i >> 10, k = i & 1023; const int rr = (q < 32) ? 1536 + slot_row(10, 32 + q) : 1536 + slot_row(11, q - 32); WI[(size_t)rr * 1024 + k] = 0; } }
    { float* cs = (float*)(ws + WS_ROPE);
      for (int i = gt; i < 2048 * 16; i += NGT) { const int pos = i >> 4, k = i & 15; const float inv = __builtin_amdgcn_exp2f(-(float)k * (13.287712379549449f / 16.0f));
          const float ang = (float)pos * inv; double rv = (double)ang * 0.15915494309189535; rv -= __builtin_floor(rv); const float rf = (float)rv;
          cs[pos * 32 + k] = __builtin_amdgcn_cosf(rf); cs[pos * 32 + 16 + k] = __builtin_amdgcn_sinf(rf); }
      float* tb = (float*)(ws + WS_TBG); const float* relb = a.in[I_RELB];
      for (int i = gt; i < 3 * 8 * 320; i += NGT) { const int br = i / 2560, hh = (i / 320) & 7, idx = i % 320, delta = idx - 96;
          float v = -1e30f; if (delta >= 0 && delta <= 128) v = relb[t5_bucket(delta << (2 * br)) * 8 + hh] * LOG2E; tb[i] = v; }
      { float* z0 = (float*)(ws + WS_SSQCQ); float* z1 = (float*)(ws + WS_SSQCKV); float* z2 = (float*)(ws + WS_SSQE); for (int i = gt; i < M; i += NGT) { z0[i] = 0.f; z1[i] = 0.f; z2[i] = 0.f; } }
      i32x4* rr4 = (i32x4*)(ws + WS_ROWREC); unsigned* ro = (unsigned*)(ws + WS_ROWOFF);
      for (int i = gt; i < MAXT * 256; i += NGT) { rr4[i] = (i32x4){-1, 0, 0, 0}; ro[i] = 0u; }
      i32x4* rr5 = (i32x4*)(ws + WS_ROWREC2); unsigned* ro5 = (unsigned*)(ws + WS_ROWOFF2);
      for (int i = gt; i < MAXTE * 256; i += NGT) { rr5[i] = (i32x4){-1, 0, 0, 0}; ro5[i] = 0u; } }
    { const f32x4* p4 = (const f32x4*)a.in[I_P]; u32x4* pb = (u32x4*)((char*)a.out + PB_IN_OUT);
      for (int i0 = gt; i0 < M * PLE / 8; i0 += 4 * NGT) { f32x4 u[4], v[4];
#pragma unroll
          for (int j = 0; j < 4; ++j) { const int i = i0 + j * NGT; if (i < M * PLE / 8) { u[j] = __builtin_nontemporal_load(p4 + 2 * i); v[j] = __builtin_nontemporal_load(p4 + 2 * i + 1); } }
#pragma unroll
          for (int j = 0; j < 4; ++j) { const int i = i0 + j * NGT; if (i < M * PLE / 8) { u32x4 o; o.x = pk2(u[j][0], u[j][1]); o.y = pk2(u[j][2], u[j][3]); o.z = pk2(v[j][0], v[j][1]); o.w = pk2(v[j][2], v[j][3]); pb[i] = o; } } } }
    { const float* x = a.in[I_X]; bf16_t* XB = (bf16_t*)(ws + WS_XB); float* rs1 = (float*)(ws + WS_RSTD1);
      for (int m0 = gw; m0 < M; m0 += 4 * NGW) {
          f32x4 v[4][4];
#pragma unroll
          for (int q = 0; q < 4; ++q) { const int m = m0 + q * NGW; if (m < M) { const f32x4* xr = (const f32x4*)(x + (size_t)m * DM) + lane;
#pragma unroll
              for (int j = 0; j < 4; ++j) v[q][j] = __builtin_nontemporal_load(xr + 64 * j); } }
#pragma unroll
          for (int q = 0; q < 4; ++q) { const int m = m0 + q * NGW; if (m < M) { float s = 0.f;
#pragma unroll
              for (int j = 0; j < 4; ++j) s += dot4(v[q][j]);
              const float rstd = rsq(wave_sum(s) * (1.f / DM) + EPS);
              if (lane == 0) rs1[m] = rstd;
              u32x2* o8 = (u32x2*)(XB + (size_t)m * DM) + lane;
#pragma unroll
              for (int j = 0; j < 4; ++j) { const f32x4 y = v[q][j]; u32x2 o; o.x = pk2(y[0], y[1]); o.y = pk2(y[2], y[3]); o8[64 * j] = o; } } }
      } }
}

__device__ __forceinline__ size_t hrow(size_t r, int hd) { return (r >> 11) * (8 * SEQ) + (size_t)hd * SEQ + (r & (SEQ - 1)); }
typedef f32x4 AccT[2][2][4][2];
#define EPI_ROWS for (int ai = 0; ai < 2; ++ai) _Pragma("unroll") for (int m = 0; m < 4; ({ if (m & 1) asm volatile("" ::: "memory"); }), ++m)
#define EPI_ROW(u) ((u).pm * 256 + ai * 128 + wr * 64 + m * 16 + fr)
#define EPI_FENCE() asm volatile("" ::: "memory")
#define EPI_HALF for (int ai = 0; ai < 2; ++ai)
#define EPI_M4 _Pragma("unroll") for (int m = 0; m < 4; ++m)

struct EpiInProj {
    bf16_t *QA, *KA, *VA, *CQ, *CKV, *KR; float *ssq_cq, *ssq_ckv; const float *qn_gain, *kn_gain, *knr_gain, *rope_cs;
    __device__ __forceinline__ void operator()(const AccT& acc, const pg8::Unit& u, int wr, int wc, int fr, int fq) const {
        const int pn = u.pn;
        if (pn < 4) {
            const bool isq = pn < 2; const int head = (pn & 1) * 4 + wc; const float* gain = isq ? qn_gain : kn_gain; bf16_t* dst = isq ? QA : KA; const float sc = isq ? C2A : 1.0f;
            f32x4 g[2][2];
#pragma unroll
            for (int bj = 0; bj < 2; ++bj)
#pragma unroll
                for (int n = 0; n < 2; ++n) g[bj][n] = *(const f32x4*)(gain + 32 * bj + 8 * fq + 4 * n) * sc;
#pragma unroll
            EPI_ROWS { const size_t row = EPI_ROW(u);
                float ss = dot4(acc[ai][0][m][0]) + dot4(acc[ai][0][m][1]) + dot4(acc[ai][1][m][0]) + dot4(acc[ai][1][m][1]); ss = red_fq(ss);
                const float rn = rsq(ss * (1.f / 64.f) + EPS);
#pragma unroll
                for (int bj = 0; bj < 2; ++bj) st8(dst + hrow(row, head) * 64 + 32 * bj + 8 * fq, acc[ai][bj][m][0] * rn * g[bj][0], acc[ai][bj][m][1] * rn * g[bj][1]); }
        } else if (pn < 6) {
#pragma unroll
            EPI_ROWS { const size_t row = EPI_ROW(u);
#pragma unroll
                for (int bj = 0; bj < 2; ++bj) { const int col = (pn - 4) * 256 + 64 * wc + 32 * bj + 8 * fq; st8(VA + hrow(row, col >> 6) * 64 + (col & 63), acc[ai][bj][m][0], acc[ai][bj][m][1]); } }
        } else {
            const int s = 4 * (pn - 6) + wc;
            if (s < 10) {
                const bool iscq = s < 6; bf16_t* dst = iscq ? CQ : CKV; const int ld = iscq ? 384 : 256; const int col = iscq ? 64 * s : 64 * (s - 6);
                float* sq = iscq ? ssq_cq : ssq_ckv;
#pragma unroll
                EPI_ROWS { const size_t row = EPI_ROW(u);
                    float ss = dot4(acc[ai][0][m][0]) + dot4(acc[ai][0][m][1]) + dot4(acc[ai][1][m][0]) + dot4(acc[ai][1][m][1]); ss = red_fq(ss);
                    if (fq == 0) (void)__hip_atomic_fetch_add(sq + row, ss, RLX_AGENT);
#pragma unroll
                    for (int bj = 0; bj < 2; ++bj) st8(dst + row * ld + col + 32 * bj + 8 * fq, acc[ai][bj][m][0], acc[ai][bj][m][1]); }
            } else if (s == 10) {
                const f32x4 g1 = *(const f32x4*)(knr_gain + 4 * fq), g2 = *(const f32x4*)(knr_gain + 16 + 4 * fq);
#pragma unroll
                EPI_HALF { f32x4 cv[4], sv[4];
                EPI_M4 { const int pos = (int)(EPI_ROW(u) & (SEQ - 1)); cv[m] = *(const f32x4*)(rope_cs + pos * 32 + 4 * fq); sv[m] = *(const f32x4*)(rope_cs + pos * 32 + 16 + 4 * fq); }
                EPI_M4 { const size_t row = EPI_ROW(u);
                    f32x4 x1 = acc[ai][0][m][0], x2 = acc[ai][0][m][1];
                    float ss = red_fq(dot4(x1) + dot4(x2)); const float rn = rsq(ss * (1.f / 32.f) + EPS);
                    x1 = x1 * rn * g1; x2 = x2 * rn * g2;
                    const f32x4 c = cv[m], sn = sv[m];
                    const f32x4 o1 = x1 * c - x2 * sn, o2 = x2 * c + x1 * sn;
                    u32x2 w1, w2; w1.x = pk2(o1[0], o1[1]); w1.y = pk2(o1[2], o1[3]); w2.x = pk2(o2[0], o2[1]); w2.y = pk2(o2[2], o2[3]);
                    *(u32x2*)(KR + row * 32 + 4 * fq) = w1; *(u32x2*)(KR + row * 32 + 16 + 4 * fq) = w2; }
                EPI_FENCE(); }
            }
        }
    }
};
struct EpiRawSsq {
    unsigned char* O; float* ssq;
    __device__ __forceinline__ void operator()(const AccT& acc, const pg8::Unit& u, int wr, int wc, int fr, int fq) const {
        const unsigned rowb = (unsigned)u.pm * 256u + wr * 64u + fr, colb = 256u * u.pn + 64u * wc + 8u * fq;
#pragma unroll
        EPI_ROWS { const unsigned row = rowb + ai * 128 + m * 16;
            float ss = dot4(acc[ai][0][m][0]) + dot4(acc[ai][0][m][1]) + dot4(acc[ai][1][m][0]) + dot4(acc[ai][1][m][1]); ss = red_fq(ss);
            if (fq == 0) (void)__hip_atomic_fetch_add(ssq + row, ss, RLX_AGENT);
#pragma unroll
            for (int bj = 0; bj < 2; ++bj) { const f32x4 a = acc[ai][bj][m][0], b = acc[ai][bj][m][1]; u32x2 w;
                w.x = (unsigned)__builtin_amdgcn_cvt_pk_fp8_f32(a[2], a[3], __builtin_amdgcn_cvt_pk_fp8_f32(a[0], a[1], 0, false), true);
                w.y = (unsigned)__builtin_amdgcn_cvt_pk_fp8_f32(b[2], b[3], __builtin_amdgcn_cvt_pk_fp8_f32(b[0], b[1], 0, false), true);
                *(u32x2*)(O + (row * 1024u + colb + 32u * bj)) = w; } }
    }
};
struct EpiQup {
    bf16_t* QM; const float *ssq_cq, *nope_gain, *rope_gain, *rope_cs;
    __device__ __forceinline__ void operator()(const AccT& acc, const pg8::Unit& u, int wr, int wc, int fr, int fq) const {
        const int pn = u.pn;
        if (pn < 2) {
            const int head = 4 * pn + wc; f32x4 g[2][2];
#pragma unroll
            for (int bj = 0; bj < 2; ++bj)
#pragma unroll
                for (int n = 0; n < 2; ++n) g[bj][n] = *(const f32x4*)(nope_gain + 32 * bj + 8 * fq + 4 * n) * C2M;
            float sq[2][4];
#pragma unroll
            EPI_HALF EPI_M4 sq[ai][m] = ssq_cq[EPI_ROW(u)];
#pragma unroll
            EPI_HALF EPI_M4 { const size_t row = EPI_ROW(u);
                const float rq = rsq(sq[ai][m] * (1.f / 384.f) + EPS);
                f32x4 v[2][2]; float ss = 0.f;
#pragma unroll
                for (int bj = 0; bj < 2; ++bj)
#pragma unroll
                    for (int n = 0; n < 2; ++n) { v[bj][n] = acc[ai][bj][m][n] * rq; ss += dot4(v[bj][n]); }
                ss = red_fq(ss); const float rn = rsq(ss * (1.f / 64.f) + EPS);
#pragma unroll
                for (int bj = 0; bj < 2; ++bj) st8(QM + hrow(row, head) * 96 + 32 * bj + 8 * fq, v[bj][0] * rn * g[bj][0], v[bj][1] * rn * g[bj][1]); }
        } else {
            const f32x4 g1 = *(const f32x4*)(rope_gain + 4 * fq) * C2M, g2 = *(const f32x4*)(rope_gain + 16 + 4 * fq) * C2M;
#pragma unroll
            EPI_HALF { float sq[4]; f32x4 cc[4], sn[4];
                EPI_M4 { const size_t row = EPI_ROW(u); const int pos = (int)(row & (SEQ - 1)); sq[m] = ssq_cq[row]; cc[m] = *(const f32x4*)(rope_cs + pos * 32 + 4 * fq); sn[m] = *(const f32x4*)(rope_cs + pos * 32 + 16 + 4 * fq); }
                EPI_M4 { const size_t row = EPI_ROW(u); const float rq = rsq(sq[m] * (1.f / 384.f) + EPS);
#pragma unroll
                    for (int bj = 0; bj < 2; ++bj) { const int head = 2 * wc + bj;
                        f32x4 x1 = acc[ai][bj][m][0] * rq, x2 = acc[ai][bj][m][1] * rq;
                        float ss = red_fq(dot4(x1) + dot4(x2)); const float rn = rsq(ss * (1.f / 32.f) + EPS);
                        x1 = x1 * rn * g1; x2 = x2 * rn * g2;
                        const f32x4 o1 = x1 * cc[m] - x2 * sn[m], o2 = x2 * cc[m] + x1 * sn[m];
                        u32x2 w1, w2; w1.x = pk2(o1[0], o1[1]); w1.y = pk2(o1[2], o1[3]); w2.x = pk2(o2[0], o2[1]); w2.y = pk2(o2[2], o2[3]);
                        *(u32x2*)(QM + hrow(row, head) * 96 + 64 + 4 * fq) = w1; *(u32x2*)(QM + hrow(row, head) * 96 + 80 + 4 * fq) = w2; } }
                EPI_FENCE(); }
        }
    }
};
struct EpiKVup {
    bf16_t *KN, *VM; const float *ssq_ckv, *nope_gain;
    __device__ __forceinline__ void operator()(const AccT& acc, const pg8::Unit& u, int wr, int wc, int fr, int fq) const {
        const int pn = u.pn;
        float sq[2][4];
#pragma unroll
        EPI_HALF EPI_M4 sq[ai][m] = ssq_ckv[EPI_ROW(u)];
        if (pn < 2) {
            const int head = 4 * pn + wc; f32x4 g[2][2];
#pragma unroll
            for (int bj = 0; bj < 2; ++bj)
#pragma unroll
                for (int n = 0; n < 2; ++n) g[bj][n] = *(const f32x4*)(nope_gain + 32 * bj + 8 * fq + 4 * n);
#pragma unroll
            EPI_HALF EPI_M4 { const size_t row = EPI_ROW(u);
                const float rk = rsq(sq[ai][m] * (1.f / 256.f) + EPS);
                f32x4 v[2][2]; float ss = 0.f;
#pragma unroll
                for (int bj = 0; bj < 2; ++bj)
#pragma unroll
                    for (int n = 0; n < 2; ++n) { v[bj][n] = acc[ai][bj][m][n] * rk; ss += dot4(v[bj][n]); }
                ss = red_fq(ss); const float rn = rsq(ss * (1.f / 64.f) + EPS);
#pragma unroll
                for (int bj = 0; bj < 2; ++bj) st8(KN + hrow(row, head) * 64 + 32 * bj + 8 * fq, v[bj][0] * rn * g[bj][0], v[bj][1] * rn * g[bj][1]); }
        } else {
#pragma unroll
            EPI_HALF EPI_M4 { const size_t row = EPI_ROW(u);
                const float rk = rsq(sq[ai][m] * (1.f / 256.f) + EPS);
#pragma unroll
                for (int bj = 0; bj < 2; ++bj) { const int col = (pn - 2) * 256 + 64 * wc + 32 * bj + 8 * fq; st8(VM + hrow(row, col >> 6) * 64 + (col & 63), acc[ai][bj][m][0] * rk, acc[ai][bj][m][1] * rk); } }
        }
    }
};
struct EpiWout {
    const bf16_t* XB; bf16_t* H1B; float* ssq;
    __device__ __forceinline__ void operator()(const AccT& acc, const pg8::Unit& u, int wr, int wc, int fr, int fq) const {
        const unsigned rowb = (unsigned)u.pm * 256u + wr * 64u + fr, offb = rowb * 1024u + 256u * u.pn + 64u * wc + 8u * fq;
        const char* const xc = (const char*)XB; char* const hc = (char*)H1B; char* const sc = (char*)ssq;
        u32x4 xv[2][4][2];
#pragma unroll
        for (int ai = 0; ai < 2; ++ai)
#pragma unroll
            for (int m = 0; m < 4; ++m)
#pragma unroll
                for (int bj = 0; bj < 2; ++bj) xv[ai][m][bj] = *(const u32x4*)(xc + (offb + (unsigned)(ai * 128 + m * 16) * 1024u + 32u * bj) * 2u);
        EPI_FENCE();
#pragma unroll
        for (int ai = 0; ai < 2; ++ai) {
#pragma unroll
            for (int m = 0; m < 4; ++m) { float ss = 0.f;
#pragma unroll
                for (int bj = 0; bj < 2; ++bj) { const u32x4 w = xv[ai][m][bj];
                    const f32x4 h0 = acc[ai][bj][m][0] + (f32x4){bflo(w.x), bfhi(w.x), bflo(w.y), bfhi(w.y)}, h1 = acc[ai][bj][m][1] + (f32x4){bflo(w.z), bfhi(w.z), bflo(w.w), bfhi(w.w)};
                    ss += dot4(h0) + dot4(h1); st8((bf16_t*)(hc + (offb + (unsigned)(ai * 128 + m * 16) * 1024u + 32u * bj) * 2u), h0, h1); }
                ss = red_fq(ss); if (fq == 0) *(float*)(sc + ((rowb + ai * 128 + m * 16) * 16u + 4u * u.pn + wc) * 4u) = ss; }
            EPI_FENCE(); }
    }
};
struct EpiNull {
    float* sink;
    __device__ __forceinline__ void operator()(const AccT& acc, const pg8::Unit& u, int wr, int wc, int fr, int fq) const {
        float s = 0.f;
#pragma unroll
        for (int ai = 0; ai < 2; ++ai)
#pragma unroll
            for (int bj = 0; bj < 2; ++bj)
#pragma unroll
                for (int m = 0; m < 4; ++m)
#pragma unroll
                    for (int n = 0; n < 2; ++n) s += acc[ai][bj][m][n][0] + acc[ai][bj][m][n][1] + acc[ai][bj][m][n][2] + acc[ai][bj][m][n][3];
        if (s == 1.2345e37f) sink[0] = s;
    }
};
struct EpiRoute {
    const float *ssq_h1, *b_rg, *b_re; float* rstd2; i32x4* route; unsigned* cnt;
    __device__ __forceinline__ void operator()(const AccT& acc, const pg8::Unit& u, int wr, int wc, int fr, int fq) const {
        if (wc != 0) return;
        const f32x4 be0 = *(const f32x4*)(b_re + 8 * fq), be1 = *(const f32x4*)(b_re + 8 * fq + 4), bg = *(const f32x4*)b_rg;
        float r2v[2][4];
#pragma unroll
        EPI_ROWS { const size_t row = EPI_ROW(u);
            float s = 0.f;
#pragma unroll
            for (int q = 0; q < 4; ++q) { const f32x4 t = *(const f32x4*)(ssq_h1 + row * 16 + 4 * q); s += (t[0] + t[1]) + (t[2] + t[3]); }
            r2v[ai][m] = rsq(s * (1.f / 1024.f) + EPS);
            if (fq == 0) rstd2[row] = r2v[ai][m]; }
        int pairv[2][4]; float wav[2][4], wbv[2][4]; bool mine[2][4];
#pragma unroll
        EPI_HALF EPI_M4 { const float r2 = r2v[ai][m];
            const f32x4 e0 = acc[ai][0][m][0] * r2 + be0, e1 = acc[ai][0][m][1] * r2 + be1;
            const f32x4 gloc = acc[ai][1][m][0] * r2 + bg;
            float gl[4];
#pragma unroll
            for (int j = 0; j < 4; ++j) gl[j] = __shfl(gloc[j], fr);
            int gi = 0; float gm = gl[0];
#pragma unroll
            for (int j = 1; j < 4; ++j) if (gl[j] > gm) { gm = gl[j]; gi = j; }
            float den = 0.f;
#pragma unroll
            for (int j = 0; j < 4; ++j) den += __expf(gl[j] - gm);
            const float gate = 1.0f / den;
            float el[8] = {e0[0], e0[1], e0[2], e0[3], e1[0], e1[1], e1[2], e1[3]};
            int i1 = 0; float l1 = el[0];
#pragma unroll
            for (int j = 1; j < 8; ++j) if (el[j] > l1) { l1 = el[j]; i1 = j; }
            int i2 = -1; float l2 = -INFINITY;
#pragma unroll
            for (int j = 0; j < 8; ++j) if (j != i1 && el[j] > l2) { l2 = el[j]; i2 = j; }
            const float w1 = gate / (1.0f + __expf(l2 - l1)), w2 = gate - w1;
            const int ea = i1 < i2 ? i1 : i2, eb = i1 < i2 ? i2 : i1;
            wav[ai][m] = i1 < i2 ? w1 : w2; wbv[ai][m] = i1 < i2 ? w2 : w1;
            pairv[ai][m] = gi * 28 + (ea * (15 - ea)) / 2 + (eb - ea - 1); mine[ai][m] = (fq == gi); }
        unsigned posv[2][4];
#pragma unroll
        EPI_HALF EPI_M4 { posv[ai][m] = 0u; if (mine[ai][m]) posv[ai][m] = __hip_atomic_fetch_add(cnt + 16 * pairv[ai][m], 1u, RLX_AGENT); }
#pragma unroll
        EPI_HALF EPI_M4 { if (mine[ai][m]) route[EPI_ROW(u)] = (i32x4){pairv[ai][m], (int)posv[ai][m], (int)__float_as_uint(wav[ai][m]), (int)__float_as_uint(wbv[ai][m])}; }
    }
};
struct EpiGateUp {
    const i32x4* rowrec2; bf16_t* HDN;
    __device__ __forceinline__ void operator()(const AccT& acc, const pg8::Unit& u, int wr, int wc, int fr, int fq) const {
        const unsigned rowb = (unsigned)u.pm * 256u + wr * 64u + fr, colb = (unsigned)u.pn * 128u + 32u * wc + 8u * fq;
        const char* const rc = (const char*)rowrec2; char* const hc = (char*)HDN;
        i32x4 rec[2][4];
#pragma unroll
        for (int ai = 0; ai < 2; ++ai)
#pragma unroll
            for (int m = 0; m < 4; ++m) rec[ai][m] = *(const i32x4*)(rc + (rowb + ai * 128 + m * 16) * 16u);
        EPI_FENCE();
#pragma unroll
        for (int ai = 0; ai < 2; ++ai) {
#pragma unroll
            for (int m = 0; m < 4; ++m) { const i32x4 rcd = rec[ai][m];
                const float r2 = __uint_as_float((unsigned)rcd.y), w = __uint_as_float((unsigned)rcd.z); const unsigned pr = (unsigned)rcd.w >> 1, slot = (unsigned)rcd.w & 1u;
                f32x4 hd[2];
#pragma unroll
                for (int n = 0; n < 2; ++n)
#pragma unroll
                    for (int e = 0; e < 4; ++e) { const float g = acc[ai][0][m][n][e] * r2, up = acc[ai][1][m][n][e] * r2; hd[n][e] = g * frcp(1.0f + fexp2(-g * LOG2E)) * up * w; }
                const unsigned eoff = rcd.x >= 0 ? pr * 1024u + slot * 512u + colb : (unsigned)((WS_DUMMY - WS_HDN) / 2) + colb;
                st8((bf16_t*)(hc + eoff * 2u), hd[0], hd[1]); }
            EPI_FENCE(); }
    }
};
struct EpiDown {
    const i32x4* rowrec; const bf16_t* H1B; bf16_t* H2B;
    __device__ __forceinline__ void operator()(const AccT& acc, const pg8::Unit& u, int wr, int wc, int fr, int fq) const {
        const unsigned rowb = (unsigned)u.pm * 256u + wr * 64u + fr, colb = 256u * u.pn + 64u * wc + 8u * fq;
        const char* const rc = (const char*)rowrec; const char* const h1c = (const char*)H1B; char* const h2c = (char*)H2B;
        int tk[2][4];
#pragma unroll
        for (int ai = 0; ai < 2; ++ai)
#pragma unroll
            for (int m = 0; m < 4; ++m) tk[ai][m] = *(const int*)(rc + (rowb + ai * 128 + m * 16) * 16u);
        u32x4 hv[2][4][2];
#pragma unroll
        for (int ai = 0; ai < 2; ++ai)
#pragma unroll
            for (int m = 0; m < 4; ++m) { const unsigned tok = tk[ai][m] < 0 ? 0u : (unsigned)tk[ai][m];
#pragma unroll
                for (int bj = 0; bj < 2; ++bj) hv[ai][m][bj] = *(const u32x4*)(h1c + (tok * 1024u + colb + 32u * bj) * 2u); }
        EPI_FENCE();
#pragma unroll
        for (int ai = 0; ai < 2; ++ai) {
#pragma unroll
            for (int m = 0; m < 4; ++m) { const int tok = tk[ai][m];
                const unsigned eoff = tok >= 0 ? (unsigned)tok * 1024u + colb : (unsigned)((WS_DUMMY - WS_H2B) / 2) + (colb & 1023u);
#pragma unroll
                for (int bj = 0; bj < 2; ++bj) { const u32x4 w = hv[ai][m][bj];
                    const f32x4 a = (f32x4){bflo(w.x), bfhi(w.x), bflo(w.y), bfhi(w.y)}, b = (f32x4){bflo(w.z), bfhi(w.z), bflo(w.w), bfhi(w.w)};
                    st8((bf16_t*)(h2c + (eoff + 32u * bj) * 2u), a + acc[ai][bj][m][0], b + acc[ai][bj][m][1]); } }
            EPI_FENCE(); }
    }
};
struct EpiFinal {
    const bf16_t *H2B, *E; const float* ssq_e; const LAS float* tb; float* out;
    __device__ __forceinline__ void operator()(const AccT& acc, const pg8::Unit& u, int wr, int wc, int fr, int fq) const {
        const unsigned colb = 256u * u.pn + 64u * wc + 8u * fq;
        const unsigned rowb = (unsigned)u.pm * 256u + wr * 64u + fr, offb = rowb * 1024u + colb;
        const char* const h2c = (const char*)H2B; const char* const ec = (const char*)E; const char* const sqc = (const char*)ssq_e; char* const oc = (char*)out;
        u32x4 hv[2][4][2]; u32x2 ev[2][4][2]; float sq[2][4]; unsigned sp[2][2][4][4];
#define EPIF_OFF(ai, m, bj) (offb + (unsigned)((ai) * 128 + (m) * 16) * 1024u + 32u * (bj))
#define EPIF_LOAD_E(ai) do { _Pragma("unroll") for (int m = 0; m < 4; ++m) { sq[ai][m] = *(const float*)(sqc + (rowb + (ai) * 128 + m * 16) * 4u); \
            _Pragma("unroll") for (int bj = 0; bj < 2; ++bj) ev[ai][m][bj] = *(const u32x2*)(ec + EPIF_OFF(ai, m, bj)); } } while (0)
#define EPIF_LOAD_H(ai) do { _Pragma("unroll") for (int m = 0; m < 4; ++m) _Pragma("unroll") for (int bj = 0; bj < 2; ++bj) hv[ai][m][bj] = *(const u32x4*)(h2c + EPIF_OFF(ai, m, bj) * 2u); } while (0)
        EPIF_LOAD_E(0); EPIF_LOAD_E(1);
        __builtin_amdgcn_sched_barrier(0);
#pragma unroll
        for (int bj = 0; bj < 2; ++bj) {
            const f32x4 bp0 = *(const LAS f32x4*)(tb + colb + 32 * bj), bp1 = *(const LAS f32x4*)(tb + colb + 32 * bj + 4);
#pragma unroll
            for (int ai = 0; ai < 2; ++ai)
#pragma unroll
                for (int m = 0; m < 4; ++m) {
                    const f32x4 z0 = acc[ai][bj][m][0] * (-LOG2E) + bp0, z1 = acc[ai][bj][m][1] * (-LOG2E) + bp1;
                    f32x4 s0, s1;
#pragma unroll
                    for (int e = 0; e < 4; ++e) { s0[e] = frcp(1.0f + fexp2(z0[e])); s1[e] = frcp(1.0f + fexp2(z1[e])); }
                    sp[ai][bj][m][0] = pk2(s0[0], s0[1]); sp[ai][bj][m][1] = pk2(s0[2], s0[3]); sp[ai][bj][m][2] = pk2(s1[0], s1[1]); sp[ai][bj][m][3] = pk2(s1[2], s1[3]); __builtin_amdgcn_sched_barrier(0); }
            __builtin_amdgcn_sched_barrier(0); }
        EPIF_LOAD_H(0); __builtin_amdgcn_sched_barrier(0); EPIF_LOAD_H(1);
        __builtin_amdgcn_sched_barrier(0);
#pragma unroll
        for (int ai = 0; ai < 2; ++ai) {
#pragma unroll
            for (int bj = 0; bj < 2; ++bj) {
                const f32x4 gn0 = *(const LAS f32x4*)(tb + 1024 + colb + 32 * bj), gn1 = *(const LAS f32x4*)(tb + 1024 + colb + 32 * bj + 4);
#pragma unroll
                for (int m = 0; m < 4; ++m) { const float re = rsq(sq[ai][m] * (1.f / 1024.f) + EPS); const u32x4 hw = hv[ai][m][bj]; const u32x2 ew = ev[ai][m][bj];
                    const unsigned* q = sp[ai][bj][m];
                    const f32x4 h0 = (f32x4){bflo(hw.x), bfhi(hw.x), bflo(hw.y), bfhi(hw.y)}, h1 = (f32x4){bflo(hw.z), bfhi(hw.z), bflo(hw.w), bfhi(hw.w)};
                    const f32x2 ea = __builtin_amdgcn_cvt_pk_f32_fp8((int)ew.x, false), eb = __builtin_amdgcn_cvt_pk_f32_fp8((int)ew.x, true), ec2 = __builtin_amdgcn_cvt_pk_f32_fp8((int)ew.y, false), ed = __builtin_amdgcn_cvt_pk_f32_fp8((int)ew.y, true);
                    const f32x4 e0 = (f32x4){ea[0], ea[1], eb[0], eb[1]} * gn0 * re, e1 = (f32x4){ec2[0], ec2[1], ed[0], ed[1]} * gn1 * re;
                    const f32x4 g0 = (f32x4){bflo(q[0]), bfhi(q[0]), bflo(q[1]), bfhi(q[1])}, g1 = (f32x4){bflo(q[2]), bfhi(q[2]), bflo(q[3]), bfhi(q[3])};
                    char* o = oc + EPIF_OFF(ai, m, bj) * 4u;
                    *(f32x4*)o = h0 + g0 * e0; *(f32x4*)(o + 16) = h1 + g1 * e1; __builtin_amdgcn_sched_barrier(0); } }
            __builtin_amdgcn_sched_barrier(0); }
#undef EPIF_LOAD_E
#undef EPIF_LOAD_H
#undef EPIF_OFF
    }
};

struct MoeSchedUp {
    const LAS int* tinfoE; int T, G, c; const char* A; const char* W; const unsigned* rowoff;
    __device__ __forceinline__ bool next(int i, pg8::Unit& u) const { const int nun = T * 4, L = i * G + c; if (L >= nun) return false; const int w = pg8::xcd_remap(L, nun); u.pm = w >> 2; u.pn = w & 3; return true; }
    __device__ __forceinline__ const char* a_base(const pg8::Unit&) const { return A; }
    __device__ __forceinline__ const char* b_base(const pg8::Unit& u) const { const int e = tinfoE[u.pm]; return W + (size_t)e * (1024 * 1024 * 2) + (size_t)u.pn * (256 * 1024 * 2); }
    __device__ __forceinline__ const char* b_base2(const pg8::Unit& u) const { return b_base(u); }
    __device__ __forceinline__ const unsigned* a_rowptr(const pg8::Unit& u, int r) const { return rowoff + u.pm * 256 + r; }
};
struct MoeSchedDown {
    const LAS int* tinfo; int T, G, c; const char* A; const char* W;
    __device__ __forceinline__ bool next(int i, pg8::Unit& u) const { const int nun = T * 4, L = i * G + c; if (L >= nun) return false; const int w = pg8::xcd_remap(L, nun); u.pm = w >> 2; u.pn = w & 3; return true; }
    __device__ __forceinline__ const char* a_base(const pg8::Unit& u) const { return A + (size_t)u.pm * (256 * 1024 * 2); }
    __device__ __forceinline__ const char* b_base(const pg8::Unit& u) const { const int e = tinfo[u.pm] >> 8; return W + (size_t)e * (1024 * 512 * 2) + (size_t)u.pn * (256 * 512 * 2); }
    __device__ __forceinline__ const char* b_base2(const pg8::Unit& u) const { const int e = tinfo[u.pm] & 255; return W + (size_t)e * (1024 * 512 * 2) + (size_t)u.pn * (256 * 512 * 2); }
    __device__ __forceinline__ const unsigned* a_rowptr(const pg8::Unit&, int) const { return nullptr; }
};

#ifndef MK_REPEAT
#define MK_REPEAT 0
#endif
#define WSP(T, off) ((T*)(F.ws + (off)))
__device__ __forceinline__ void phase1(Frame& F, const Args& args) {
    {
        pg8::DenseSched S; S.init(WSP(const bf16_t, WS_XB), WSP(const bf16_t, WS_WIN), M, INC_PAD, 1024, F.G, (int)blockIdx.x, WGM_INPROJ); S.rs = WSP(const float, WS_RSTD1);
        EpiInProj E{WSP(bf16_t, WS_QA), WSP(bf16_t, WS_KA), WSP(bf16_t, WS_VA), WSP(bf16_t, WS_CQ), WSP(bf16_t, WS_CKV), WSP(bf16_t, WS_KROPE),
                    WSP(float, WS_SSQCQ), WSP(float, WS_SSQCKV), args.in[I_QNA], args.in[I_KNA], args.in[I_KNR], WSP(const float, WS_ROPE)};
        pg8::gemm_phase<EpiInProj, pg8::DenseSched, false, false, true>(F.lds, 1024, S, E);
    }
}
__device__ __forceinline__ void phase2(Frame& F, const Args& args) {
    {
        pg8::DenseSched S; S.init(WSP(const bf16_t, WS_CQ), WSP(const bf16_t, WS_WQUP), M, 768, 384, F.G, (int)blockIdx.x);
        EpiQup E{WSP(bf16_t, WS_QM), WSP(const float, WS_SSQCQ), args.in[I_QNN], args.in[I_QNR], WSP(const float, WS_ROPE)};
        pg8::gemm_phase<EpiQup, pg8::DenseSched, false, false>(F.lds, 384, S, E);
    }
    {
        pg8::DenseSched S; S.init(WSP(const bf16_t, WS_CKV), WSP(const bf16_t, WS_WKVUP), M, 1024, 256, F.G, (int)blockIdx.x);
        EpiKVup E{WSP(bf16_t, WS_KN), WSP(bf16_t, WS_VM), WSP(const float, WS_SSQCKV), args.in[I_KNN]};
        pg8::gemm_phase<EpiKVup, pg8::DenseSched, false, false>(F.lds, 256, S, E);
    }
}
__device__ __forceinline__ void phase3(Frame& F, const Args& args) {
    LAS char* shm = (LAS char*)F.lds;
    LAS float* tbl = (LAS float*)(F.lds + TB_OFF);
    if (F.G == 256) {
        const int xcd = F.vcu >> 5, jj = F.vcu & 31, grp = jj >> 2, k = jj & 3;
        for (int r = 0; r < 4; ++r) {
            const int bh = 32 * xcd + 8 * r + grp, b = bh >> 3, h = bh & 7;
#if (MK_REPEAT >> 12) & 7
            for (int q = 0; q < 2; ++q) att::mla_unit<(MK_REPEAT >> 12) & 7>(b, h, q ? k : 7 - k, WSP(const bf16_t, WS_QM), WSP(const bf16_t, WS_KN), WSP(const bf16_t, WS_KROPE), WSP(const bf16_t, WS_VM), WSP(bf16_t, WS_O2), shm);
#endif
            for (int q = 0; q < (((MK_REPEAT >> 10) & 1) ? 4 : 2); ++q)
                att::mla_unit<0>(b, h, (q & 1) ? k : 7 - k, WSP(const bf16_t, WS_QM), WSP(const bf16_t, WS_KN), WSP(const bf16_t, WS_KROPE), WSP(const bf16_t, WS_VM), (bf16_t*)args.out, shm);
        }
    } else {
        for (int bh = F.vcu; bh < BATCH * 8; bh += F.G)
            for (int qb = 0; qb < 8; ++qb)
                att::mla_unit<0>(bh >> 3, bh & 7, qb, WSP(const bf16_t, WS_QM), WSP(const bf16_t, WS_KN), WSP(const bf16_t, WS_KROPE), WSP(const bf16_t, WS_VM), (bf16_t*)args.out, shm);
    }
    for (int bh = F.vcu; bh < BATCH * 8; bh += F.G) {
        const int b = bh >> 3, h = bh & 7;
        for (int i = F.tid; i < 960; i += 512) tbl[i] = WSP(const float, WS_TBG)[(i / 320) * 2560 + h * 320 + (i % 320)];
        __syncthreads();
#if (MK_REPEAT >> 16) & 7
        att::dil_phase2<(MK_REPEAT >> 16) & 7>(b, h, WSP(const bf16_t, WS_QA), WSP(const bf16_t, WS_KA), WSP(const bf16_t, WS_VA), WSP(bf16_t, WS_O2), WSP(bf16_t, WS_O3),
                            WSP(float, WS_LSE2), WSP(float, WS_LSE3), (bf16_t*)args.out, shm, tbl);
#endif
        for (int rep = 0; rep < (((MK_REPEAT >> 11) & 1) ? 2 : 1); ++rep)
            att::dil_phase2<0>(b, h, WSP(const bf16_t, WS_QA), WSP(const bf16_t, WS_KA), WSP(const bf16_t, WS_VA), WSP(bf16_t, WS_O2), WSP(bf16_t, WS_O3),
                            WSP(float, WS_LSE2), WSP(float, WS_LSE3), (bf16_t*)args.out, shm, tbl);
        __syncthreads();
    }
}
__device__ __forceinline__ void phase4(Frame& F, const Args& args) {
#if (MK_REPEAT >> 18) & 1
    { pg8::DenseSched S; S.init((const bf16_t*)args.out, WSP(const bf16_t, WS_WOUT), M, 1024, 1024, F.G, (int)blockIdx.x);
      EpiNull E{WSP(float, WS_RSTD2)}; pg8::gemm_phase<EpiNull, pg8::DenseSched, false, false>(F.lds, 1024, S, E); }
#endif
    pg8::DenseSched S; S.init((const bf16_t*)args.out, WSP(const bf16_t, WS_WOUT), M, 1024, 1024, F.G, (int)blockIdx.x);
    EpiWout E{WSP(const bf16_t, WS_XB), WSP(bf16_t, WS_H1B), WSP(float, WS_SSQH1)};
    pg8::gemm_phase<EpiWout, pg8::DenseSched, false, false>(F.lds, 1024, S, E);
}
__device__ __forceinline__ void phase5(Frame& F, const Args& args) {
    pg8::DenseSched S; S.init(WSP(const bf16_t, WS_H1B), WSP(const bf16_t, WS_WR), M, 256, 1024, F.G, (int)blockIdx.x);
    EpiRoute E{WSP(const float, WS_SSQH1), args.in[I_BRG], args.in[I_BRE], WSP(float, WS_RSTD2), WSP(i32x4, WS_ROUTE), F.ctl + CW_CNT};
    pg8::gemm_phase<EpiRoute, pg8::DenseSched, false, false>(F.lds, 1024, S, E);
}
__device__ __forceinline__ int pair_index(int g, int x, int y) { const int a = x < y ? x : y, b = x < y ? y : x; return g * 28 + (a * (15 - a)) / 2 + (b - a - 1); }
__device__ __forceinline__ void phase6(Frame& F, const Args& args) {
    LAS int* mo_cnt = (LAS int*)(F.lds + MOE_OFF); LAS int* mo_start = mo_cnt + 128; LAS int* tinfo = mo_cnt + 256;
    LAS int* e_cnt = (LAS int*)(F.lds + MOE_E_OFF); LAS int* e_start = e_cnt + 32; LAS int* tinfoE = e_cnt + 96;
    LAS int* offA = (LAS int*)(F.lds + MOE_O_OFF); LAS int* offB = offA + 128;
    if (F.tid < NPAIR) mo_cnt[F.tid] = (int)__hip_atomic_load(F.ctl + CW_CNT + 16 * F.tid, RLX_AGENT);
    __syncthreads();
    if (F.tid == 0) { int acc = 0; for (int p = 0; p < NPAIR; ++p) { mo_start[p] = acc; acc += (mo_cnt[p] + 255) >> 8; } mo_start[NPAIR] = acc; }
    if (F.tid >= 128 && F.tid < 128 + NEXP) { const int e = F.tid - 128, g = e >> 3, x = e & 7; int s = 0; for (int y = 0; y < 8; ++y) if (y != x) s += mo_cnt[pair_index(g, x, y)]; e_cnt[e] = s; }
    if (F.tid >= 256 && F.tid < 256 + NPAIR) { const int p = F.tid - 256, g = p / 28, q = p % 28; int ea = 0; while (ea < 6 && ((ea + 1) * (14 - ea)) / 2 <= q) ++ea; const int eb = ea + 1 + (q - (ea * (15 - ea)) / 2);
        int sa = 0, sb = 0;
        for (int y = 0; y < 8; ++y) { if (y != ea) { const int pp = pair_index(g, ea, y); if (pp < p) sa += mo_cnt[pp]; } if (y != eb) { const int pp = pair_index(g, eb, y); if (pp < p) sb += mo_cnt[pp]; } }
        offA[p] = sa; offB[p] = sb; }
    __syncthreads();
    if (F.tid == 64) { int acc = 0; for (int e = 0; e < NEXP; ++e) { e_start[e] = acc; acc += (e_cnt[e] + 255) >> 8; } e_start[NEXP] = acc; }
    if (F.tid < NPAIR) { const int p = F.tid, g = p / 28, q = p % 28; int ea = 0; while (ea < 6 && ((ea + 1) * (14 - ea)) / 2 <= q) ++ea; const int eb = ea + 1 + (q - (ea * (15 - ea)) / 2);
        const int info = ((8 * g + ea) << 8) | (8 * g + eb); const int t0 = mo_start[p], t1 = mo_start[p + 1]; for (int t = t0; t < t1; ++t) tinfo[t] = info; }
    __syncthreads();
    if (F.tid >= 128 && F.tid < 128 + NEXP) { const int e = F.tid - 128; const int t0 = e_start[e], t1 = e_start[e + 1]; for (int t = t0; t < t1; ++t) tinfoE[t] = e; }
    __syncthreads();
    const i32x4* route = WSP(const i32x4, WS_ROUTE); const float* rstd2 = WSP(const float, WS_RSTD2);
    i32x4* rowrec = WSP(i32x4, WS_ROWREC); i32x4* rowrec2 = WSP(i32x4, WS_ROWREC2); unsigned* rowoff2 = WSP(unsigned, WS_ROWOFF2);
    for (int tok = F.vcu * 512 + F.tid; tok < M; tok += F.G * 512) { const i32x4 r = route[tok]; const int p = r.x; const int prow = (mo_start[p] << 8) + r.y; const int rs = (int)__float_as_uint(rstd2[tok]);
        rowrec[prow] = (i32x4){tok, rs, r.z, r.w};
        const int info = tinfo[mo_start[p]]; const int xa = info >> 8, xb = info & 255;
        const int ra = (e_start[xa] << 8) + offA[p] + r.y, rb = (e_start[xb] << 8) + offB[p] + r.y;
        rowrec2[ra] = (i32x4){tok, rs, r.z, 2 * prow}; rowoff2[ra] = (unsigned)tok * 2048u;
        rowrec2[rb] = (i32x4){tok, rs, r.w, 2 * prow + 1}; rowoff2[rb] = (unsigned)tok * 2048u; }
}
__device__ __forceinline__ void phase7(Frame& F, const Args& args) {
    const LAS int* e_start = (const LAS int*)(F.lds + MOE_E_OFF) + 32; const LAS int* tinfoE = (const LAS int*)(F.lds + MOE_E_OFF) + 96;
    MoeSchedUp S{tinfoE, e_start[NEXP], F.G, (int)blockIdx.x, WSP(const char, WS_H1B), WSP(const char, WS_WGU), WSP(const unsigned, WS_ROWOFF2)};
    EpiGateUp E{WSP(const i32x4, WS_ROWREC2), WSP(bf16_t, WS_HDN)};
    pg8::gemm_phase<EpiGateUp, MoeSchedUp, true, false>(F.lds, 1024, S, E);
    if (!WD_IN_P0) {
        const int rem = (e_start[NEXP] * 4) % F.G, c = (int)blockIdx.x;
        if (rem == 0) convert_wd(F, args, c, F.G); else if (c >= rem) convert_wd(F, args, c - rem, F.G - rem);
    }
}
__device__ __forceinline__ void phase8(Frame& F, const Args& args) {
    const LAS int* mo_start = (const LAS int*)(F.lds + MOE_OFF) + 128; const LAS int* tinfo = (const LAS int*)(F.lds + MOE_OFF) + 256;
    MoeSchedDown S{tinfo, mo_start[NPAIR], F.G, (int)blockIdx.x, WSP(const char, WS_HDN), WSP(const char, WS_WD)};
    EpiDown E{WSP(const i32x4, WS_ROWREC), WSP(const bf16_t, WS_H1B), WSP(bf16_t, WS_H2B)};
    pg8::gemm_phase<EpiDown, MoeSchedDown, false, true>(F.lds, 1024, S, E);
    {
        pg8::DenseSched S2; S2.init((const bf16_t*)((const char*)args.out + PB_IN_OUT), WSP(const bf16_t, WS_WPP), M, 1024, 256, F.G, (int)blockIdx.x);
        EpiRawSsq E2{WSP(unsigned char, WS_E), WSP(float, WS_SSQE)};
        pg8::gemm_phase<EpiRawSsq, pg8::DenseSched, false, false>(F.lds, 256, S2, E2);
    }
}
#ifndef MK_STAGGER9
#define MK_STAGGER9 0
#endif
__device__ __forceinline__ void stagger_start(unsigned ticks) {
    if (ticks) { const unsigned long long t0 = __builtin_amdgcn_s_memrealtime(); while (__builtin_amdgcn_s_memrealtime() - t0 < (unsigned long long)ticks) __builtin_amdgcn_s_sleep(16); }
}
__device__ __forceinline__ void phase9(Frame& F, const Args& args, const bf16_t* Esrc) {
    stagger_start(((blockIdx.x >> 3) & 3) * MK_STAGGER9);
    pg8::DenseSched S; S.init(WSP(const bf16_t, WS_H2B), WSP(const bf16_t, WS_WPG), M, 1024, 1024, F.G, (int)blockIdx.x);
    LAS float* tb = (LAS float*)(F.lds + TB_OFF);
    for (int i = F.tid; i < 1024; i += 512) { tb[i] = args.in[I_BPG][i] * (-LOG2E); tb[1024 + i] = args.in[I_PNG][i]; }
    __syncthreads();
    EpiFinal E{WSP(const bf16_t, WS_H2B), Esrc, WSP(const float, WS_SSQE), tb, args.out};
    pg8::gemm_phase<EpiFinal, pg8::DenseSched, false, false>(F.lds, 1024, S, E);
}

__global__ void __launch_bounds__(512, 2) hybrid_fwd(Args args) {
    extern __shared__ __attribute__((aligned(16))) unsigned char lds_raw[];
    Frame F;
    F.lds = (LAS unsigned char*)lds_raw;
    F.MISC = (volatile LAS unsigned*)(F.lds + MISC_OFF);
    F.tid = threadIdx.x; F.lane = F.tid & 63; F.wave = __builtin_amdgcn_readfirstlane(F.tid >> 6);
    F.G = gridDim.x; { const int bx = blockIdx.x; F.vcu = (F.G % 8 == 0) ? (bx % 8) * (F.G / 8) + bx / 8 : bx; }
    F.ws = args.ws; F.ctl = (unsigned*)(args.ws + WS_CTL);
    for (int u = F.tid; u < 128; u += 512) ((LAS unsigned*)(F.lds + MISC_OFF))[u] = 0u;
    __syncthreads();
    XcdBarrier bar = xcd_barrier_post(F.ctl + CW_BAR, F.MISC + 8);
#define RUN(k, call) do { call; if ((MK_REPEAT >> (k)) & 1) { xcd_barrier(bar); call; } } while (0)
    RUN(0, p0_prologue(F, args)); xcd_barrier(bar);
    RUN(1, phase1(F, args)); xcd_barrier(bar);
    RUN(2, phase2(F, args)); xcd_barrier(bar);
    RUN(3, phase3(F, args)); xcd_barrier(bar);
    RUN(4, phase4(F, args)); xcd_barrier(bar);
    phase5(F, args); xcd_barrier(bar);
    phase6(F, args); xcd_barrier(bar);
    RUN(7, phase7(F, args)); xcd_barrier(bar);
    RUN(8, phase8(F, args)); xcd_barrier(bar);
    phase9(F, args, WSP(const bf16_t, WS_E));
#undef RUN
}

extern "C" void kernel_launch(void* const* d_in, const int* in_sizes, int n_in, void* d_out, int out_size, void* d_ws, size_t ws_size, hipStream_t stream) {
    static int grid = 0;
    if (grid == 0) {
        if (n_in != 28 || in_sizes[0] != M * DM || out_size != M * DM || ws_size < WS_END) { fprintf(stderr, "kernel_launch: unexpected problem (n_in %d, in0 %d, out %d, ws %zu); nothing launched\n", n_in, n_in > 0 ? in_sizes[0] : -1, out_size, ws_size); grid = -1; return; }
        int dev = 0, cus = 0, per_cu = 0;
        if (hipGetDevice(&dev) != hipSuccess || hipDeviceGetAttribute(&cus, hipDeviceAttributeMultiprocessorCount, dev) != hipSuccess) { grid = -1; return; }
        if (hipFuncSetAttribute((const void*)hybrid_fwd, hipFuncAttributeMaxDynamicSharedMemorySize, LDS_BYTES) != hipSuccess) { fprintf(stderr, "kernel_launch: hipFuncSetAttribute failed\n"); grid = -1; return; }
        if (hipOccupancyMaxActiveBlocksPerMultiprocessor(&per_cu, (const void*)hybrid_fwd, 512, LDS_BYTES) != hipSuccess || per_cu < 1) { fprintf(stderr, "kernel_launch: occupancy query reports %d workgroups per CU\n", per_cu); }
        (void)hipGetLastError();
        grid = cus;
    }
    if (grid < 0) return;
    if (hipMemsetAsync((char*)d_ws + WS_CTL, 0, CTL_ZERO_BYTES, stream) != hipSuccess) return;
    Args a{};
    for (int i = 0; i < 28; ++i) a.in[i] = (const float*)d_in[i];
    a.out = (float*)d_out; a.ws = (unsigned char*)d_ws;
    hipLaunchKernelGGL(hybrid_fwd, dim3(grid), dim3(512), LDS_BYTES, stream, a);
}
```

```cpp
#ifndef MK_REPEAT
#define MK_REPEAT 0
#endif
#ifndef WGM_INPROJ
#define WGM_INPROJ 8
#endif
#include <hip/hip_runtime.h>
#include <cstdio>
#include <cstdint>

#define LAS __attribute__((address_space(3)))
#define GAS __attribute__((address_space(1)))
typedef unsigned short bf16_t;
typedef short bf16x8 __attribute__((ext_vector_type(8)));
typedef short s16x4 __attribute__((ext_vector_type(4)));
typedef short v4i16_t __attribute__((ext_vector_type(4)));
typedef float f32x4 __attribute__((ext_vector_type(4)));
typedef float f32x2 __attribute__((ext_vector_type(2)));
typedef float f32x16 __attribute__((ext_vector_type(16)));
typedef unsigned u32x4 __attribute__((ext_vector_type(4)));
typedef unsigned u32x2 __attribute__((ext_vector_type(2)));
typedef int i32x4 __attribute__((ext_vector_type(4)));
typedef __bf16 bf16x2_t __attribute__((ext_vector_type(2)));

constexpr int BATCH = 32, SEQ = 2048, DM = 1024, M = BATCH * SEQ;
constexpr int PLE = 256;
constexpr int AW = 512, QLORA = 384, KVLORA = 256, ROPE = 32;
constexpr int INC = 2208, INC_PAD = 2304;
constexpr int NEXP = 32, EFF = 512, NPAIR = 112;
constexpr int MAXT = 368;
constexpr int MAXTE = 544;
constexpr float EPS = 1e-6f;
constexpr float LOG2E = 1.4426950408889634f;
constexpr float C2A = 0.125f * LOG2E;
constexpr float C2M = 0.10206207261596575f * LOG2E;

constexpr size_t MiB = 1u << 20;
constexpr size_t WS_CTL = 0, CTL_ZERO_BYTES = 1 * MiB;
constexpr size_t WS_TBG = 1 * MiB;
constexpr size_t WS_ROPE = 1 * MiB + 65536;
constexpr size_t WS_ROWREC = 2 * MiB;
constexpr size_t WS_ROWOFF = 3 * MiB + 524288;
constexpr size_t WS_ROUTE = 4 * MiB;
constexpr size_t WS_RSTD2 = 5 * MiB;
constexpr size_t WS_RSTD1 = 5 * MiB + 524288;
constexpr size_t WS_SSQCQ = 6 * MiB;
constexpr size_t WS_SSQCKV = 8 * MiB;
constexpr size_t WS_SSQH1 = 9 * MiB;
constexpr size_t WS_SSQE = 13 * MiB;
constexpr size_t WS_LSE2 = 17 * MiB;
constexpr size_t WS_LSE3 = 19 * MiB;
constexpr size_t WS_ROWREC2 = 13 * MiB + 524288;
constexpr size_t WS_ROWOFF2 = 16 * MiB;
constexpr size_t WS_KROPE = 21 * MiB;
constexpr size_t WS_WIN = 25 * MiB;
constexpr size_t WS_WQUP = 30 * MiB;
constexpr size_t WS_WKVUP = 31 * MiB;
constexpr size_t WS_WR = 32 * MiB;
constexpr size_t WS_WOUT = 33 * MiB;
constexpr size_t WS_WPP = 35 * MiB;
constexpr size_t WS_WPG = 36 * MiB;
constexpr size_t WS_WGU = 40 * MiB;
constexpr size_t WS_WD = 104 * MiB;
constexpr size_t WS_XB = 136 * MiB;
constexpr size_t WS_QA = 264 * MiB, WS_KA = 328 * MiB, WS_VA = 392 * MiB;
constexpr size_t WS_HDN = 264 * MiB;
constexpr size_t WS_QM = 456 * MiB;
constexpr size_t WS_KN = 552 * MiB, WS_VM = 616 * MiB;
constexpr size_t WS_H2B = 456 * MiB;
constexpr size_t PB_IN_OUT = 128 * MiB;
constexpr size_t WS_CQ = 712 * MiB;
constexpr size_t WS_CKV = 760 * MiB;
constexpr size_t WS_O2 = 680 * MiB, WS_O3 = 744 * MiB;
constexpr size_t WS_H1B = 680 * MiB;
constexpr size_t WS_E = 808 * MiB;
constexpr size_t WS_DUMMY = 936 * MiB;
constexpr size_t WS_END = 937 * MiB;
constexpr int CW_BAR = 4096;
constexpr int CW_CNT = 16384;

constexpr int RING_BYTES = 131072;
constexpr int ATT_WSF = 102400;
constexpr int ATT_OST = 106496;
constexpr int MISC_OFF = 139264;
constexpr int TB_OFF = MISC_OFF + 512;
constexpr int MOE_OFF = TB_OFF + 3840;
constexpr int LDS_BYTES = 151552;
constexpr int MOE_E_OFF = MOE_OFF + 128 * 4 * 2 + MAXT * 4;
constexpr int MOE_O_OFF = MOE_E_OFF + 96 * 4 + MAXTE * 4;
static_assert(MOE_O_OFF + 256 * 4 <= LDS_BYTES && TB_OFF + 8192 <= LDS_BYTES, "LDS map");

#define LDS_WAIT() asm volatile("s_waitcnt lgkmcnt(0)" ::: "memory")
#define VM_WAIT() asm volatile("s_waitcnt vmcnt(0)" ::: "memory")
#define RLX_AGENT __ATOMIC_RELAXED, __HIP_MEMORY_SCOPE_AGENT

__device__ __forceinline__ unsigned pk2(float lo, float hi) { f32x2 v = {lo, hi}; bf16x2_t b = __builtin_convertvector(v, bf16x2_t); return __builtin_bit_cast(unsigned, b); }
__device__ __forceinline__ float bflo(unsigned u) { return __uint_as_float(u << 16); }
__device__ __forceinline__ float bfhi(unsigned u) { return __uint_as_float(u & 0xffff0000u); }
__device__ __forceinline__ void st8(bf16_t* p, f32x4 a, f32x4 b) { u32x4 w; w.x = pk2(a[0], a[1]); w.y = pk2(a[2], a[3]); w.z = pk2(b[0], b[1]); w.w = pk2(b[2], b[3]); *(u32x4*)p = w; }
__device__ __forceinline__ void ld8(const bf16_t* p, f32x4& a, f32x4& b) { const u32x4 w = *(const u32x4*)p; a = (f32x4){bflo(w.x), bfhi(w.x), bflo(w.y), bfhi(w.y)}; b = (f32x4){bflo(w.z), bfhi(w.z), bflo(w.w), bfhi(w.w)}; }
__device__ __forceinline__ float dot4(f32x4 a) { return (a[0] * a[0] + a[1] * a[1]) + (a[2] * a[2] + a[3] * a[3]); }
__device__ __forceinline__ float red_fq(float s) { s += __shfl_xor(s, 16); s += __shfl_xor(s, 32); return s; }
__device__ __forceinline__ float rsq(float x) { return __builtin_amdgcn_rsqf(x); }
__device__ __forceinline__ float fexp2(float x) { return __builtin_amdgcn_exp2f(x); }
__device__ __forceinline__ float frcp(float x) { return __builtin_amdgcn_rcpf(x); }

namespace pg8 {
constexpr int BM = 256, BK = 64, HALF = 128, HTB = HALF * BK * 2, STAGE_BYTES = 8 * HTB, NXCD = 8, WGM = 8;
__host__ __device__ __forceinline__ int lds_byte(int r, int c) { const int st = (r >> 4) * 2 + (c >> 5), rr = r & 15, cc = c & 31, ob = rr * 64 + cc * 2; return st * 1024 + (ob ^ (((ob >> 9) & 1) << 5)); }
__host__ __device__ __forceinline__ void stage_rc(int b, int& R, int& C) { const int st = b / 1024, sb = b % 1024, swz = sb ^ (((sb >> 9) & 1) << 5); R = (st >> 1) * 16 + swz / 64; C = (st & 1) * 32 + (swz % 64) / 2; }
__host__ __device__ __forceinline__ int perm32(int rho) { const int n = rho >> 4, i = rho & 15; return 8 * (i >> 2) + 4 * n + (i & 3); }
struct Unit { int pm, pn; };

__device__ __forceinline__ int xcd_remap(int L, int nwg) { const int q = nwg / NXCD, r = nwg % NXCD, xcd = L % NXCD, off = L / NXCD; return (xcd < r ? xcd * (q + 1) : r * (q + 1) + (xcd - r) * q) + off; }
struct DenseSched {
    const char* A; const char* Bt; const float* rs = nullptr; int K, nM, nN, nwg, G, c, wgm;
    __device__ __forceinline__ void init(const bf16_t* A_, const bf16_t* Bt_, int Mr, int N, int K_, int G_, int c_, int wgm_ = WGM) { A = (const char*)A_; Bt = (const char*)Bt_; K = K_; nM = Mr / BM; nN = N / BM; nwg = nM * nN; G = G_; c = c_; wgm = wgm_; }
    __device__ __forceinline__ bool next(int i, Unit& u) const {
        const int L = i * G + c; if (L >= nwg) return false;
        const int wgid = xcd_remap(L, nwg);
        const int nig = wgm * nN, gid = wgid / nig, fm = gid * wgm, gsz = (nM - fm) < wgm ? (nM - fm) : wgm;
        u.pm = fm + ((wgid % nig) % gsz); u.pn = (wgid % nig) / gsz; return true;
    }
    __device__ __forceinline__ const char* a_base(const Unit& u) const { return A + (size_t)u.pm * ((size_t)BM * K * 2); }
    __device__ __forceinline__ const char* b_base(const Unit& u) const { return Bt + (size_t)u.pn * ((size_t)BM * K * 2); }
    __device__ __forceinline__ const char* b_base2(const Unit& u) const { return b_base(u); }
    __device__ __forceinline__ const unsigned* a_rowptr(const Unit&, int) const { return nullptr; }
};
__device__ __forceinline__ unsigned gld_untracked(const unsigned* p) { unsigned r; asm volatile("global_load_dword %0, %1, off" : "=&v"(r) : "v"(p) : "memory"); return r; }

template <class Epi, class Sched, bool GATHER, bool BSPLIT, bool PRESCALE = false>
__device__ __forceinline__ void gemm_phase(LAS unsigned char* lds, const int K_, const Sched& S, const Epi& E) {
    int K = K_; asm volatile("" : "+s"(K));
    int tid_ = threadIdx.x; asm volatile("" : "+v"(tid_));
    const int tid = tid_, wid = __builtin_amdgcn_readfirstlane(tid >> 6), lane = tid & 63, wr = wid >> 2, wc = wid & 3, fr = lane & 15, fq = lane >> 4;
    const int nt = K / BK, nth = BSPLIT ? nt / 2 : nt, ldb = BSPLIT ? K / 2 : K;
    int Rr[2], Cc[2]; unsigned voffB[2];
#pragma unroll
    for (int i = 0; i < 2; ++i) { stage_rc(tid * 16 + i * 8192, Rr[i], Cc[i]); const int Rb = (Rr[i] & ~31) + perm32(Rr[i] & 31); voffB[i] = (unsigned)(Rb * ldb + Cc[i]) * 2u; }
    const size_t kstep = (size_t)(BK * 2);
    const size_t hstepB = (size_t)HALF * ldb * 2;
    const unsigned hstepA = (unsigned)HALF * (unsigned)K * 2u;
    const unsigned ldsw = (unsigned)wid * 1024u;
    const int aoff = lds_byte(wr * 64 + fr, fq * 8), boff = lds_byte(wc * 32 + fr, fq * 8);
#define PG8_SA(b, h) (((b) * 2 + (h)) * HTB)
#define PG8_SB(b, h) ((4 + (b) * 2 + (h)) * HTB)
#define PG8_STAGE(bufoff, gbase, o0, o1) do { \
        __builtin_amdgcn_global_load_lds((const unsigned*)((const char*)(gbase) + (o0)), (LAS unsigned*)(lds + (bufoff) + ldsw), 16, 0, 0); \
        __builtin_amdgcn_global_load_lds((const unsigned*)((const char*)(gbase) + (o1)), (LAS unsigned*)(lds + (bufoff) + ldsw + 8192), 16, 0, 0); } while (0)
#define PG8_STAGE_B(bufoff, gbase) PG8_STAGE(bufoff, gbase, voffB[0], voffB[1])
#define PG8_LDA(dst, b, h) do { _Pragma("unroll") for (int m = 0; m < 4; ++m) _Pragma("unroll") for (int k = 0; k < 2; ++k) dst[m][k] = *(const LAS bf16x8*)(lds + PG8_SA(b, h) + aoff + m * 2048 + k * 1024); } while (0)
#define PG8_LDB(dst, b, h) do { _Pragma("unroll") for (int n = 0; n < 2; ++n) _Pragma("unroll") for (int k = 0; k < 2; ++k) dst[n][k] = *(const LAS bf16x8*)(lds + PG8_SB(b, h) + boff + n * 2048 + k * 1024); } while (0)
#define PG8_MMA(ai, bj, At, Bt) do { __builtin_amdgcn_s_setprio(1); _Pragma("unroll") for (int m = 0; m < 4; ++m) _Pragma("unroll") for (int n = 0; n < 2; ++n) _Pragma("unroll") for (int k = 0; k < 2; ++k) \
        acc[ai][bj][m][n] = __builtin_amdgcn_mfma_f32_16x16x32_bf16(Bt[n][k], At[m][k], acc[ai][bj][m][n], 0, 0, 0); __builtin_amdgcn_s_setprio(0); } while (0)
#define PG8_WAIT_V(n) asm volatile("s_waitcnt vmcnt(" #n ")" ::: "memory")
#define PG8_WAIT_L(n) asm volatile("s_waitcnt lgkmcnt(" #n ")" ::: "memory")
#define PG8_BAR __builtin_amdgcn_s_barrier()
#define PG8_SCHED __builtin_amdgcn_sched_barrier(0)
    Unit cur, nxt; int ui = 0;
    if (!S.next(0, cur)) return;
    f32x4 acc[2][2][4][2];
#pragma unroll
    for (int a = 0; a < 2; ++a)
#pragma unroll
        for (int b = 0; b < 2; ++b)
#pragma unroll
            for (int m = 0; m < 4; ++m)
#pragma unroll
                for (int n = 0; n < 2; ++n) acc[a][b][m][n] = (f32x4){0.f, 0.f, 0.f, 0.f};
    bf16x8 At[4][2], B0[2][2], B1[2][2];
    unsigned oC[2][2], oN[2][2], rawN[2][2];
    if (GATHER) {
#pragma unroll
        for (int h = 0; h < 2; ++h)
#pragma unroll
            for (int i = 0; i < 2; ++i) rawN[h][i] = gld_untracked(S.a_rowptr(cur, Rr[i] + HALF * h));
        asm volatile("s_waitcnt vmcnt(0)" ::: "memory");
#pragma unroll
        for (int h = 0; h < 2; ++h)
#pragma unroll
            for (int i = 0; i < 2; ++i) { asm volatile("" : "+v"(rawN[h][i])); oC[h][i] = rawN[h][i] + (unsigned)Cc[i] * 2u; oN[h][i] = oC[h][i]; }
    } else {
#pragma unroll
        for (int h = 0; h < 2; ++h)
#pragma unroll
            for (int i = 0; i < 2; ++i) { oC[h][i] = (unsigned)(Rr[i] * K + Cc[i]) * 2u + (unsigned)h * hstepA; oN[h][i] = oC[h][i]; rawN[h][i] = 0u; }
    }
    const char* cA = S.a_base(cur); const char* cB = S.b_base(cur); const char* cB2 = S.b_base2(cur);
    PG8_STAGE_B(PG8_SB(0, 0), cB); PG8_STAGE_B(PG8_SB(0, 1), cB + hstepB); PG8_STAGE(PG8_SA(0, 0), cA, oC[0][0], oC[0][1]); PG8_STAGE(PG8_SA(0, 1), cA, oC[1][0], oC[1][1]);
    if (wr == 1) PG8_BAR;
    PG8_WAIT_V(2); PG8_BAR;
    PG8_STAGE_B(PG8_SB(1, 0), cB + kstep); PG8_STAGE(PG8_SA(1, 0), cA + kstep, oC[0][0], oC[0][1]); PG8_STAGE_B(PG8_SB(1, 1), cB + hstepB + kstep);
    PG8_WAIT_V(6); PG8_BAR;
    for (;;) {
        const bool has_next = S.next(ui + 1, nxt);
        const char* nA = has_next ? S.a_base(nxt) : cA; const char* nB = has_next ? S.b_base(nxt) : cB;
        if (GATHER) {
            if (has_next) {
#pragma unroll
                for (int h = 0; h < 2; ++h)
#pragma unroll
                    for (int i = 0; i < 2; ++i) rawN[h][i] = gld_untracked(S.a_rowptr(nxt, Rr[i] + HALF * h));
            }
        }
        for (int t = 0; t < nt; t += 2) {
            const bool last = (t == nt - 2);
            const char* a1 = cA + (size_t)(t + 1) * kstep;
            const char* a2 = last ? nA : cA + (size_t)(t + 2) * kstep;
            const char* b2 = last ? nB : ((BSPLIT && t + 2 >= nth) ? cB2 + (size_t)(t + 2 - nth) * kstep : cB + (size_t)(t + 2) * kstep);
            const char* a3 = a2 + kstep; const char* b3 = b2 + kstep;
            unsigned o2[2][2];
            if (GATHER && last && has_next) {
#pragma unroll
                for (int h = 0; h < 2; ++h)
#pragma unroll
                    for (int i = 0; i < 2; ++i) { asm volatile("" : "+v"(rawN[h][i])); oN[h][i] = rawN[h][i] + (unsigned)Cc[i] * 2u; }
            }
#pragma unroll
            for (int h = 0; h < 2; ++h)
#pragma unroll
                for (int i = 0; i < 2; ++i) o2[h][i] = (GATHER && last && has_next) ? oN[h][i] : oC[h][i];
            PG8_LDB(B0, 0, 0); PG8_LDB(B1, 0, 1); PG8_SCHED; PG8_LDA(At, 0, 0); PG8_STAGE(PG8_SA(1, 1), a1, oC[1][0], oC[1][1]);
            PG8_WAIT_V(8); PG8_WAIT_L(0); PG8_BAR; PG8_MMA(0, 0, At, B0); PG8_MMA(0, 1, At, B1); PG8_BAR; PG8_SCHED;
            PG8_LDA(At, 0, 1); PG8_STAGE_B(PG8_SB(0, 0), b2); PG8_STAGE_B(PG8_SB(0, 1), b2 + hstepB); PG8_STAGE(PG8_SA(0, 0), a2, o2[0][0], o2[0][1]);
            PG8_WAIT_V(8); PG8_WAIT_L(0); PG8_BAR; PG8_MMA(1, 0, At, B0); PG8_MMA(1, 1, At, B1); PG8_BAR; PG8_SCHED;
            PG8_LDB(B0, 1, 0); PG8_LDB(B1, 1, 1); PG8_SCHED; PG8_LDA(At, 1, 0); PG8_STAGE(PG8_SA(0, 1), a2, o2[1][0], o2[1][1]);
            PG8_WAIT_V(8); PG8_WAIT_L(0); PG8_BAR; PG8_MMA(0, 0, At, B0); PG8_MMA(0, 1, At, B1); PG8_BAR; PG8_SCHED;
            PG8_LDA(At, 1, 1); PG8_STAGE_B(PG8_SB(1, 0), b3); PG8_STAGE_B(PG8_SB(1, 1), b3 + hstepB); PG8_STAGE(PG8_SA(1, 0), a3, o2[0][0], o2[0][1]);
            PG8_WAIT_V(8); PG8_WAIT_L(0); PG8_BAR; PG8_MMA(1, 0, At, B0); PG8_MMA(1, 1, At, B1); PG8_BAR; PG8_SCHED;
        }
        float rsv[2][4];
        if constexpr (PRESCALE) {
#pragma unroll
            for (int a = 0; a < 2; ++a)
#pragma unroll
                for (int m = 0; m < 4; ++m) rsv[a][m] = *(const float*)((const char*)S.rs + (unsigned)(cur.pm * 256 + a * 128 + wr * 64 + m * 16 + fr) * 4u);
        }
        if (wr == 0) PG8_BAR;
        if constexpr (PRESCALE) {
#pragma unroll
            for (int a = 0; a < 2; ++a)
#pragma unroll
                for (int m = 0; m < 4; ++m)
#pragma unroll
                    for (int b = 0; b < 2; ++b)
#pragma unroll
                        for (int n = 0; n < 2; ++n) acc[a][b][m][n] *= rsv[a][m];
        }
        E(acc, cur, wr, wc, fr, fq);
        if (!has_next) break;
#pragma unroll
        for (int a = 0; a < 2; ++a)
#pragma unroll
            for (int b = 0; b < 2; ++b)
#pragma unroll
                for (int m = 0; m < 4; ++m)
#pragma unroll
                    for (int n = 0; n < 2; ++n) acc[a][b][m][n] = (f32x4){0.f, 0.f, 0.f, 0.f};
        cur = nxt; cA = nA; cB = nB; cB2 = S.b_base2(cur); ++ui;
        if (GATHER) {
#pragma unroll
            for (int h = 0; h < 2; ++h)
#pragma unroll
                for (int i = 0; i < 2; ++i) oC[h][i] = oN[h][i];
        }
        if (wr == 1) PG8_BAR;
    }
    PG8_WAIT_V(0);
    PG8_BAR;
#undef PG8_SA
#undef PG8_SB
#undef PG8_STAGE
#undef PG8_STAGE_B
#undef PG8_LDA
#undef PG8_LDB
#undef PG8_MMA
#undef PG8_WAIT_V
#undef PG8_WAIT_L
#undef PG8_BAR
#undef PG8_SCHED
}
}

namespace att {
#define SBAR() __builtin_amdgcn_sched_barrier(0)
typedef LAS const char* lds_cptr;
__device__ __forceinline__ int crow(int r, int hi) { return (r & 3) + 8 * (r >> 2) + 4 * hi; }
__device__ __forceinline__ int dslot(int rot, int j) { const int s = rot + j; return s >= 6 ? s - 6 : s; }
__device__ __forceinline__ void glds16(const void* gsrc, unsigned lds_dst) { unsigned keep;
    asm volatile("s_mov_b32 %0, m0\n\ts_mov_b32 m0, %2\n\ts_nop 0\n\tglobal_load_lds_dwordx4 %1, off\n\ts_mov_b32 m0, %0" : "=&s"(keep) : "v"(gsrc), "s"(lds_dst) : "memory"); }
__device__ __forceinline__ float max3f(float a, float b, float c) { return __builtin_fmaxf(__builtin_fmaxf(a, b), c); }
__device__ __forceinline__ float rowmax(const f32x16& p0, const f32x16& p1) {
    float a = max3f(p0[0], p0[1], p1[0]), b = max3f(p0[2], p0[3], p1[1]); a = max3f(a, p1[2], p1[3]);
#pragma unroll
    for (int r = 4; r < 16; r += 4) { a = max3f(a, p0[r], p0[r + 1]); b = max3f(b, p0[r + 2], p0[r + 3]); a = max3f(a, p1[r], p1[r + 1]); b = max3f(b, p1[r + 2], p1[r + 3]); }
    const float m = __builtin_fmaxf(a, b);
    auto rr = __builtin_amdgcn_permlane32_swap(__float_as_uint(m), __float_as_uint(m), false, false);
    return __builtin_fmaxf(__uint_as_float(rr[0]), __uint_as_float(rr[1]));
}
template <int ND, bool NOLDS = false> __device__ __forceinline__ void qkt(f32x16& p0, f32x16& p1, lds_cptr Kslot, const bf16x8* qr, const f32x16& negm, int r32, int hi) {
    lds_cptr kb = Kslot + r32 * 128; const int sw = (r32 & 7) ^ ((r32 >> 3) & 1); lds_cptr kr = Kslot + 8192 + r32 * 64; const int swr = (r32 >> 2) & 3;
    bf16x8 kf[2 * ND];
#pragma unroll
    for (int d0 = 0; d0 < ND; ++d0) {
        if (NOLDS) { kf[2 * d0] = qr[d0]; kf[2 * d0 + 1] = qr[ND - 1 - d0]; }
        else if (d0 < 4) { const int o = ((2 * d0 + hi) ^ sw) * 16; kf[2 * d0] = *(const LAS bf16x8*)(kb + o); kf[2 * d0 + 1] = *(const LAS bf16x8*)(kb + o + 4096); }
        else { const int o = ((2 * (d0 - 4) + hi) ^ swr) * 16; kf[2 * d0] = *(const LAS bf16x8*)(kr + o); kf[2 * d0 + 1] = *(const LAS bf16x8*)(kr + o + 2048); }
    }
    __builtin_amdgcn_sched_barrier(0);
#pragma unroll
    for (int d0 = 0; d0 < ND; ++d0) {
        if (d0 == 0) { p0 = __builtin_amdgcn_mfma_f32_32x32x16_bf16(kf[0], qr[0], negm, 0, 0, 0); p1 = __builtin_amdgcn_mfma_f32_32x32x16_bf16(kf[1], qr[0], negm, 0, 0, 0); }
        else { p0 = __builtin_amdgcn_mfma_f32_32x32x16_bf16(kf[2 * d0], qr[d0], p0, 0, 0, 0); p1 = __builtin_amdgcn_mfma_f32_32x32x16_bf16(kf[2 * d0 + 1], qr[d0], p1, 0, 0, 0); }
    }
    __builtin_amdgcn_sched_barrier(0);
}
template <int ND> __device__ __forceinline__ void qkt_acc(f32x16& p0, f32x16& p1, lds_cptr Kslot, const bf16x8* qr, int r32, int hi) {
    lds_cptr kb = Kslot + r32 * 128; const int sw = (r32 & 7) ^ ((r32 >> 3) & 1);
    bf16x8 kf[2 * ND];
#pragma unroll
    for (int d0 = 0; d0 < ND; ++d0) { const int o = ((2 * d0 + hi) ^ sw) * 16; kf[2 * d0] = *(const LAS bf16x8*)(kb + o); kf[2 * d0 + 1] = *(const LAS bf16x8*)(kb + o + 4096); }
    __builtin_amdgcn_sched_barrier(0);
#pragma unroll
    for (int d0 = 0; d0 < ND; ++d0) { p0 = __builtin_amdgcn_mfma_f32_32x32x16_bf16(kf[2 * d0], qr[d0], p0, 0, 0, 0); p1 = __builtin_amdgcn_mfma_f32_32x32x16_bf16(kf[2 * d0 + 1], qr[d0], p1, 0, 0, 0); }
    __builtin_amdgcn_sched_barrier(0);
}
template <int ND, int HALF> __device__ __forceinline__ void qkt_half_acc(f32x16& p, lds_cptr Kslot, const bf16x8* qr, int r32, int hi) {
    lds_cptr kb = Kslot + r32 * 128 + HALF * 4096; const int sw = (r32 & 7) ^ ((r32 >> 3) & 1);
    bf16x8 kf[ND];
#pragma unroll
    for (int d0 = 0; d0 < ND; ++d0) kf[d0] = *(const LAS bf16x8*)(kb + ((2 * d0 + hi) ^ sw) * 16);
    __builtin_amdgcn_sched_barrier(0);
#pragma unroll
    for (int d0 = 0; d0 < ND; ++d0) p = __builtin_amdgcn_mfma_f32_32x32x16_bf16(kf[d0], qr[d0], p, 0, 0, 0);
    __builtin_amdgcn_sched_barrier(0);
}
template <int HALF> __device__ __forceinline__ void pv_half(f32x16* o, int vb, bf16x8 pa0, bf16x8 pa1) {
#pragma unroll
    for (int d0 = 0; d0 < 2; ++d0) { s16x4 lo[2], hi[2];
#pragma unroll
        for (int ks = 0; ks < 2; ++ks) {
            asm volatile("ds_read_b64_tr_b16 %0,%1 offset:%c2" : "=&v"(lo[ks]) : "v"(vb), "i"(d0 * 512 + (2 * HALF + ks) * 2048) : "memory");
            asm volatile("ds_read_b64_tr_b16 %0,%1 offset:%c2" : "=&v"(hi[ks]) : "v"(vb), "i"(d0 * 512 + (2 * HALF + ks) * 2048 + 1024) : "memory"); }
        asm volatile("s_waitcnt lgkmcnt(0)" ::: "memory"); SBAR();
#define PK(k) (bf16x8){lo[k][0], lo[k][1], lo[k][2], lo[k][3], hi[k][0], hi[k][1], hi[k][2], hi[k][3]}
        o[d0] = __builtin_amdgcn_mfma_f32_32x32x16_bf16(pa0, PK(0), o[d0], 0, 0, 0);
        o[d0] = __builtin_amdgcn_mfma_f32_32x32x16_bf16(pa1, PK(1), o[d0], 0, 0, 0);
#undef PK
    }
}
__device__ __forceinline__ void pv(f32x16* o, int vb, bf16x8 pa0, bf16x8 pa1, bf16x8 pa2, bf16x8 pa3) {
#pragma unroll
    for (int d0 = 0; d0 < 2; ++d0) { s16x4 lo[4], hi[4];
#pragma unroll
        for (int ks = 0; ks < 4; ++ks) {
            asm volatile("ds_read_b64_tr_b16 %0,%1 offset:%c2" : "=&v"(lo[ks]) : "v"(vb), "i"(d0 * 512 + ks * 2048) : "memory");
            asm volatile("ds_read_b64_tr_b16 %0,%1 offset:%c2" : "=&v"(hi[ks]) : "v"(vb), "i"(d0 * 512 + ks * 2048 + 1024) : "memory"); }
        asm volatile("s_waitcnt lgkmcnt(0)" ::: "memory"); SBAR();
#define PK(k) (bf16x8){lo[k][0], lo[k][1], lo[k][2], lo[k][3], hi[k][0], hi[k][1], hi[k][2], hi[k][3]}
        o[d0] = __builtin_amdgcn_mfma_f32_32x32x16_bf16(pa0, PK(0), o[d0], 0, 0, 0);
        o[d0] = __builtin_amdgcn_mfma_f32_32x32x16_bf16(pa1, PK(1), o[d0], 0, 0, 0);
        o[d0] = __builtin_amdgcn_mfma_f32_32x32x16_bf16(pa2, PK(2), o[d0], 0, 0, 0);
        o[d0] = __builtin_amdgcn_mfma_f32_32x32x16_bf16(pa3, PK(3), o[d0], 0, 0, 0);
#undef PK
    }
}
constexpr float THR = 8.0f;
struct SoftState { float mhat, l; f32x16 negm; f32x16 o[2]; };
struct SoftStateD { float mhat, l; f32x16 o[2]; };
__device__ __forceinline__ void softmax_pv(SoftState& st, f32x16& p0, f32x16& p1, LAS float* wsf, int vb, int r32, int hi) {
    const float rm = rowmax(p0, p1);
    if (__any(rm > THR)) {
        const float dl = __builtin_fmaxf(rm, 0.f);
        st.mhat += dl;
#pragma unroll
        for (int r = 0; r < 16; ++r) { p0[r] -= dl; p1[r] -= dl; }
#pragma unroll
        for (int r = 0; r < 16; ++r) st.negm[r] = -st.mhat;
        const float f = fexp2(-dl); st.l *= f;
        if (hi == 0) wsf[r32] = f;
        LDS_WAIT();
#pragma unroll
        for (int r = 0; r < 16; ++r) { const float fr_ = wsf[crow(r, hi)]; st.o[0][r] *= fr_; st.o[1][r] *= fr_; }
        LDS_WAIT();
    }
    float sacc = 0.f;
#pragma unroll
    for (int r = 0; r < 16; ++r) { p0[r] = fexp2(p0[r]); p1[r] = fexp2(p1[r]); sacc += p0[r] + p1[r]; }
    st.l += sacc;
    u32x4 w0, w1, w2, w3;
    w0 = (u32x4){pk2(p0[0], p0[1]), pk2(p0[2], p0[3]), pk2(p0[4], p0[5]), pk2(p0[6], p0[7])};
    w1 = (u32x4){pk2(p0[8], p0[9]), pk2(p0[10], p0[11]), pk2(p0[12], p0[13]), pk2(p0[14], p0[15])};
    w2 = (u32x4){pk2(p1[0], p1[1]), pk2(p1[2], p1[3]), pk2(p1[4], p1[5]), pk2(p1[6], p1[7])};
    w3 = (u32x4){pk2(p1[8], p1[9]), pk2(p1[10], p1[11]), pk2(p1[12], p1[13]), pk2(p1[14], p1[15])};
    pv(st.o, vb, __builtin_bit_cast(bf16x8, w0), __builtin_bit_cast(bf16x8, w1), __builtin_bit_cast(bf16x8, w2), __builtin_bit_cast(bf16x8, w3));
}
template <class ST, bool NOEXP = false> __device__ __forceinline__ void exp_pv(ST& st, f32x16& p0, f32x16& p1, int vb) {
    float sacc = 0.f;
#pragma unroll
    for (int r = 0; r < 16; ++r) { if (!NOEXP) { p0[r] = fexp2(p0[r]); p1[r] = fexp2(p1[r]); } sacc += p0[r] + p1[r]; }
    st.l += sacc;
    u32x4 w0, w1, w2, w3;
    w0 = (u32x4){pk2(p0[0], p0[1]), pk2(p0[2], p0[3]), pk2(p0[4], p0[5]), pk2(p0[6], p0[7])};
    w1 = (u32x4){pk2(p0[8], p0[9]), pk2(p0[10], p0[11]), pk2(p0[12], p0[13]), pk2(p0[14], p0[15])};
    w2 = (u32x4){pk2(p1[0], p1[1]), pk2(p1[2], p1[3]), pk2(p1[4], p1[5]), pk2(p1[6], p1[7])};
    w3 = (u32x4){pk2(p1[8], p1[9]), pk2(p1[10], p1[11]), pk2(p1[12], p1[13]), pk2(p1[14], p1[15])};
    pv(st.o, vb, __builtin_bit_cast(bf16x8, w0), __builtin_bit_cast(bf16x8, w1), __builtin_bit_cast(bf16x8, w2), __builtin_bit_cast(bf16x8, w3));
}
template <class ST> __device__ __forceinline__ void finish_rows(ST& st, LAS float* wsf, LAS bf16_t* stg, int r32, int hi) {
    float l = st.l;
    { auto rr = __builtin_amdgcn_permlane32_swap(__float_as_uint(l), __float_as_uint(l), false, false); l = __uint_as_float(rr[0]) + __uint_as_float(rr[1]); }
    if (hi == 0) { wsf[32 + r32] = l; wsf[64 + r32] = st.mhat + __builtin_amdgcn_logf(l); }
    LDS_WAIT();
#pragma unroll
    for (int r = 0; r < 16; ++r) { const int orow = crow(r, hi); const float rl = frcp(wsf[32 + orow]);
#pragma unroll
        for (int d0 = 0; d0 < 2; ++d0) stg[orow * 64 + d0 * 32 + r32] = (bf16_t)(pk2(st.o[d0][r] * rl, 0.f) & 0xffffu); }
    LDS_WAIT();
}

constexpr int MK_SLOT = 12288, MV_SLOT = 8192, M_NSLOT = 5, M_LK = 0, M_LV = M_NSLOT * MK_SLOT;
template <int MODE  > __device__ __forceinline__ void mla_unit(int b, int h, int qb, const bf16_t* QM, const bf16_t* KN, const bf16_t* KR, const bf16_t* VM, bf16_t* MIX, LAS char* shm) {
    int tid_ = threadIdx.x; asm volatile("" : "+v"(tid_)); const int tid = tid_, lane = tid & 63, r32 = lane & 31, hi = lane >> 5; const int wid = __builtin_amdgcn_readfirstlane(tid >> 6);
    const long rowbase = (long)b * SEQ; const int q0 = qb * 256;
    const unsigned lds0 = (unsigned)(uintptr_t)shm;
    LAS float* wsf = (LAS float*)(shm + ATT_WSF) + wid * 128;
    LAS bf16_t* stg = (LAS bf16_t*)(shm + ATT_OST) + wid * 2048;
    const long hb = ((long)b * 8 + h) * SEQ;
    const bf16_t* ksrc0 = KN + (hb + 8 * wid + (lane >> 3)) * 64 + (((lane & 7) ^ (lane >> 3) ^ (wid & 1)) * 8);
    const bf16_t* ksrc1 = KR + (rowbase + 16 * (wid & 3) + (lane >> 2)) * 32 + (((lane & 3) ^ ((lane >> 4) & 3)) * 8);
    const bf16_t* vsrc = VM + (hb + 8 * wid + ((lane >> 2) & 7)) * 64 + (lane >> 5) * 32 + (lane & 3) * 8;
    const unsigned kdst0 = lds0 + M_LK + wid * 1024, kdst1 = lds0 + M_LK + (8 + (wid & 3)) * 1024, vdst = lds0 + M_LV + wid * 1024;
#define MLA_DMA(t, s) do { glds16(ksrc0 + (long)(t) * 64 * 64, (unsigned)__builtin_amdgcn_readfirstlane(kdst0 + (s) * MK_SLOT)); \
        glds16(ksrc1 + (long)(t) * 64 * 32, (unsigned)__builtin_amdgcn_readfirstlane(kdst1 + (s) * MK_SLOT)); \
        glds16(vsrc + (long)(t) * 64 * 64, (unsigned)__builtin_amdgcn_readfirstlane(vdst + (s) * MV_SLOT)); } while (0)
    const int NT = (q0 + 256) / 64;
    if (MODE != 2) { MLA_DMA(0, 0); MLA_DMA(1, 1); MLA_DMA(2, 2); }
    const bf16_t* Qw = QM + (hb + q0 + wid * 32 + r32) * 96 + hi * 8;
    bf16x8 qr[6];
#pragma unroll
    for (int d0 = 0; d0 < 6; ++d0) qr[d0] = *(const bf16x8*)(Qw + d0 * 16);
#pragma unroll
    for (int d0 = 0; d0 < 6; ++d0) asm volatile("" : "+v"(qr[d0]));
    SoftStateD st; st.mhat = 0.f; st.l = 0.f; st.o[0] = f32x16{}; st.o[1] = f32x16{}; const f32x16 zc = f32x16{};
    const int qw0 = q0 + wid * 32, qrel = qw0 + r32;
    const int vb0 = (int)(lds0 + M_LV) + ((lane >> 4) & 1) * 32 + (lane & 3) * 8 + (4 * hi + ((lane & 15) >> 2)) * 64;
    f32x16 p0, p1;
#define MLA_QK(t) do { qkt<6, MODE == 7>(p0, p1, (lds_cptr)(shm + M_LK + sl * MK_SLOT), qr, zc, r32, hi); \
        if (64 * (t) + 63 > qw0) { const int kb = 64 * (t) + 4 * hi; \
            _Pragma("unroll") for (int r = 0; r < 16; ++r) { const int kv = kb + (r & 3) + 8 * (r >> 2); if (kv > qrel) p0[r] = -INFINITY; if (kv + 32 > qrel) p1[r] = -INFINITY; } } } while (0)
    int sl = 0, slp = 4, sln = 3;
    for (int t = 0; t < NT; ++t) {
        if (MODE == 2) asm volatile("s_waitcnt lgkmcnt(0)\n\ts_barrier" ::: "memory");
        else if (MODE == 5) asm volatile("s_waitcnt vmcnt(0) lgkmcnt(0)" ::: "memory");
        else if (t + 2 < NT) asm volatile("s_waitcnt vmcnt(6) lgkmcnt(0)\n\ts_barrier" ::: "memory");
        else if (t + 1 < NT) asm volatile("s_waitcnt vmcnt(3) lgkmcnt(0)\n\ts_barrier" ::: "memory");
        else asm volatile("s_waitcnt vmcnt(0) lgkmcnt(0)\n\ts_barrier" ::: "memory");
        if (MODE != 2 && t + 3 < NT) MLA_DMA(t + 3, sln);
        const bool valid = (MODE != 1) && (64 * t <= qw0 + 31);
        if (valid) { MLA_QK(t); if (MODE == 6) exp_pv<SoftStateD, true>(st, p0, p1, vb0 + sl * MV_SLOT); else if (MODE != 3) exp_pv(st, p0, p1, vb0 + sl * MV_SLOT); else { st.o[0] += p0; st.o[1] += p1; } }
        slp = sl; sl = (sl == 4) ? 0 : sl + 1; sln = (sln == 4) ? 0 : sln + 1;
    }
    finish_rows(st, wsf, stg, r32, hi);
    bf16_t* Ow = MIX + (rowbase + q0 + wid * 32) * 1024 + 512 + h * 64;
#pragma unroll
    for (int i = 0; i < 4; ++i) { const int row = i * 8 + (lane >> 3), ch = lane & 7; const u32x4 v = *(const LAS u32x4*)(stg + row * 64 + ch * 8); *(u32x4*)(Ow + (long)row * 1024 + ch * 8) = v; }
    asm volatile("s_waitcnt lgkmcnt(0)\n\ts_barrier" ::: "memory");
#undef MLA_DMA
#undef MLA_QK
}

struct MlaPtrs { const bf16_t *ksrc0, *ksrc1, *vsrc, *Qw; };
__device__ __forceinline__ MlaPtrs mla_ptrs(int b, int h, int qb, const bf16_t* QM, const bf16_t* KN, const bf16_t* KR, const bf16_t* VM, int lane, int wid) {
    const long rowbase = (long)b * SEQ, hb = ((long)b * 8 + h) * SEQ; const int r32 = lane & 31, hi = lane >> 5;
    MlaPtrs P;
    P.ksrc0 = KN + (hb + 8 * wid + (lane >> 3)) * 64 + (((lane & 7) ^ (lane >> 3) ^ (wid & 1)) * 8);
    P.ksrc1 = KR + (rowbase + 16 * (wid & 3) + (lane >> 2)) * 32 + (((lane & 3) ^ ((lane >> 4) & 3)) * 8);
    P.vsrc = VM + (hb + 8 * wid + ((lane >> 2) & 7)) * 64 + (lane >> 5) * 32 + (lane & 3) * 8;
    P.Qw = QM + (hb + qb * 256 + wid * 32 + r32) * 96 + hi * 8;
    return P;
}
__device__ __forceinline__ void mla_chain(int xcd, int grp, int k, const bf16_t* QM, const bf16_t* KN, const bf16_t* KR, const bf16_t* VM, bf16_t* MIX, LAS char* shm) {
    int tid_ = threadIdx.x; asm volatile("" : "+v"(tid_)); const int tid = tid_, lane = tid & 63, r32 = lane & 31, hi = lane >> 5; const int wid = __builtin_amdgcn_readfirstlane(tid >> 6);
    const unsigned lds0 = (unsigned)(uintptr_t)shm;
    LAS float* wsf = (LAS float*)(shm + ATT_WSF) + wid * 128;
    LAS bf16_t* stg = (LAS bf16_t*)(shm + ATT_OST) + wid * 2048;
    const unsigned kdst0 = lds0 + M_LK + wid * 1024, kdst1 = lds0 + M_LK + (8 + (wid & 3)) * 1024, vdst = lds0 + M_LV + wid * 1024;
    const int vb0 = (int)(lds0 + M_LV) + ((lane >> 4) & 1) * 32 + (lane & 3) * 8 + (4 * hi + ((lane & 15) >> 2)) * 64;
#define MLC_DMA(P, t, s) do { glds16((P).ksrc0 + (long)(t) * 64 * 64, (unsigned)__builtin_amdgcn_readfirstlane(kdst0 + (s) * MK_SLOT)); \
        glds16((P).ksrc1 + (long)(t) * 64 * 32, (unsigned)__builtin_amdgcn_readfirstlane(kdst1 + (s) * MK_SLOT)); \
        glds16((P).vsrc + (long)(t) * 64 * 64, (unsigned)__builtin_amdgcn_readfirstlane(vdst + (s) * MV_SLOT)); } while (0)
#define MLC_UNIT(i, b_, h_, qb_) do { const int bh_ = 32 * xcd + 8 * ((i) >> 1) + grp; b_ = bh_ >> 3; h_ = bh_ & 7; qb_ = ((i) & 1) ? k : 7 - k; } while (0)
    int b, h, qb; MLC_UNIT(0, b, h, qb);
    MlaPtrs P = mla_ptrs(b, h, qb, QM, KN, KR, VM, lane, wid);
    MLC_DMA(P, 0, 0); MLC_DMA(P, 1, 1); MLC_DMA(P, 2, 2);
    bf16x8 qr[6];
#pragma unroll
    for (int d0 = 0; d0 < 6; ++d0) qr[d0] = *(const bf16x8*)(P.Qw + d0 * 16);
    for (int i = 0; i < 8; ++i) {
#pragma unroll
        for (int d0 = 0; d0 < 6; ++d0) asm volatile("" : "+v"(qr[d0]));
        const int q0 = qb * 256, NT = (q0 + 256) / 64;
        SoftStateD st; st.mhat = 0.f; st.l = 0.f; st.o[0] = f32x16{}; st.o[1] = f32x16{}; const f32x16 zc = f32x16{};
        const int qw0 = q0 + wid * 32, qrel = qw0 + r32;
        f32x16 p0, p1;
        int sl = 0, sln = 3;
        for (int t = 0; t < NT; ++t) {
            if (t + 2 < NT) asm volatile("s_waitcnt vmcnt(6) lgkmcnt(0)\n\ts_barrier" ::: "memory");
            else if (t + 1 < NT) asm volatile("s_waitcnt vmcnt(3) lgkmcnt(0)\n\ts_barrier" ::: "memory");
            else asm volatile("s_waitcnt vmcnt(0) lgkmcnt(0)\n\ts_barrier" ::: "memory");
            if (t + 3 < NT) MLC_DMA(P, t + 3, sln);
            if (64 * t <= qw0 + 31) {
                qkt<6, false>(p0, p1, (lds_cptr)(shm + M_LK + sl * MK_SLOT), qr, zc, r32, hi);
                if (64 * t + 63 > qw0) { const int kb = 64 * t + 4 * hi;
#pragma unroll
                    for (int r = 0; r < 16; ++r) { const int kv = kb + (r & 3) + 8 * (r >> 2); if (kv > qrel) p0[r] = -INFINITY; if (kv + 32 > qrel) p1[r] = -INFINITY; } }
                exp_pv(st, p0, p1, vb0 + sl * MV_SLOT); }
            sl = (sl == 4) ? 0 : sl + 1; sln = (sln == 4) ? 0 : sln + 1;
        }
        asm volatile("s_waitcnt lgkmcnt(0)\n\ts_barrier" ::: "memory");
        int bn = b, hn = h, qbn = qb; MlaPtrs Pn = P; bf16x8 qn[6];
        if (i + 1 < 8) { MLC_UNIT(i + 1, bn, hn, qbn); Pn = mla_ptrs(bn, hn, qbn, QM, KN, KR, VM, lane, wid);
            MLC_DMA(Pn, 0, 0); MLC_DMA(Pn, 1, 1); MLC_DMA(Pn, 2, 2);
#pragma unroll
            for (int d0 = 0; d0 < 6; ++d0) qn[d0] = *(const bf16x8*)(Pn.Qw + d0 * 16); }
        finish_rows(st, wsf, stg, r32, hi);
        bf16_t* Ow = MIX + ((long)b * SEQ + q0 + wid * 32) * 1024 + 512 + h * 64;
#pragma unroll
        for (int j = 0; j < 4; ++j) { const int row = j * 8 + (lane >> 3), ch = lane & 7; const u32x4 v = *(const LAS u32x4*)(stg + row * 64 + ch * 8); *(u32x4*)(Ow + (long)row * 1024 + ch * 8) = v; }
        LDS_WAIT();
        if (i + 1 < 8) { b = bn; h = hn; qb = qbn; P = Pn;
#pragma unroll
            for (int d0 = 0; d0 < 6; ++d0) qr[d0] = qn[d0]; }
    }
    asm volatile("s_waitcnt lgkmcnt(0)\n\ts_barrier" ::: "memory");
#undef MLC_DMA
#undef MLC_UNIT
}

constexpr int D_LK = 0, D_LV = 49152;
struct DilGeom { int br, uu, d, res0, tb, nslot, rot; };
__device__ __forceinline__ DilGeom dil_geom(int uidx) {
    DilGeom g; g.br = 2 - (uidx >> 3); g.uu = uidx & 7; g.d = 1 << (2 * g.br);
    if (g.br == 2) { g.res0 = 2 * g.uu; g.tb = 0; g.nslot = 4; }
    else { g.res0 = (g.br == 0) ? 0 : (g.uu >> 1); const int Q0 = (g.br == 0) ? 256 * g.uu : 256 * (g.uu & 1); g.tb = Q0 / 64 - 2; g.nslot = 6; }
    g.rot = (g.br == 2) ? 0 : (4 * ((g.br == 0) ? g.uu : (g.uu & 1))) % 6;
    return g;
}
template <bool ISV, int MODE = 0> __device__ __forceinline__ void dil_issue_tiles(const DilGeom& g, long hb, const bf16_t* KA, const bf16_t* VA, unsigned lds0, int lane, int wid) {
    if (MODE == 4) return;
    for (int j = (g.br == 2) ? 0 : 2; j < g.nslot; ++j) {
        const int tile = (g.br == 2) ? (j & 1) : g.tb + j; const int res = (g.br == 2) ? g.res0 + (j >> 1) : g.res0; const int sj = dslot(g.rot, j);
        if (!ISV) { const long krow = res + (long)g.d * (64 * tile + 8 * wid + (lane >> 3));
            glds16(KA + (hb + krow) * 64 + (((lane & 7) ^ (lane >> 3) ^ (wid & 1)) * 8), (unsigned)__builtin_amdgcn_readfirstlane(lds0 + D_LK + sj * 8192 + wid * 1024)); }
        else { const long vrow = res + (long)g.d * (64 * tile + 8 * wid + ((lane >> 2) & 7));
            glds16(VA + (hb + vrow) * 64 + (lane >> 5) * 32 + (lane & 3) * 8, (unsigned)__builtin_amdgcn_readfirstlane(lds0 + D_LV + sj * 8192 + wid * 1024)); }
    }
}
template <int MODE  > __device__ __forceinline__ void dil_phase2(int b, int h, const bf16_t* QA, const bf16_t* KA, const bf16_t* VA, bf16_t* O2, bf16_t* O3, float* LSE2, float* LSE3, bf16_t* MIX, LAS char* shm, const LAS float* tbl) {
    int tid_ = threadIdx.x; asm volatile("" : "+v"(tid_)); const int tid = tid_, lane = tid & 63, r32 = lane & 31, hi = lane >> 5; const int wid = __builtin_amdgcn_readfirstlane(tid >> 6);
    const long rowbase = (long)b * SEQ; const long hb = ((long)b * 8 + h) * SEQ;
    const unsigned lds0 = (unsigned)(uintptr_t)shm;
    LAS float* wsf = (LAS float*)(shm + ATT_WSF) + wid * 128;
    LAS bf16_t* stg = (LAS bf16_t*)(shm + ATT_OST) + wid * 2048;
    const int vb0 = (int)(lds0 + D_LV) + ((lane >> 4) & 1) * 32 + (lane & 3) * 8 + (4 * hi + ((lane & 15) >> 2)) * 64;
    dil_issue_tiles<false, MODE>(dil_geom(0), hb, KA, VA, lds0, lane, wid);
    bf16x8 qn[4];
    { const DilGeom g0 = dil_geom(0); const int wres0 = g0.res0 + (wid >> 2), qs0 = 32 * (wid & 3);
      const bf16_t* Qw0 = QA + (hb + wres0 + (long)g0.d * (qs0 + r32)) * 64 + hi * 8;
#pragma unroll
      for (int d0 = 0; d0 < 4; ++d0) qn[d0] = *(const bf16x8*)(Qw0 + d0 * 16); }
    for (int uidx = 0; uidx < 24; ++uidx) {
        const DilGeom g = dil_geom(uidx); const int br = g.br, d = g.d;
        if (uidx == 16) { VM_WAIT(); __syncthreads(); __builtin_amdgcn_fence(__ATOMIC_ACQUIRE, "agent"); VM_WAIT(); }
        int wres, qs, j0, nj;
        if (br == 2) { wres = g.res0 + (wid >> 2); qs = 32 * (wid & 3); j0 = 2 * (wid >> 2); nj = (wid & 3) < 2 ? 1 : 2; }
        else { wres = g.res0; qs = (g.tb + 2) * 64 + 32 * wid; j0 = wid >> 1; nj = 3; }
        if (uidx == 0 || uidx == 16) asm volatile("s_waitcnt vmcnt(0) lgkmcnt(0)\n\ts_barrier" ::: "memory");
        else asm volatile("s_waitcnt vmcnt(8) lgkmcnt(0)\n\ts_barrier" ::: "memory");
        bf16x8 qr[4];
#pragma unroll
        for (int d0 = 0; d0 < 4; ++d0) { qr[d0] = qn[d0]; asm volatile("" : "+v"(qr[d0])); }
        dil_issue_tiles<true, MODE>(g, hb, KA, VA, lds0, lane, wid);
        u32x2 o2v[4], o3v[4]; float l2v[4], l3v[4];
        if (br == 0) {
#pragma unroll
            for (int i = 0; i < 4; ++i) { const int row = i * 8 + (lane >> 3), ch = lane & 7; const long hr = hb + qs + row;
                o2v[i] = *(const u32x2*)((const char*)O2 + hr * 64 + ch * 8); o3v[i] = *(const u32x2*)((const char*)O3 + hr * 64 + ch * 8); l2v[i] = LSE2[hr]; l3v[i] = LSE3[hr]; }
            asm volatile("" ::: "memory");
        }
        const LAS float* tbr = tbl + br * 320;
        SoftStateD st; st.mhat = 0.f; st.l = 0.f; st.o[0] = f32x16{}; st.o[1] = f32x16{};
        u32x4 pw[3][4]; int hmask = 0;
#pragma unroll
        for (int jj = 0; jj < 3; ++jj) {
            const int j = j0 + jj; const int tile = (br == 2) ? jj : g.tb + j; const int sj = dslot(g.rot, j);
            const bool live = (MODE != 1) && jj < nj && tile >= 0;
            const bool h0 = live && !(64 * tile > qs + 31) && !(64 * tile + 31 < qs - 128);
            const bool h1 = live && !(64 * tile + 32 > qs + 31) && !(64 * tile + 63 < qs - 128);
            const LAS float* tp = tbr + (qs + r32 - 64 * tile + 33 - 4 * hi);
            if (h0) { f32x16 s0;
#pragma unroll
                for (int r = 0; r < 16; ++r) { const int c0 = (r & 3) + 8 * (r >> 2); s0[r] = tp[63 - c0]; }
                qkt_half_acc<4, 0>(s0, (lds_cptr)(shm + D_LK + sj * 8192), qr, r32, hi);
                float sacc = 0.f;
#pragma unroll
                for (int r = 0; r < 16; ++r) { s0[r] = fexp2(s0[r]); sacc += s0[r]; }
                st.l += sacc;
                pw[jj][0] = (u32x4){pk2(s0[0], s0[1]), pk2(s0[2], s0[3]), pk2(s0[4], s0[5]), pk2(s0[6], s0[7])};
                pw[jj][1] = (u32x4){pk2(s0[8], s0[9]), pk2(s0[10], s0[11]), pk2(s0[12], s0[13]), pk2(s0[14], s0[15])}; }
            if (h1) { f32x16 s1;
#pragma unroll
                for (int r = 0; r < 16; ++r) { const int c0 = (r & 3) + 8 * (r >> 2); s1[r] = tp[31 - c0]; }
                qkt_half_acc<4, 1>(s1, (lds_cptr)(shm + D_LK + sj * 8192), qr, r32, hi);
                float sacc = 0.f;
#pragma unroll
                for (int r = 0; r < 16; ++r) { s1[r] = fexp2(s1[r]); sacc += s1[r]; }
                st.l += sacc;
                pw[jj][2] = (u32x4){pk2(s1[0], s1[1]), pk2(s1[2], s1[3]), pk2(s1[4], s1[5]), pk2(s1[6], s1[7])};
                pw[jj][3] = (u32x4){pk2(s1[8], s1[9]), pk2(s1[10], s1[11]), pk2(s1[12], s1[13]), pk2(s1[14], s1[15])}; }
            hmask |= (h0 ? 1 : 0) << (2 * jj) | (h1 ? 2 : 0) << (2 * jj);
        }
        asm volatile("s_waitcnt vmcnt(0) lgkmcnt(0)\n\ts_barrier" ::: "memory");
        if (uidx + 1 < 24) { const DilGeom gn = dil_geom(uidx + 1);
            dil_issue_tiles<false, MODE>(gn, hb, KA, VA, lds0, lane, wid);
            int wresn, qsn;
            if (gn.br == 2) { wresn = gn.res0 + (wid >> 2); qsn = 32 * (wid & 3); } else { wresn = gn.res0; qsn = (gn.tb + 2) * 64 + 32 * wid; }
            const bf16_t* Qwn = QA + (hb + wresn + (long)gn.d * (qsn + r32)) * 64 + hi * 8;
#pragma unroll
            for (int d0 = 0; d0 < 4; ++d0) qn[d0] = *(const bf16x8*)(Qwn + d0 * 16);
            asm volatile("" ::: "memory"); }
#pragma unroll
        for (int jj = 0; jj < 3; ++jj) {
            const int sj = dslot(g.rot, j0 + jj);
            if ((hmask >> (2 * jj)) & 1) pv_half<0>(st.o, vb0 + sj * 8192, __builtin_bit_cast(bf16x8, pw[jj][0]), __builtin_bit_cast(bf16x8, pw[jj][1]));
            if ((hmask >> (2 * jj)) & 2) pv_half<1>(st.o, vb0 + sj * 8192, __builtin_bit_cast(bf16x8, pw[jj][2]), __builtin_bit_cast(bf16x8, pw[jj][3]));
        }
        if (MODE != 3) finish_rows(st, wsf, stg, r32, hi);
        const long trow0 = rowbase + wres + (long)d * qs;
        if (MODE == 2 || MODE == 3) { } else
        if (br != 0) {
            bf16_t* Ob = (br == 1) ? O2 : O3; float* Lb = (br == 1) ? LSE2 : LSE3;
#pragma unroll
            for (int i = 0; i < 4; ++i) { const int row = i * 8 + (lane >> 3), ch = lane & 7; const long tr = trow0 + (long)d * row;
                const u32x4 v = *(const LAS u32x4*)(stg + row * 64 + ch * 8); u32x2 q8;
                q8.x = (unsigned)__builtin_amdgcn_cvt_pk_fp8_f32(bflo(v.y), bfhi(v.y), __builtin_amdgcn_cvt_pk_fp8_f32(bflo(v.x), bfhi(v.x), 0, false), true);
                q8.y = (unsigned)__builtin_amdgcn_cvt_pk_fp8_f32(bflo(v.w), bfhi(v.w), __builtin_amdgcn_cvt_pk_fp8_f32(bflo(v.z), bfhi(v.z), 0, false), true);
                *(u32x2*)((char*)Ob + (hb + tr - rowbase) * 64 + ch * 8) = q8;
                if (ch == 0) Lb[7 * rowbase + (long)h * SEQ + tr] = wsf[64 + row]; }
        } else {
#pragma unroll
            for (int i = 0; i < 4; ++i) { const int row = i * 8 + (lane >> 3), ch = lane & 7; const long tr = trow0 + row;
                f32x4 a1, b1, a2, b2, a3, b3;
                { const u32x4 w = *(const LAS u32x4*)(stg + row * 64 + ch * 8); a1 = (f32x4){bflo(w.x), bfhi(w.x), bflo(w.y), bfhi(w.y)}; b1 = (f32x4){bflo(w.z), bfhi(w.z), bflo(w.w), bfhi(w.w)}; }
                { const u32x2 w = o2v[i]; const f32x2 c0 = __builtin_amdgcn_cvt_pk_f32_fp8((int)w.x, false), c1 = __builtin_amdgcn_cvt_pk_f32_fp8((int)w.x, true), c2 = __builtin_amdgcn_cvt_pk_f32_fp8((int)w.y, false), c3 = __builtin_amdgcn_cvt_pk_f32_fp8((int)w.y, true); a2 = (f32x4){c0[0], c0[1], c1[0], c1[1]}; b2 = (f32x4){c2[0], c2[1], c3[0], c3[1]}; }
                { const u32x2 w = o3v[i]; const f32x2 c0 = __builtin_amdgcn_cvt_pk_f32_fp8((int)w.x, false), c1 = __builtin_amdgcn_cvt_pk_f32_fp8((int)w.x, true), c2 = __builtin_amdgcn_cvt_pk_f32_fp8((int)w.y, false), c3 = __builtin_amdgcn_cvt_pk_f32_fp8((int)w.y, true); a3 = (f32x4){c0[0], c0[1], c1[0], c1[1]}; b3 = (f32x4){c2[0], c2[1], c3[0], c3[1]}; }
                const float l1 = wsf[64 + row], l2 = l2v[i], l3 = l3v[i];
                const float mm = max3f(l1, l2, l3); const float e1 = fexp2(l1 - mm), e2 = fexp2(l2 - mm), e3 = fexp2(l3 - mm); const float inv = frcp(e1 + e2 + e3);
                const float w1 = e1 * inv, w2 = e2 * inv, w3 = e3 * inv;
                st8(MIX + tr * 1024 + h * 64 + ch * 8, a1 * w1 + a2 * w2 + a3 * w3, b1 * w1 + b2 * w2 + b3 * w3); }
        }
        LDS_WAIT();
    }
    VM_WAIT(); __syncthreads();
}
#undef SBAR
}

#define XB_TMO      128
#define XB_XCNT(j)  (256  + 64 * (j))
#define XB_XSUB(j)  (1280 + 64 * (j))
#define XB_XGEN(j)  (2304 + 64 * (j))
#define XB_TOP      3328
#define XB_TOPGEN   3392
#define XCD_BAR_WORDS 3456
#define XB_SPIN_CAP (1u << 18)

__device__ __forceinline__ unsigned xb_ld(unsigned* p)              { return __hip_atomic_load(p, __ATOMIC_RELAXED, __HIP_MEMORY_SCOPE_AGENT); }
__device__ __forceinline__ unsigned xb_add(unsigned* p, unsigned v) { return __hip_atomic_fetch_add(p, v, __ATOMIC_RELAXED, __HIP_MEMORY_SCOPE_AGENT); }
__device__ __forceinline__ unsigned xb_xcc_id() { return (unsigned)__builtin_amdgcn_s_getreg((3 << 11) | 20) & 0xFu; }
#define XB_SPIN(cond, bar) do { unsigned _sp = 0; while (cond) { __builtin_amdgcn_s_sleep(1); \
    if ((++_sp & 255u) == 0u) { if (xb_ld(&(bar)[XB_TMO])) break; if (_sp > XB_SPIN_CAP) { atomicAdd(&(bar)[XB_TMO], 1u); break; } } } } while (0)

struct XcdBarrier {
    unsigned* bar; unsigned x;
    volatile LAS unsigned* st;
};

__device__ __forceinline__ XcdBarrier xcd_barrier_post(unsigned* bar, volatile LAS unsigned* st) {
    XcdBarrier b; b.bar = bar; b.x = xb_xcc_id(); b.st = st;
    if (threadIdx.x == 0) (void)xb_add(&bar[XB_XCNT(b.x)], 1u);
    return b;
}
__device__ __forceinline__ void xcd_barrier_complete(unsigned* bar, unsigned x, unsigned& nloc, unsigned& nx) {
    const unsigned G = gridDim.x * gridDim.y * gridDim.z;
    unsigned sum, cnt, mine, sp = 0u;
    for (;;) {
        sum = 0u; cnt = 0u; mine = 0u;
#pragma unroll
        for (unsigned j = 0; j < 16; ++j) { const unsigned c = xb_ld(&bar[XB_XCNT(j)]); sum += c; cnt += (c > 0u) ? 1u : 0u; mine = (j == x) ? c : mine; }
        if (sum == G) break;
        __builtin_amdgcn_s_sleep(1);
        if ((++sp & 255u) == 0u) { if (xb_ld(&bar[XB_TMO])) break; if (sp > XB_SPIN_CAP) { atomicAdd(&bar[XB_TMO], 1u); break; } }
    }
    nloc = mine > 0u ? mine : 1u; nx = cnt > 0u ? cnt : 1u;
}

__device__ __forceinline__ void xcd_barrier(const XcdBarrier& b) {
    asm volatile("s_waitcnt vmcnt(0)" ::: "memory");
    __syncthreads();
    if (threadIdx.x == 0) {
        unsigned* bar = b.bar;
        __builtin_amdgcn_s_waitcnt(0);
        unsigned nloc = b.st[0], nx = b.st[1];
        if (nloc == 0u) { xcd_barrier_complete(bar, b.x, nloc, nx); b.st[0] = nloc; b.st[1] = nx; }
        const unsigned old = xb_add(&bar[XB_XSUB(b.x)], 1u);
        const unsigned gen = old / nloc;
        if (old + 1u == (gen + 1u) * nloc) {
            __builtin_amdgcn_fence(__ATOMIC_RELEASE, "agent");
            asm volatile("s_waitcnt vmcnt(0)" ::: "memory");
            const unsigned og = xb_add(&bar[XB_TOP], 1u);
            const unsigned tg = og / nx;
            if (og + 1u == (tg + 1u) * nx) xb_add(&bar[XB_TOPGEN], 1u);
            else XB_SPIN(xb_ld(&bar[XB_TOPGEN]) == tg, bar);
            __builtin_amdgcn_fence(__ATOMIC_ACQUIRE, "agent");
            xb_add(&bar[XB_XGEN(b.x)], 1u);
            asm volatile("s_waitcnt vmcnt(0)" ::: "memory");
        } else {
            XB_SPIN(xb_ld(&bar[XB_XGEN(b.x)]) == gen, bar);
            __builtin_amdgcn_fence(__ATOMIC_ACQUIRE, "agent");
            asm volatile("s_waitcnt vmcnt(0)" ::: "memory");
        }
    }
    __syncthreads();
}

struct Frame {
    LAS unsigned char* lds; volatile LAS unsigned* MISC; unsigned* ctl; unsigned char* ws;
    int tid, lane, wave, vcu, G;
};
struct Args {
    const float* in[28]; float* out; unsigned char* ws;
};
enum { I_X = 0, I_P, I_RELB, I_NMG, I_WIN, I_QNA, I_KNA, I_QAG, I_WQUP, I_KVAG, I_WKVUP, I_QNN, I_QNR, I_KNN, I_KNR, I_WOUT, I_NFG, I_WRG, I_BRG, I_WRE, I_BRE, I_WEG, I_WEU, I_WED, I_WPP, I_PNG, I_WPG, I_BPG };

__device__ __forceinline__ float wave_sum(float v) {
#pragma unroll
    for (int o = 1; o < 64; o <<= 1) v += __shfl_xor(v, o);
    return v;
}

template <class RowMap>
__device__ __forceinline__ void tr_item(const float* __restrict__ W, int N, const float* __restrict__ kscale, bf16_t* WT, int ldt, RowMap map, LAS float* scr, int k0, int n0, int lane) {
    float tv[32];
#pragma unroll
    for (int i = 0; i < 32; ++i) { const int kk = 2 * i + (lane >> 5); tv[i] = __builtin_nontemporal_load(W + (size_t)(k0 + kk) * N + n0 + (lane & 31)); }
    if (kscale) {
#pragma unroll
        for (int i = 0; i < 32; ++i) tv[i] *= kscale[k0 + 2 * i + (lane >> 5)];
    }
#pragma unroll
    for (int i = 0; i < 32; ++i) scr[(2 * i + (lane >> 5)) * 33 + (lane & 31)] = tv[i];
    LDS_WAIT(); asm volatile("" ::: "memory");
    const int c = lane & 7;
#pragma unroll
    for (int j = 0; j < 4; ++j) { const int n = (lane >> 3) + 8 * j; const LAS float* s = scr + (8 * c) * 33 + n;
        u32x4 o; o.x = pk2(s[0 * 33], s[1 * 33]); o.y = pk2(s[2 * 33], s[3 * 33]); o.z = pk2(s[4 * 33], s[5 * 33]); o.w = pk2(s[6 * 33], s[7 * 33]);
        const int dr = map(n0 + n);
        if (dr >= 0) *(u32x4*)(WT + (size_t)dr * ldt + k0 + 8 * c) = o; }
    LDS_WAIT(); asm volatile("" ::: "memory");
}
struct MapId { int off; __device__ __forceinline__ int operator()(int n) const { return off + n; } };
struct MapSlot { __device__ __forceinline__ int operator()(int L) const { return 256 * (L >> 8) + 128 * ((L >> 5) & 1) + 32 * ((L >> 6) & 3) + (L & 31); } };
__device__ __forceinline__ int slot_row(int s, int c64) { return 256 * (s >> 2) + 128 * (c64 >> 5) + 32 * (s & 3) + (c64 & 31); }
__device__ __forceinline__ int rope_j(int dim) { return 8 * ((dim & 15) >> 2) + 4 * (dim >> 4) + (dim & 3); }
struct MapWin { __device__ __forceinline__ int operator()(int L) const {
    if (L < 1024) return slot_row(L >> 6, L & 63);
    if (L < 1536) return 1024 + slot_row((L - 1024) >> 6, (L - 1024) & 63);
    if (L < 2176) return 1536 + slot_row((L - 1536) >> 6, (L - 1536) & 63);
    return 1536 + slot_row(10, rope_j(L - 2176));
} };
struct MapQup { __device__ __forceinline__ int operator()(int L) const { const int hd = L / 96, dd = L % 96;
    if (dd < 64) return slot_row(hd, dd);
    return 512 + slot_row(hd >> 1, 32 * (hd & 1) + rope_j(dd - 64));
} };
struct MapKVup { __device__ __forceinline__ int operator()(int L) const { const int hd = L >> 7, dd = L & 127;
    if (dd < 64) return slot_row(hd, dd);
    return 512 + slot_row(hd, dd - 64);
} };
struct MapGU { int up; __device__ __forceinline__ int operator()(int c) const { return (c >> 7) * 256 + up * 128 + (c & 127); } };

__device__ __forceinline__ int t5_bucket(int n) {
    if (n < 16) return n;
    int lg = 16 + (int)(__builtin_amdgcn_logf((float)n * 0.0625f) * (16.0f / 7.0f));
    return lg < 31 ? lg : 31;
}

#ifndef WD_IN_P0
#define WD_IN_P0 0
#endif
__device__ __forceinline__ void convert_wd(Frame& F, const Args& a, int rank, int count) {
    LAS float* scr = (LAS float*)(F.lds + F.wave * 16384);
    for (int r = rank * 8 + F.wave; r < NEXP * 256; r += count * 8) { const int e = r >> 8, q = r & 255;
        tr_item(a.in[I_WED] + (size_t)e * 512 * 1024, 1024, nullptr, (bf16_t*)(F.ws + WS_WD) + (size_t)e * 1024 * 512, 512, MapSlot{}, scr, 64 * (q >> 5), 32 * (q & 31), F.lane); }
}
__device__ __forceinline__ void p0_prologue(Frame& F, const Args& a) {
    LAS float* scr = (LAS float*)(F.lds + F.wave * 16384);
    const int gw = F.vcu * 8 + F.wave, NGW = F.G * 8, lane = F.lane;
    unsigned char* ws = F.ws;
    constexpr int I0 = 16 * 69, I1 = 6 * 24, I2 = 4 * 32, I3 = 16 * 32, I4 = 16, I5 = NEXP * 256, I6 = NEXP * 256, I7 = WD_IN_P0 ? NEXP * 256 : 0, I8 = 4 * 32, I9 = 16 * 32;
    constexpr int NITEMS = I0 + I1 + I2 + I3 + I4 + I5 + I6 + I7 + I8 + I9;
    for (int it = gw; it < NITEMS; it += NGW) {
        int r = it;
        if (r < I0) { tr_item(a.in[I_WIN], INC, a.in[I_NMG], (bf16_t*)(ws + WS_WIN), 1024, MapWin{}, scr, 64 * (r / 69), 32 * (r % 69), lane); continue; } r -= I0;
        if (r < I1) { tr_item(a.in[I_WQUP], 768, a.in[I_QAG], (bf16_t*)(ws + WS_WQUP), 384, MapQup{}, scr, 64 * (r / 24), 32 * (r % 24), lane); continue; } r -= I1;
        if (r < I2) { tr_item(a.in[I_WKVUP], 1024, a.in[I_KVAG], (bf16_t*)(ws + WS_WKVUP), 256, MapKVup{}, scr, 64 * (r / 32), 32 * (r % 32), lane); continue; } r -= I2;
        if (r < I3) { tr_item(a.in[I_WOUT], 1024, nullptr, (bf16_t*)(ws + WS_WOUT), 1024, MapSlot{}, scr, 64 * (r / 32), 32 * (r % 32), lane); continue; } r -= I3;
        if (r < I4) { tr_item(a.in[I_WRE], 32, a.in[I_NFG], (bf16_t*)(ws + WS_WR), 1024, MapId{0}, scr, 64 * r, 0, lane); continue; } r -= I4;
        if (r < I5) { const int e = r >> 8, q = r & 255; tr_item(a.in[I_WEG] + (size_t)e * 1024 * 512, 512, a.in[I_NFG], (bf16_t*)(ws + WS_WGU) + (size_t)e * 1024 * 1024, 1024, MapGU{0}, scr, 64 * (q >> 4), 32 * (q & 15), lane); continue; } r -= I5;
        if (r < I6) { const int e = r >> 8, q = r & 255; tr_item(a.in[I_WEU] + (size_t)e * 1024 * 512, 512, a.in[I_NFG], (bf16_t*)(ws + WS_WGU) + (size_t)e * 1024 * 1024, 1024, MapGU{1}, scr, 64 * (q >> 4), 32 * (q & 15), lane); continue; } r -= I6;
        if (r < I7) { const int e = r >> 8, q = r & 255; tr_item(a.in[I_WED] + (size_t)e * 512 * 1024, 1024, nullptr, (bf16_t*)(ws + WS_WD) + (size_t)e * 1024 * 512, 512, MapSlot{}, scr, 64 * (q >> 5), 32 * (q & 31), lane); continue; } r -= I7;
        if (r < I8) { tr_item(a.in[I_WPP], 1024, nullptr, (bf16_t*)(ws + WS_WPP), 256, MapSlot{}, scr, 64 * (r / 32), 32 * (r % 32), lane); continue; } r -= I8;
        tr_item(a.in[I_WPG], 1024, nullptr, (bf16_t*)(ws + WS_WPG), 1024, MapSlot{}, scr, 64 * (r / 32), 32 * (r % 32), lane);
    }
    const int gt = F.vcu * 512 + F.tid, NGT = F.G * 512;
    { bf16_t* WR = (bf16_t*)(ws + WS_WR); const float* wrg = a.in[I_WRG]; const float* nfg = a.in[I_NFG];
      for (int i = gt; i < 224 * 1024; i += NGT) { const int rr = 32 + (i >> 10), k = i & 1023; float v = 0.f; if (rr >= 128 && rr < 132) v = wrg[k * 4 + (rr - 128)] * nfg[k]; WR[(size_t)rr * 1024 + k] = (bf16_t)(pk2(v, 0.f) & 0xffffu); }
      bf16_t* WI = (bf16_t*)(ws + WS_WIN);
      for (int i = gt; i < 96 * 1024; i += NGT) { const int q = i >> 10, k = i & 1023; const int rr = (q < 32) ? 1536 + slot_row(10, 32 + q) : 1536 + slot_row(11, q - 32); WI[(size_t)rr * 1024 + k] = 0; } }
    { float* cs = (float*)(ws + WS_ROPE);
      for (int i = gt; i < 2048 * 16; i += NGT) { const int pos = i >> 4, k = i & 15; const float inv = __builtin_amdgcn_exp2f(-(float)k * (13.287712379549449f / 16.0f));
          const float ang = (float)pos * inv; double rv = (double)ang * 0.15915494309189535; rv -= __builtin_floor(rv); const float rf = (float)rv;
          cs[pos * 32 + k] = __builtin_amdgcn_cosf(rf); cs[pos * 32 + 16 + k] = __builtin_amdgcn_sinf(rf); }
      float* tb = (float*)(ws + WS_TBG); const float* relb = a.in[I_RELB];
      for (int i = gt; i < 3 * 8 * 320; i += NGT) { const int br = i / 2560, hh = (i / 320) & 7, idx = i % 320, delta = idx - 96;
          float v = -1e30f; if (delta >= 0 && delta <= 128) v = relb[t5_bucket(delta << (2 * br)) * 8 + hh] * LOG2E; tb[i] = v; }
      { float* z0 = (float*)(ws + WS_SSQCQ); float* z1 = (float*)(ws + WS_SSQCKV); float* z2 = (float*)(ws + WS_SSQE); for (int i = gt; i < M; i += NGT) { z0[i] = 0.f; z1[i] = 0.f; z2[i] = 0.f; } }
      i32x4* rr4 = (i32x4*)(ws + WS_ROWREC); unsigned* ro = (unsigned*)(ws + WS_ROWOFF);
      for (int i = gt; i < MAXT * 256; i += NGT) { rr4[i] = (i32x4){-1, 0, 0, 0}; ro[i] = 0u; }
      i32x4* rr5 = (i32x4*)(ws + WS_ROWREC2); unsigned* ro5 = (unsigned*)(ws + WS_ROWOFF2);
      for (int i = gt; i < MAXTE * 256; i += NGT) { rr5[i] = (i32x4){-1, 0, 0, 0}; ro5[i] = 0u; } }
    { const f32x4* p4 = (const f32x4*)a.in[I_P]; u32x4* pb = (u32x4*)((char*)a.out + PB_IN_OUT);
      for (int i0 = gt; i0 < M * PLE / 8; i0 += 4 * NGT) { f32x4 u[4], v[4];
#pragma unroll
          for (int j = 0; j < 4; ++j) { const int i = i0 + j * NGT; if (i < M * PLE / 8) { u[j] = __builtin_nontemporal_load(p4 + 2 * i); v[j] = __builtin_nontemporal_load(p4 + 2 * i + 1); } }
#pragma unroll
          for (int j = 0; j < 4; ++j) { const int i = i0 + j * NGT; if (i < M * PLE / 8) { u32x4 o; o.x = pk2(u[j][0], u[j][1]); o.y = pk2(u[j][2], u[j][3]); o.z = pk2(v[j][0], v[j][1]); o.w = pk2(v[j][2], v[j][3]); pb[i] = o; } } } }
    { const float* x = a.in[I_X]; bf16_t* XB = (bf16_t*)(ws + WS_XB); float* rs1 = (float*)(ws + WS_RSTD1);
      for (int m0 = gw; m0 < M; m0 += 4 * NGW) {
          f32x4 v[4][4];
#pragma unroll
          for (int q = 0; q < 4; ++q) { const int m = m0 + q * NGW; if (m < M) { const f32x4* xr = (const f32x4*)(x + (size_t)m * DM) + lane;
#pragma unroll
              for (int j = 0; j < 4; ++j) v[q][j] = __builtin_nontemporal_load(xr + 64 * j); } }
#pragma unroll
          for (int q = 0; q < 4; ++q) { const int m = m0 + q * NGW; if (m < M) { float s = 0.f;
#pragma unroll
              for (int j = 0; j < 4; ++j) s += dot4(v[q][j]);
              const float rstd = rsq(wave_sum(s) * (1.f / DM) + EPS);
              if (lane == 0) rs1[m] = rstd;
              u32x2* o8 = (u32x2*)(XB + (size_t)m * DM) + lane;
#pragma unroll
              for (int j = 0; j < 4; ++j) { const f32x4 y = v[q][j]; u32x2 o; o.x = pk2(y[0], y[1]); o.y = pk2(y[2], y[3]); o8[64 * j] = o; } } }
      } }
}

__device__ __forceinline__ size_t hrow(size_t r, int hd) { return (r >> 11) * (8 * SEQ) + (size_t)hd * SEQ + (r & (SEQ - 1)); }
typedef f32x4 AccT[2][2][4][2];
#define EPI_ROWS for (int ai = 0; ai < 2; ++ai) _Pragma("unroll") for (int m = 0; m < 4; ({ if (m & 1) asm volatile("" ::: "memory"); }), ++m)
#define EPI_ROW(u) ((u).pm * 256 + ai * 128 + wr * 64 + m * 16 + fr)
#define EPI_FENCE() asm volatile("" ::: "memory")
#define EPI_HALF for (int ai = 0; ai < 2; ++ai)
#define EPI_M4 _Pragma("unroll") for (int m = 0; m < 4; ++m)

struct EpiInProj {
    bf16_t *QA, *KA, *VA, *CQ, *CKV, *KR; float *ssq_cq, *ssq_ckv; const float *qn_gain, *kn_gain, *knr_gain, *rope_cs;
    __device__ __forceinline__ void operator()(const AccT& acc, const pg8::Unit& u, int wr, int wc, int fr, int fq) const {
        const int pn = u.pn;
        if (pn < 4) {
            const bool isq = pn < 2; const int head = (pn & 1) * 4 + wc; const float* gain = isq ? qn_gain : kn_gain; bf16_t* dst = isq ? QA : KA; const float sc = isq ? C2A : 1.0f;
            f32x4 g[2][2];
#pragma unroll
            for (int bj = 0; bj < 2; ++bj)
#pragma unroll
                for (int n = 0; n < 2; ++n) g[bj][n] = *(const f32x4*)(gain + 32 * bj + 8 * fq + 4 * n) * sc;
#pragma unroll
            EPI_ROWS { const size_t row = EPI_ROW(u);
                float ss = dot4(acc[ai][0][m][0]) + dot4(acc[ai][0][m][1]) + dot4(acc[ai][1][m][0]) + dot4(acc[ai][1][m][1]); ss = red_fq(ss);
                const float rn = rsq(ss * (1.f / 64.f) + EPS);
#pragma unroll
                for (int bj = 0; bj < 2; ++bj) st8(dst + hrow(row, head) * 64 + 32 * bj + 8 * fq, acc[ai][bj][m][0] * rn * g[bj][0], acc[ai][bj][m][1] * rn * g[bj][1]); }
        } else if (pn < 6) {
#pragma unroll
            EPI_ROWS { const size_t row = EPI_ROW(u);
#pragma unroll
                for (int bj = 0; bj < 2; ++bj) { const int col = (pn - 4) * 256 + 64 * wc + 32 * bj + 8 * fq; st8(VA + hrow(row, col >> 6) * 64 + (col & 63), acc[ai][bj][m][0], acc[ai][bj][m][1]); } }
        } else {
            const int s = 4 * (pn - 6) + wc;
            if (s < 10) {
                const bool iscq = s < 6; bf16_t* dst = iscq ? CQ : CKV; const int ld = iscq ? 384 : 256; const int col = iscq ? 64 * s : 64 * (s - 6);
                float* sq = iscq ? ssq_cq : ssq_ckv;
#pragma unroll
                EPI_ROWS { const size_t row = EPI_ROW(u);
                    float ss = dot4(acc[ai][0][m][0]) + dot4(acc[ai][0][m][1]) + dot4(acc[ai][1][m][0]) + dot4(acc[ai][1][m][1]); ss = red_fq(ss);
                    if (fq == 0) (void)__hip_atomic_fetch_add(sq + row, ss, RLX_AGENT);
#pragma unroll
                    for (int bj = 0; bj < 2; ++bj) st8(dst + row * ld + col + 32 * bj + 8 * fq, acc[ai][bj][m][0], acc[ai][bj][m][1]); }
            } else if (s == 10) {
                const f32x4 g1 = *(const f32x4*)(knr_gain + 4 * fq), g2 = *(const f32x4*)(knr_gain + 16 + 4 * fq);
#pragma unroll
                EPI_HALF { f32x4 cv[4], sv[4];
                EPI_M4 { const int pos = (int)(EPI_ROW(u) & (SEQ - 1)); cv[m] = *(const f32x4*)(rope_cs + pos * 32 + 4 * fq); sv[m] = *(const f32x4*)(rope_cs + pos * 32 + 16 + 4 * fq); }
                EPI_M4 { const size_t row = EPI_ROW(u);
                    f32x4 x1 = acc[ai][0][m][0], x2 = acc[ai][0][m][1];
                    float ss = red_fq(dot4(x1) + dot4(x2)); const float rn = rsq(ss * (1.f / 32.f) + EPS);
                    x1 = x1 * rn * g1; x2 = x2 * rn * g2;
                    const f32x4 c = cv[m], sn = sv[m];
                    const f32x4 o1 = x1 * c - x2 * sn, o2 = x2 * c + x1 * sn;
                    u32x2 w1, w2; w1.x = pk2(o1[0], o1[1]); w1.y = pk2(o1[2], o1[3]); w2.x = pk2(o2[0], o2[1]); w2.y = pk2(o2[2], o2[3]);
                    *(u32x2*)(KR + row * 32 + 4 * fq) = w1; *(u32x2*)(KR + row * 32 + 16 + 4 * fq) = w2; }
                EPI_FENCE(); }
            }
        }
    }
};
struct EpiRawSsq {
    unsigned char* O; float* ssq;
    __device__ __forceinline__ void operator()(const AccT& acc, const pg8::Unit& u, int wr, int wc, int fr, int fq) const {
        const unsigned rowb = (unsigned)u.pm * 256u + wr * 64u + fr, colb = 256u * u.pn + 64u * wc + 8u * fq;
#pragma unroll
        EPI_ROWS { const unsigned row = rowb + ai * 128 + m * 16;
            float ss = dot4(acc[ai][0][m][0]) + dot4(acc[ai][0][m][1]) + dot4(acc[ai][1][m][0]) + dot4(acc[ai][1][m][1]); ss = red_fq(ss);
            if (fq == 0) (void)__hip_atomic_fetch_add(ssq + row, ss, RLX_AGENT);
#pragma unroll
            for (int bj = 0; bj < 2; ++bj) { const f32x4 a = acc[ai][bj][m][0], b = acc[ai][bj][m][1]; u32x2 w;
                w.x = (unsigned)__builtin_amdgcn_cvt_pk_fp8_f32(a[2], a[3], __builtin_amdgcn_cvt_pk_fp8_f32(a[0], a[1], 0, false), true);
                w.y = (unsigned)__builtin_amdgcn_cvt_pk_fp8_f32(b[2], b[3], __builtin_amdgcn_cvt_pk_fp8_f32(b[0], b[1], 0, false), true);
                *(u32x2*)(O + (row * 1024u + colb + 32u * bj)) = w; } }
    }
};
struct EpiQup {
    bf16_t* QM; const float *ssq_cq, *nope_gain, *rope_gain, *rope_cs;
    __device__ __forceinline__ void operator()(const AccT& acc, const pg8::Unit& u, int wr, int wc, int fr, int fq) const {
        const int pn = u.pn;
        if (pn < 2) {
            const int head = 4 * pn + wc; f32x4 g[2][2];
#pragma unroll
            for (int bj = 0; bj < 2; ++bj)
#pragma unroll
                for (int n = 0; n < 2; ++n) g[bj][n] = *(const f32x4*)(nope_gain + 32 * bj + 8 * fq + 4 * n) * C2M;
            float sq[2][4];
#pragma unroll
            EPI_HALF EPI_M4 sq[ai][m] = ssq_cq[EPI_ROW(u)];
#pragma unroll
            EPI_HALF EPI_M4 { const size_t row = EPI_ROW(u);
                const float rq = rsq(sq[ai][m] * (1.f / 384.f) + EPS);
                f32x4 v[2][2]; float ss = 0.f;
#pragma unroll
                for (int bj = 0; bj < 2; ++bj)
#pragma unroll
                    for (int n = 0; n < 2; ++n) { v[bj][n] = acc[ai][bj][m][n] * rq; ss += dot4(v[bj][n]); }
                ss = red_fq(ss); const float rn = rsq(ss * (1.f / 64.f) + EPS);
#pragma unroll
                for (int bj = 0; bj < 2; ++bj) st8(QM + hrow(row, head) * 96 + 32 * bj + 8 * fq, v[bj][0] * rn * g[bj][0], v[bj][1] * rn * g[bj][1]); }
        } else {
            const f32x4 g1 = *(const f32x4*)(rope_gain + 4 * fq) * C2M, g2 = *(const f32x4*)(rope_gain + 16 + 4 * fq) * C2M;
#pragma unroll
            EPI_HALF { float sq[4]; f32x4 cc[4], sn[4];
                EPI_M4 { const size_t row = EPI_ROW(u); const int pos = (int)(row & (SEQ - 1)); sq[m] = ssq_cq[row]; cc[m] = *(const f32x4*)(rope_cs + pos * 32 + 4 * fq); sn[m] = *(const f32x4*)(rope_cs + pos * 32 + 16 + 4 * fq); }
                EPI_M4 { const size_t row = EPI_ROW(u); const float rq = rsq(sq[m] * (1.f / 384.f) + EPS);
#pragma unroll
                    for (int bj = 0; bj < 2; ++bj) { const int head = 2 * wc + bj;
                        f32x4 x1 = acc[ai][bj][m][0] * rq, x2 = acc[ai][bj][m][1] * rq;
                        float ss = red_fq(dot4(x1) + dot4(x2)); const float rn = rsq(ss * (1.f / 32.f) + EPS);
                        x1 = x1 * rn * g1; x2 = x2 * rn * g2;
                        const f32x4 o1 = x1 * cc[m] - x2 * sn[m], o2 = x2 * cc[m] + x1 * sn[m];
                        u32x2 w1, w2; w1.x = pk2(o1[0], o1[1]); w1.y = pk2(o1[2], o1[3]); w2.x = pk2(o2[0], o2[1]); w2.y = pk2(o2[2], o2[3]);
                        *(u32x2*)(QM + hrow(row, head) * 96 + 64 + 4 * fq) = w1; *(u32x2*)(QM + hrow(row, head) * 96 + 80 + 4 * fq) = w2; } }
                EPI_FENCE(); }
        }
    }
};
struct EpiKVup {
    bf16_t *KN, *VM; const float *ssq_ckv, *nope_gain;
    __device__ __forceinline__ void operator()(const AccT& acc, const pg8::Unit& u, int wr, int wc, int fr, int fq) const {
        const int pn = u.pn;
        float sq[2][4];
#pragma unroll
        EPI_HALF EPI_M4 sq[ai][m] = ssq_ckv[EPI_ROW(u)];
        if (pn < 2) {
            const int head = 4 * pn + wc; f32x4 g[2][2];
#pragma unroll
            for (int bj = 0; bj < 2; ++bj)
#pragma unroll
                for (int n = 0; n < 2; ++n) g[bj][n] = *(const f32x4*)(nope_gain + 32 * bj + 8 * fq + 4 * n);
#pragma unroll
            EPI_HALF EPI_M4 { const size_t row = EPI_ROW(u);
                const float rk = rsq(sq[ai][m] * (1.f / 256.f) + EPS);
                f32x4 v[2][2]; float ss = 0.f;
#pragma unroll
                for (int bj = 0; bj < 2; ++bj)
#pragma unroll
                    for (int n = 0; n < 2; ++n) { v[bj][n] = acc[ai][bj][m][n] * rk; ss += dot4(v[bj][n]); }
                ss = red_fq(ss); const float rn = rsq(ss * (1.f / 64.f) + EPS);
#pragma unroll
                for (int bj = 0; bj < 2; ++bj) st8(KN + hrow(row, head) * 64 + 32 * bj + 8 * fq, v[bj][0] * rn * g[bj][0], v[bj][1] * rn * g[bj][1]); }
        } else {
#pragma unroll
            EPI_HALF EPI_M4 { const size_t row = EPI_ROW(u);
                const float rk = rsq(sq[ai][m] * (1.f / 256.f) + EPS);
#pragma unroll
                for (int bj = 0; bj < 2; ++bj) { const int col = (pn - 2) * 256 + 64 * wc + 32 * bj + 8 * fq; st8(VM + hrow(row, col >> 6) * 64 + (col & 63), acc[ai][bj][m][0] * rk, acc[ai][bj][m][1] * rk); } }
        }
    }
};
struct EpiWout {
    const bf16_t* XB; bf16_t* H1B; float* ssq;
    __device__ __forceinline__ void operator()(const AccT& acc, const pg8::Unit& u, int wr, int wc, int fr, int fq) const {
        const unsigned rowb = (unsigned)u.pm * 256u + wr * 64u + fr, offb = rowb * 1024u + 256u * u.pn + 64u * wc + 8u * fq;
        const char* const xc = (const char*)XB; char* const hc = (char*)H1B; char* const sc = (char*)ssq;
        u32x4 xv[2][4][2];
#pragma unroll
        for (int ai = 0; ai < 2; ++ai)
#pragma unroll
            for (int m = 0; m < 4; ++m)
#pragma unroll
                for (int bj = 0; bj < 2; ++bj) xv[ai][m][bj] = *(const u32x4*)(xc + (offb + (unsigned)(ai * 128 + m * 16) * 1024u + 32u * bj) * 2u);
        EPI_FENCE();
#pragma unroll
        for (int ai = 0; ai < 2; ++ai) {
#pragma unroll
            for (int m = 0; m < 4; ++m) { float ss = 0.f;
#pragma unroll
                for (int bj = 0; bj < 2; ++bj) { const u32x4 w = xv[ai][m][bj];
                    const f32x4 h0 = acc[ai][bj][m][0] + (f32x4){bflo(w.x), bfhi(w.x), bflo(w.y), bfhi(w.y)}, h1 = acc[ai][bj][m][1] + (f32x4){bflo(w.z), bfhi(w.z), bflo(w.w), bfhi(w.w)};
                    ss += dot4(h0) + dot4(h1); st8((bf16_t*)(hc + (offb + (unsigned)(ai * 128 + m * 16) * 1024u + 32u * bj) * 2u), h0, h1); }
                ss = red_fq(ss); if (fq == 0) *(float*)(sc + ((rowb + ai * 128 + m * 16) * 16u + 4u * u.pn + wc) * 4u) = ss; }
            EPI_FENCE(); }
    }
};
struct EpiNull {
    float* sink;
    __device__ __forceinline__ void operator()(const AccT& acc, const pg8::Unit& u, int wr, int wc, int fr, int fq) const {
        float s = 0.f;
#pragma unroll
        for (int ai = 0; ai < 2; ++ai)
#pragma unroll
            for (int bj = 0; bj < 2; ++bj)
#pragma unroll
                for (int m = 0; m < 4; ++m)
#pragma unroll
                    for (int n = 0; n < 2; ++n) s += acc[ai][bj][m][n][0] + acc[ai][bj][m][n][1] + acc[ai][bj][m][n][2] + acc[ai][bj][m][n][3];
        if (s == 1.2345e37f) sink[0] = s;
    }
};
struct EpiRoute {
    const float *ssq_h1, *b_rg, *b_re; float* rstd2; i32x4* route; unsigned* cnt;
    __device__ __forceinline__ void operator()(const AccT& acc, const pg8::Unit& u, int wr, int wc, int fr, int fq) const {
        if (wc != 0) return;
        const f32x4 be0 = *(const f32x4*)(b_re + 8 * fq), be1 = *(const f32x4*)(b_re + 8 * fq + 4), bg = *(const f32x4*)b_rg;
        float r2v[2][4];
#pragma unroll
        EPI_ROWS { const size_t row = EPI_ROW(u);
            float s = 0.f;
#pragma unroll
            for (int q = 0; q < 4; ++q) { const f32x4 t = *(const f32x4*)(ssq_h1 + row * 16 + 4 * q); s += (t[0] + t[1]) + (t[2] + t[3]); }
            r2v[ai][m] = rsq(s * (1.f / 1024.f) + EPS);
            if (fq == 0) rstd2[row] = r2v[ai][m]; }
        int pairv[2][4]; float wav[2][4], wbv[2][4]; bool mine[2][4];
#pragma unroll
        EPI_HALF EPI_M4 { const float r2 = r2v[ai][m];
            const f32x4 e0 = acc[ai][0][m][0] * r2 + be0, e1 = acc[ai][0][m][1] * r2 + be1;
            const f32x4 gloc = acc[ai][1][m][0] * r2 + bg;
            float gl[4];
#pragma unroll
            for (int j = 0; j < 4; ++j) gl[j] = __shfl(gloc[j], fr);
            int gi = 0; float gm = gl[0];
#pragma unroll
            for (int j = 1; j < 4; ++j) if (gl[j] > gm) { gm = gl[j]; gi = j; }
            float den = 0.f;
#pragma unroll
            for (int j = 0; j < 4; ++j) den += __expf(gl[j] - gm);
            const float gate = 1.0f / den;
            float el[8] = {e0[0], e0[1], e0[2], e0[3], e1[0], e1[1], e1[2], e1[3]};
            int i1 = 0; float l1 = el[0];
#pragma unroll
            for (int j = 1; j < 8; ++j) if (el[j] > l1) { l1 = el[j]; i1 = j; }
            int i2 = -1; float l2 = -INFINITY;
#pragma unroll
            for (int j = 0; j < 8; ++j) if (j != i1 && el[j] > l2) { l2 = el[j]; i2 = j; }
            const float w1 = gate / (1.0f + __expf(l2 - l1)), w2 = gate - w1;
            const int ea = i1 < i2 ? i1 : i2, eb = i1 < i2 ? i2 : i1;
            wav[ai][m] = i1 < i2 ? w1 : w2; wbv[ai][m] = i1 < i2 ? w2 : w1;
            pairv[ai][m] = gi * 28 + (ea * (15 - ea)) / 2 + (eb - ea - 1); mine[ai][m] = (fq == gi); }
        unsigned posv[2][4];
#pragma unroll
        EPI_HALF EPI_M4 { posv[ai][m] = 0u; if (mine[ai][m]) posv[ai][m] = __hip_atomic_fetch_add(cnt + 16 * pairv[ai][m], 1u, RLX_AGENT); }
#pragma unroll
        EPI_HALF EPI_M4 { if (mine[ai][m]) route[EPI_ROW(u)] = (i32x4){pairv[ai][m], (int)posv[ai][m], (int)__float_as_uint(wav[ai][m]), (int)__float_as_uint(wbv[ai][m])}; }
    }
};
struct EpiGateUp {
    const i32x4* rowrec2; bf16_t* HDN;
    __device__ __forceinline__ void operator()(const AccT& acc, const pg8::Unit& u, int wr, int wc, int fr, int fq) const {
        const unsigned rowb = (unsigned)u.pm * 256u + wr * 64u + fr, colb = (unsigned)u.pn * 128u + 32u * wc + 8u * fq;
        const char* const rc = (const char*)rowrec2; char* const hc = (char*)HDN;
        i32x4 rec[2][4];
#pragma unroll
        for (int ai = 0; ai < 2; ++ai)
#pragma unroll
            for (int m = 0; m < 4; ++m) rec[ai][m] = *(const i32x4*)(rc + (rowb + ai * 128 + m * 16) * 16u);
        EPI_FENCE();
#pragma unroll
        for (int ai = 0; ai < 2; ++ai) {
#pragma unroll
            for (int m = 0; m < 4; ++m) { const i32x4 rcd = rec[ai][m];
                const float r2 = __uint_as_float((unsigned)rcd.y), w = __uint_as_float((unsigned)rcd.z); const unsigned pr = (unsigned)rcd.w >> 1, slot = (unsigned)rcd.w & 1u;
                f32x4 hd[2];
#pragma unroll
                for (int n = 0; n < 2; ++n)
#pragma unroll
                    for (int e = 0; e < 4; ++e) { const float g = acc[ai][0][m][n][e] * r2, up = acc[ai][1][m][n][e] * r2; hd[n][e] = g * frcp(1.0f + fexp2(-g * LOG2E)) * up * w; }
                const unsigned eoff = rcd.x >= 0 ? pr * 1024u + slot * 512u + colb : (unsigned)((WS_DUMMY - WS_HDN) / 2) + colb;
                st8((bf16_t*)(hc + eoff * 2u), hd[0], hd[1]); }
            EPI_FENCE(); }
    }
};
struct EpiDown {
    const i32x4* rowrec; const bf16_t* H1B; bf16_t* H2B;
    __device__ __forceinline__ void operator()(const AccT& acc, const pg8::Unit& u, int wr, int wc, int fr, int fq) const {
        const unsigned rowb = (unsigned)u.pm * 256u + wr * 64u + fr, colb = 256u * u.pn + 64u * wc + 8u * fq;
        const char* const rc = (const char*)rowrec; const char* const h1c = (const char*)H1B; char* const h2c = (char*)H2B;
        int tk[2][4];
#pragma unroll
        for (int ai = 0; ai < 2; ++ai)
#pragma unroll
            for (int m = 0; m < 4; ++m) tk[ai][m] = *(const int*)(rc + (rowb + ai * 128 + m * 16) * 16u);
        u32x4 hv[2][4][2];
#pragma unroll
        for (int ai = 0; ai < 2; ++ai)
#pragma unroll
            for (int m = 0; m < 4; ++m) { const unsigned tok = tk[ai][m] < 0 ? 0u : (unsigned)tk[ai][m];
#pragma unroll
                for (int bj = 0; bj < 2; ++bj) hv[ai][m][bj] = *(const u32x4*)(h1c + (tok * 1024u + colb + 32u * bj) * 2u); }
        EPI_FENCE();
#pragma unroll
        for (int ai = 0; ai < 2; ++ai) {
#pragma unroll
            for (int m = 0; m < 4; ++m) { const int tok = tk[ai][m];
                const unsigned eoff = tok >= 0 ? (unsigned)tok * 1024u + colb : (unsigned)((WS_DUMMY - WS_H2B) / 2) + (colb & 1023u);
#pragma unroll
                for (int bj = 0; bj < 2; ++bj) { const u32x4 w = hv[ai][m][bj];
                    const f32x4 a = (f32x4){bflo(w.x), bfhi(w.x), bflo(w.y), bfhi(w.y)}, b = (f32x4){bflo(w.z), bfhi(w.z), bflo(w.w), bfhi(w.w)};
                    st8((bf16_t*)(h2c + (eoff + 32u * bj) * 2u), a + acc[ai][bj][m][0], b + acc[ai][bj][m][1]); } }
            EPI_FENCE(); }
    }
};
struct EpiFinal {
    const bf16_t *H2B, *E; const float* ssq_e; const LAS float* tb; float* out;
    __device__ __forceinline__ void operator()(const AccT& acc, const pg8::Unit& u, int wr, int wc, int fr, int fq) const {
        const unsigned colb = 256u * u.pn + 64u * wc + 8u * fq;
        const unsigned rowb = (unsigned)u.pm * 256u + wr * 64u + fr, offb = rowb * 1024u + colb;
        const char* const h2c = (const char*)H2B; const char* const ec = (const char*)E; const char* const sqc = (const char*)ssq_e; char* const oc = (char*)out;
        u32x4 hv[2][4][2]; u32x2 ev[2][4][2]; float sq[2][4]; unsigned sp[2][2][4][4];
#define EPIF_OFF(ai, m, bj) (offb + (unsigned)((ai) * 128 + (m) * 16) * 1024u + 32u * (bj))
#define EPIF_LOAD_E(ai) do { _Pragma("unroll") for (int m = 0; m < 4; ++m) { sq[ai][m] = *(const float*)(sqc + (rowb + (ai) * 128 + m * 16) * 4u); \
            _Pragma("unroll") for (int bj = 0; bj < 2; ++bj) ev[ai][m][bj] = *(const u32x2*)(ec + EPIF_OFF(ai, m, bj)); } } while (0)
#define EPIF_LOAD_H(ai) do { _Pragma("unroll") for (int m = 0; m < 4; ++m) _Pragma("unroll") for (int bj = 0; bj < 2; ++bj) hv[ai][m][bj] = *(const u32x4*)(h2c + EPIF_OFF(ai, m, bj) * 2u); } while (0)
        EPIF_LOAD_E(0); EPIF_LOAD_E(1);
        __builtin_amdgcn_sched_barrier(0);
#pragma unroll
        for (int bj = 0; bj < 2; ++bj) {
            const f32x4 bp0 = *(const LAS f32x4*)(tb + colb + 32 * bj), bp1 = *(const LAS f32x4*)(tb + colb + 32 * bj + 4);
#pragma unroll
            for (int ai = 0; ai < 2; ++ai)
#pragma unroll
                for (int m = 0; m < 4; ++m) {
                    const f32x4 z0 = acc[ai][bj][m][0] * (-LOG2E) + bp0, z1 = acc[ai][bj][m][1] * (-LOG2E) + bp1;
                    f32x4 s0, s1;
#pragma unroll
                    for (int e = 0; e < 4; ++e) { s0[e] = frcp(1.0f + fexp2(z0[e])); s1[e] = frcp(1.0f + fexp2(z1[e])); }
                    sp[ai][bj][m][0] = pk2(s0[0], s0[1]); sp[ai][bj][m][1] = pk2(s0[2], s0[3]); sp[ai][bj][m][2] = pk2(s1[0], s1[1]); sp[ai][bj][m][3] = pk2(s1[2], s1[3]); __builtin_amdgcn_sched_barrier(0); }
            __builtin_amdgcn_sched_barrier(0); }
        EPIF_LOAD_H(0); __builtin_amdgcn_sched_barrier(0); EPIF_LOAD_H(1);
        __builtin_amdgcn_sched_barrier(0);
#pragma unroll
        for (int ai = 0; ai < 2; ++ai) {
#pragma unroll
            for (int bj = 0; bj < 2; ++bj) {
                const f32x4 gn0 = *(const LAS f32x4*)(tb + 1024 + colb + 32 * bj), gn1 = *(const LAS f32x4*)(tb + 1024 + colb + 32 * bj + 4);
#pragma unroll
                for (int m = 0; m < 4; ++m) { const float re = rsq(sq[ai][m] * (1.f / 1024.f) + EPS); const u32x4 hw = hv[ai][m][bj]; const u32x2 ew = ev[ai][m][bj];
                    const unsigned* q = sp[ai][bj][m];
                    const f32x4 h0 = (f32x4){bflo(hw.x), bfhi(hw.x), bflo(hw.y), bfhi(hw.y)}, h1 = (f32x4){bflo(hw.z), bfhi(hw.z), bflo(hw.w), bfhi(hw.w)};
                    const f32x2 ea = __builtin_amdgcn_cvt_pk_f32_fp8((int)ew.x, false), eb = __builtin_amdgcn_cvt_pk_f32_fp8((int)ew.x, true), ec2 = __builtin_amdgcn_cvt_pk_f32_fp8((int)ew.y, false), ed = __builtin_amdgcn_cvt_pk_f32_fp8((int)ew.y, true);
                    const f32x4 e0 = (f32x4){ea[0], ea[1], eb[0], eb[1]} * gn0 * re, e1 = (f32x4){ec2[0], ec2[1], ed[0], ed[1]} * gn1 * re;
                    const f32x4 g0 = (f32x4){bflo(q[0]), bfhi(q[0]), bflo(q[1]), bfhi(q[1])}, g1 = (f32x4){bflo(q[2]), bfhi(q[2]), bflo(q[3]), bfhi(q[3])};
                    char* o = oc + EPIF_OFF(ai, m, bj) * 4u;
                    *(f32x4*)o = h0 + g0 * e0; *(f32x4*)(o + 16) = h1 + g1 * e1; __builtin_amdgcn_sched_barrier(0); } }
            __builtin_amdgcn_sched_barrier(0); }
#undef EPIF_LOAD_E
#undef EPIF_LOAD_H
#undef EPIF_OFF
    }
};

struct MoeSchedUp {
    const LAS int* tinfoE; int T, G, c; const char* A; const char* W; const unsigned* rowoff;
    __device__ __forceinline__ bool next(int i, pg8::Unit& u) const { const int nun = T * 4, L = i * G + c; if (L >= nun) return false; const int w = pg8::xcd_remap(L, nun); u.pm = w >> 2; u.pn = w & 3; return true; }
    __device__ __forceinline__ const char* a_base(const pg8::Unit&) const { return A; }
    __device__ __forceinline__ const char* b_base(const pg8::Unit& u) const { const int e = tinfoE[u.pm]; return W + (size_t)e * (1024 * 1024 * 2) + (size_t)u.pn * (256 * 1024 * 2); }
    __device__ __forceinline__ const char* b_base2(const pg8::Unit& u) const { return b_base(u); }
    __device__ __forceinline__ const unsigned* a_rowptr(const pg8::Unit& u, int r) const { return rowoff + u.pm * 256 + r; }
};
struct MoeSchedDown {
    const LAS int* tinfo; int T, G, c; const char* A; const char* W;
    __device__ __forceinline__ bool next(int i, pg8::Unit& u) const { const int nun = T * 4, L = i * G + c; if (L >= nun) return false; const int w = pg8::xcd_remap(L, nun); u.pm = w >> 2; u.pn = w & 3; return true; }
    __device__ __forceinline__ const char* a_base(const pg8::Unit& u) const { return A + (size_t)u.pm * (256 * 1024 * 2); }
    __device__ __forceinline__ const char* b_base(const pg8::Unit& u) const { const int e = tinfo[u.pm] >> 8; return W + (size_t)e * (1024 * 512 * 2) + (size_t)u.pn * (256 * 512 * 2); }
    __device__ __forceinline__ const char* b_base2(const pg8::Unit& u) const { const int e = tinfo[u.pm] & 255; return W + (size_t)e * (1024 * 512 * 2) + (size_t)u.pn * (256 * 512 * 2); }
    __device__ __forceinline__ const unsigned* a_rowptr(const pg8::Unit&, int) const { return nullptr; }
};

#ifndef MK_REPEAT
#define MK_REPEAT 0
#endif
#define WSP(T, off) ((T*)(F.ws + (off)))
__device__ __forceinline__ void phase1(Frame& F, const Args& args) {
    {
        pg8::DenseSched S; S.init(WSP(const bf16_t, WS_XB), WSP(const bf16_t, WS_WIN), M, INC_PAD, 1024, F.G, (int)blockIdx.x, WGM_INPROJ); S.rs = WSP(const float, WS_RSTD1);
        EpiInProj E{WSP(bf16_t, WS_QA), WSP(bf16_t, WS_KA), WSP(bf16_t, WS_VA), WSP(bf16_t, WS_CQ), WSP(bf16_t, WS_CKV), WSP(bf16_t, WS_KROPE),
                    WSP(float, WS_SSQCQ), WSP(float, WS_SSQCKV), args.in[I_QNA], args.in[I_KNA], args.in[I_KNR], WSP(const float, WS_ROPE)};
        pg8::gemm_phase<EpiInProj, pg8::DenseSched, false, false, true>(F.lds, 1024, S, E);
    }
}
__device__ __forceinline__ void phase2(Frame& F, const Args& args) {
    {
        pg8::DenseSched S; S.init(WSP(const bf16_t, WS_CQ), WSP(const bf16_t, WS_WQUP), M, 768, 384, F.G, (int)blockIdx.x);
        EpiQup E{WSP(bf16_t, WS_QM), WSP(const float, WS_SSQCQ), args.in[I_QNN], args.in[I_QNR], WSP(const float, WS_ROPE)};
        pg8::gemm_phase<EpiQup, pg8::DenseSched, false, false>(F.lds, 384, S, E);
    }
    {
        pg8::DenseSched S; S.init(WSP(const bf16_t, WS_CKV), WSP(const bf16_t, WS_WKVUP), M, 1024, 256, F.G, (int)blockIdx.x);
        EpiKVup E{WSP(bf16_t, WS_KN), WSP(bf16_t, WS_VM), WSP(const float, WS_SSQCKV), args.in[I_KNN]};
        pg8::gemm_phase<EpiKVup, pg8::DenseSched, false, false>(F.lds, 256, S, E);
    }
}
__device__ __forceinline__ void phase3(Frame& F, const Args& args) {
    LAS char* shm = (LAS char*)F.lds;
    LAS float* tbl = (LAS float*)(F.lds + TB_OFF);
    if (F.G == 256) {
        const int xcd = F.vcu >> 5, jj = F.vcu & 31, grp = jj >> 2, k = jj & 3;
        att::mla_chain(xcd, grp, k, WSP(const bf16_t, WS_QM), WSP(const bf16_t, WS_KN), WSP(const bf16_t, WS_KROPE), WSP(const bf16_t, WS_VM), (bf16_t*)args.out, shm);
    } else {
        for (int bh = F.vcu; bh < BATCH * 8; bh += F.G)
            for (int qb = 0; qb < 8; ++qb)
                att::mla_unit<0>(bh >> 3, bh & 7, qb, WSP(const bf16_t, WS_QM), WSP(const bf16_t, WS_KN), WSP(const bf16_t, WS_KROPE), WSP(const bf16_t, WS_VM), (bf16_t*)args.out, shm);
    }
    for (int bh = F.vcu; bh < BATCH * 8; bh += F.G) {
        const int b = bh >> 3, h = bh & 7;
        for (int i = F.tid; i < 960; i += 512) tbl[i] = WSP(const float, WS_TBG)[(i / 320) * 2560 + h * 320 + (i % 320)];
        __syncthreads();
#if (MK_REPEAT >> 16) & 7
        att::dil_phase2<(MK_REPEAT >> 16) & 7>(b, h, WSP(const bf16_t, WS_QA), WSP(const bf16_t, WS_KA), WSP(const bf16_t, WS_VA), WSP(bf16_t, WS_O2), WSP(bf16_t, WS_O3),
                            WSP(float, WS_LSE2), WSP(float, WS_LSE3), (bf16_t*)args.out, shm, tbl);
#endif
        for (int rep = 0; rep < (((MK_REPEAT >> 11) & 1) ? 2 : 1); ++rep)
            att::dil_phase2<0>(b, h, WSP(const bf16_t, WS_QA), WSP(const bf16_t, WS_KA), WSP(const bf16_t, WS_VA), WSP(bf16_t, WS_O2), WSP(bf16_t, WS_O3),
                            WSP(float, WS_LSE2), WSP(float, WS_LSE3), (bf16_t*)args.out, shm, tbl);
        __syncthreads();
    }
}
__device__ __forceinline__ void phase4(Frame& F, const Args& args) {
#if (MK_REPEAT >> 18) & 1
    { pg8::DenseSched S; S.init((const bf16_t*)args.out, WSP(const bf16_t, WS_WOUT), M, 1024, 1024, F.G, (int)blockIdx.x);
      EpiNull E{WSP(float, WS_RSTD2)}; pg8::gemm_phase<EpiNull, pg8::DenseSched, false, false>(F.lds, 1024, S, E); }
#endif
    pg8::DenseSched S; S.init((const bf16_t*)args.out, WSP(const bf16_t, WS_WOUT), M, 1024, 1024, F.G, (int)blockIdx.x);
    EpiWout E{WSP(const bf16_t, WS_XB), WSP(bf16_t, WS_H1B), WSP(float, WS_SSQH1)};
    pg8::gemm_phase<EpiWout, pg8::DenseSched, false, false>(F.lds, 1024, S, E);
}
__device__ __forceinline__ void phase5(Frame& F, const Args& args) {
    pg8::DenseSched S; S.init(WSP(const bf16_t, WS_H1B), WSP(const bf16_t, WS_WR), M, 256, 1024, F.G, (int)blockIdx.x);
    EpiRoute E{WSP(const float, WS_SSQH1), args.in[I_BRG], args.in[I_BRE], WSP(float, WS_RSTD2), WSP(i32x4, WS_ROUTE), F.ctl + CW_CNT};
    pg8::gemm_phase<EpiRoute, pg8::DenseSched, false, false>(F.lds, 1024, S, E);
}
__device__ __forceinline__ int pair_index(int g, int x, int y) { const int a = x < y ? x : y, b = x < y ? y : x; return g * 28 + (a * (15 - a)) / 2 + (b - a - 1); }
__device__ __forceinline__ void phase6(Frame& F, const Args& args) {
    LAS int* mo_cnt = (LAS int*)(F.lds + MOE_OFF); LAS int* mo_start = mo_cnt + 128; LAS int* tinfo = mo_cnt + 256;
    LAS int* e_cnt = (LAS int*)(F.lds + MOE_E_OFF); LAS int* e_start = e_cnt + 32; LAS int* tinfoE = e_cnt + 96;
    LAS int* offA = (LAS int*)(F.lds + MOE_O_OFF); LAS int* offB = offA + 128;
    if (F.tid < NPAIR) mo_cnt[F.tid] = (int)__hip_atomic_load(F.ctl + CW_CNT + 16 * F.tid, RLX_AGENT);
    __syncthreads();
    if (F.tid == 0) { int acc = 0; for (int p = 0; p < NPAIR; ++p) { mo_start[p] = acc; acc += (mo_cnt[p] + 255) >> 8; } mo_start[NPAIR] = acc; }
    if (F.tid >= 128 && F.tid < 128 + NEXP) { const int e = F.tid - 128, g = e >> 3, x = e & 7; int s = 0; for (int y = 0; y < 8; ++y) if (y != x) s += mo_cnt[pair_index(g, x, y)]; e_cnt[e] = s; }
    if (F.tid >= 256 && F.tid < 256 + NPAIR) { const int p = F.tid - 256, g = p / 28, q = p % 28; int ea = 0; while (ea < 6 && ((ea + 1) * (14 - ea)) / 2 <= q) ++ea; const int eb = ea + 1 + (q - (ea * (15 - ea)) / 2);
        int sa = 0, sb = 0;
        for (int y = 0; y < 8; ++y) { if (y != ea) { const int pp = pair_index(g, ea, y); if (pp < p) sa += mo_cnt[pp]; } if (y != eb) { const int pp = pair_index(g, eb, y); if (pp < p) sb += mo_cnt[pp]; } }
        offA[p] = sa; offB[p] = sb; }
    __syncthreads();
    if (F.tid == 64) { int acc = 0; for (int e = 0; e < NEXP; ++e) { e_start[e] = acc; acc += (e_cnt[e] + 255) >> 8; } e_start[NEXP] = acc; }
    if (F.tid < NPAIR) { const int p = F.tid, g = p / 28, q = p % 28; int ea = 0; while (ea < 6 && ((ea + 1) * (14 - ea)) / 2 <= q) ++ea; const int eb = ea + 1 + (q - (ea * (15 - ea)) / 2);
        const int info = ((8 * g + ea) << 8) | (8 * g + eb); const int t0 = mo_start[p], t1 = mo_start[p + 1]; for (int t = t0; t < t1; ++t) tinfo[t] = info; }
    __syncthreads();
    if (F.tid >= 128 && F.tid < 128 + NEXP) { const int e = F.tid - 128; const int t0 = e_start[e], t1 = e_start[e + 1]; for (int t = t0; t < t1; ++t) tinfoE[t] = e; }
    __syncthreads();
    const i32x4* route = WSP(const i32x4, WS_ROUTE); const float* rstd2 = WSP(const float, WS_RSTD2);
    i32x4* rowrec = WSP(i32x4, WS_ROWREC); i32x4* rowrec2 = WSP(i32x4, WS_ROWREC2); unsigned* rowoff2 = WSP(unsigned, WS_ROWOFF2);
    for (int tok = F.vcu * 512 + F.tid; tok < M; tok += F.G * 512) { const i32x4 r = route[tok]; const int p = r.x; const int prow = (mo_start[p] << 8) + r.y; const int rs = (int)__float_as_uint(rstd2[tok]);
        rowrec[prow] = (i32x4){tok, rs, r.z, r.w};
        const int info = tinfo[mo_start[p]]; const int xa = info >> 8, xb = info & 255;
        const int ra = (e_start[xa] << 8) + offA[p] + r.y, rb = (e_start[xb] << 8) + offB[p] + r.y;
        rowrec2[ra] = (i32x4){tok, rs, r.z, 2 * prow}; rowoff2[ra] = (unsigned)tok * 2048u;
        rowrec2[rb] = (i32x4){tok, rs, r.w, 2 * prow + 1}; rowoff2[rb] = (unsigned)tok * 2048u; }
}
__device__ __forceinline__ void phase7(Frame& F, const Args& args) {
    const LAS int* e_start = (const LAS int*)(F.lds + MOE_E_OFF) + 32; const LAS int* tinfoE = (const LAS int*)(F.lds + MOE_E_OFF) + 96;
    MoeSchedUp S{tinfoE, e_start[NEXP], F.G, (int)blockIdx.x, WSP(const char, WS_H1B), WSP(const char, WS_WGU), WSP(const unsigned, WS_ROWOFF2)};
    EpiGateUp E{WSP(const i32x4, WS_ROWREC2), WSP(bf16_t, WS_HDN)};
    pg8::gemm_phase<EpiGateUp, MoeSchedUp, true, false>(F.lds, 1024, S, E);
    if (!WD_IN_P0) {
        const int rem = (e_start[NEXP] * 4) % F.G, c = (int)blockIdx.x;
        if (rem == 0) convert_wd(F, args, c, F.G); else if (c >= rem) convert_wd(F, args, c - rem, F.G - rem);
    }
}
__device__ __forceinline__ void phase8(Frame& F, const Args& args) {
    const LAS int* mo_start = (const LAS int*)(F.lds + MOE_OFF) + 128; const LAS int* tinfo = (const LAS int*)(F.lds + MOE_OFF) + 256;
    MoeSchedDown S{tinfo, mo_start[NPAIR], F.G, (int)blockIdx.x, WSP(const char, WS_HDN), WSP(const char, WS_WD)};
    EpiDown E{WSP(const i32x4, WS_ROWREC), WSP(const bf16_t, WS_H1B), WSP(bf16_t, WS_H2B)};
    pg8::gemm_phase<EpiDown, MoeSchedDown, false, true>(F.lds, 1024, S, E);
    {
        pg8::DenseSched S2; S2.init((const bf16_t*)((const char*)args.out + PB_IN_OUT), WSP(const bf16_t, WS_WPP), M, 1024, 256, F.G, (int)blockIdx.x);
        EpiRawSsq E2{WSP(unsigned char, WS_E), WSP(float, WS_SSQE)};
        pg8::gemm_phase<EpiRawSsq, pg8::DenseSched, false, false>(F.lds, 256, S2, E2);
    }
}
#ifndef MK_STAGGER9
#define MK_STAGGER9 0
#endif
__device__ __forceinline__ void stagger_start(unsigned ticks) {
    if (ticks) { const unsigned long long t0 = __builtin_amdgcn_s_memrealtime(); while (__builtin_amdgcn_s_memrealtime() - t0 < (unsigned long long)ticks) __builtin_amdgcn_s_sleep(16); }
}
__device__ __forceinline__ void phase9(Frame& F, const Args& args, const bf16_t* Esrc) {
    stagger_start(((blockIdx.x >> 3) & 3) * MK_STAGGER9);
    pg8::DenseSched S; S.init(WSP(const bf16_t, WS_H2B), WSP(const bf16_t, WS_WPG), M, 1024, 1024, F.G, (int)blockIdx.x);
    LAS float* tb = (LAS float*)(F.lds + TB_OFF);
    for (int i = F.tid; i < 1024; i += 512) { tb[i] = args.in[I_BPG][i] * (-LOG2E); tb[1024 + i] = args.in[I_PNG][i]; }
    __syncthreads();
    EpiFinal E{WSP(const bf16_t, WS_H2B), Esrc, WSP(const float, WS_SSQE), tb, args.out};
    pg8::gemm_phase<EpiFinal, pg8::DenseSched, false, false>(F.lds, 1024, S, E);
}

__global__ void __launch_bounds__(512, 2) hybrid_fwd(Args args) {
    extern __shared__ __attribute__((aligned(16))) unsigned char lds_raw[];
    Frame F;
    F.lds = (LAS unsigned char*)lds_raw;
    F.MISC = (volatile LAS unsigned*)(F.lds + MISC_OFF);
    F.tid = threadIdx.x; F.lane = F.tid & 63; F.wave = __builtin_amdgcn_readfirstlane(F.tid >> 6);
    F.G = gridDim.x; { const int bx = blockIdx.x; F.vcu = (F.G % 8 == 0) ? (bx % 8) * (F.G / 8) + bx / 8 : bx; }
    F.ws = args.ws; F.ctl = (unsigned*)(args.ws + WS_CTL);
    for (int u = F.tid; u < 128; u += 512) ((LAS unsigned*)(F.lds + MISC_OFF))[u] = 0u;
    __syncthreads();
    XcdBarrier bar = xcd_barrier_post(F.ctl + CW_BAR, F.MISC + 8);
#define RUN(k, call) do { call; if ((MK_REPEAT >> (k)) & 1) { xcd_barrier(bar); call; } } while (0)
    RUN(0, p0_prologue(F, args)); xcd_barrier(bar);
    RUN(1, phase1(F, args)); xcd_barrier(bar);
    RUN(2, phase2(F, args)); xcd_barrier(bar);
    RUN(3, phase3(F, args)); xcd_barrier(bar);
    RUN(4, phase4(F, args)); xcd_barrier(bar);
    phase5(F, args); xcd_barrier(bar);
    phase6(F, args); xcd_barrier(bar);
    RUN(7, phase7(F, args)); xcd_barrier(bar);
    RUN(8, phase8(F, args)); xcd_barrier(bar);
    phase9(F, args, WSP(const bf16_t, WS_E));
#undef RUN
}

extern "C" void kernel_launch(void* const* d_in, const int* in_sizes, int n_in, void* d_out, int out_size, void* d_ws, size_t ws_size, hipStream_t stream) {
    static int grid = 0;
    if (grid == 0) {
        if (n_in != 28 || in_sizes[0] != M * DM || out_size != M * DM || ws_size < WS_END) { fprintf(stderr, "kernel_launch: unexpected problem (n_in %d, in0 %d, out %d, ws %zu); nothing launched\n", n_in, n_in > 0 ? in_sizes[0] : -1, out_size, ws_size); grid = -1; return; }
        int dev = 0, cus = 0, per_cu = 0;
        if (hipGetDevice(&dev) != hipSuccess || hipDeviceGetAttribute(&cus, hipDeviceAttributeMultiprocessorCount, dev) != hipSuccess) { grid = -1; return; }
        if (hipFuncSetAttribute((const void*)hybrid_fwd, hipFuncAttributeMaxDynamicSharedMemorySize, LDS_BYTES) != hipSuccess) { fprintf(stderr, "kernel_launch: hipFuncSetAttribute failed\n"); grid = -1; return; }
        if (hipOccupancyMaxActiveBlocksPerMultiprocessor(&per_cu, (const void*)hybrid_fwd, 512, LDS_BYTES) != hipSuccess || per_cu < 1) { fprintf(stderr, "kernel_launch: occupancy query reports %d workgroups per CU\n", per_cu); }
        (void)hipGetLastError();
        grid = cus;
    }
    if (grid < 0) return;
    if (hipMemsetAsync((char*)d_ws + WS_CTL, 0, CTL_ZERO_BYTES, stream) != hipSuccess) return;
    Args a{};
    for (int i = 0; i < 28; ++i) a.in[i] = (const float*)d_in[i];
    a.out = (float*)d_out; a.ws = (unsigned char*)d_ws;
    hipLaunchKernelGGL(hybrid_fwd, dim3(grid), dim3(512), LDS_BYTES, stream, a);
}
```

```cpp
#ifndef MK_REPEAT
#define MK_REPEAT 0
#endif
#ifndef WGM_INPROJ
#define WGM_INPROJ 8
#endif
#include <hip/hip_runtime.h>
#include <cstdio>
#include <cstdint>

#define LAS __attribute__((address_space(3)))
#define GAS __attribute__((address_space(1)))
typedef unsigned short bf16_t;
typedef short bf16x8 __attribute__((ext_vector_type(8)));
typedef short s16x4 __attribute__((ext_vector_type(4)));
typedef short v4i16_t __attribute__((ext_vector_type(4)));
typedef float f32x4 __attribute__((ext_vector_type(4)));
typedef float f32x2 __attribute__((ext_vector_type(2)));
typedef float f32x16 __attribute__((ext_vector_type(16)));
typedef unsigned u32x4 __attribute__((ext_vector_type(4)));
typedef unsigned u32x2 __attribute__((ext_vector_type(2)));
typedef int i32x4 __attribute__((ext_vector_type(4)));
typedef int i32x8 __attribute__((ext_vector_type(8)));
typedef __bf16 bf16x2_t __attribute__((ext_vector_type(2)));

constexpr int BATCH = 32, SEQ = 2048, DM = 1024, M = BATCH * SEQ;
constexpr int PLE = 256;
constexpr int AW = 512, QLORA = 384, KVLORA = 256, ROPE = 32;
constexpr int INC = 2208, INC_PAD = 2304;
constexpr int NEXP = 32, EFF = 512, NPAIR = 112;
constexpr int MAXT = 368;
constexpr int MAXTE = 544;
constexpr float EPS = 1e-6f;
constexpr float LOG2E = 1.4426950408889634f;
constexpr int FP8_WS2 = 6; constexpr float FP8_WMUL = 64.0f;
constexpr int FP8_MIX_AS2 = 3, FP8_HDN_AS2 = 2;
constexpr float FP8_MIX_MUL = 8.0f, FP8_HDN_MUL = 4.0f;
constexpr float C2A = 0.125f * LOG2E;
constexpr float C2M = 0.10206207261596575f * LOG2E;

constexpr size_t MiB = 1u << 20;
constexpr size_t WS_CTL = 0, CTL_ZERO_BYTES = 1 * MiB;
constexpr size_t WS_TBG = 1 * MiB;
constexpr size_t WS_ROPE = 1 * MiB + 65536;
constexpr size_t WS_ROWREC = 2 * MiB;
constexpr size_t WS_ROWOFF = 3 * MiB + 524288;
constexpr size_t WS_ROUTE = 4 * MiB;
constexpr size_t WS_RSTD2 = 5 * MiB;
constexpr size_t WS_RSTD1 = 5 * MiB + 524288;
constexpr size_t WS_SSQCQ = 6 * MiB;
constexpr size_t WS_SSQCKV = 8 * MiB;
constexpr size_t WS_SSQH1 = 9 * MiB;
constexpr size_t WS_SSQE = 13 * MiB;
constexpr size_t WS_LSE2 = 17 * MiB;
constexpr size_t WS_LSE3 = 19 * MiB;
constexpr size_t WS_ROWREC2 = 13 * MiB + 524288;
constexpr size_t WS_ROWOFF2 = 16 * MiB;
constexpr size_t WS_KROPE = 21 * MiB;
constexpr size_t WS_WIN = 25 * MiB;
constexpr size_t WS_WQUP = 30 * MiB;
constexpr size_t WS_WKVUP = 31 * MiB;
constexpr size_t WS_WR = 32 * MiB;
constexpr size_t WS_WOUT = 33 * MiB;
constexpr size_t WS_WPP = 35 * MiB;
constexpr size_t WS_WPG = 36 * MiB;
constexpr size_t WS_WGU = 40 * MiB;
constexpr size_t WS_WD = 104 * MiB;
constexpr size_t WS_XB8 = 136 * MiB;
constexpr size_t WS_XL8 = 200 * MiB;
constexpr size_t WS_QA = 264 * MiB, WS_KA = 328 * MiB, WS_VA = 392 * MiB;
constexpr size_t WS_HDN = 264 * MiB;
constexpr size_t WS_QM = 456 * MiB;
constexpr size_t WS_KN = 552 * MiB, WS_VM = 616 * MiB;
constexpr size_t WS_H2F8 = 456 * MiB;
constexpr size_t WS_H2L8 = 520 * MiB;
constexpr size_t PB_IN_OUT = 128 * MiB;
constexpr size_t WS_CQ = 712 * MiB;
constexpr size_t WS_CKV = 760 * MiB;
constexpr size_t WS_O2 = 680 * MiB, WS_O3 = 744 * MiB;
constexpr size_t WS_H1B = 680 * MiB;
constexpr size_t WS_E = 808 * MiB;
constexpr size_t WS_DUMMY = 936 * MiB;
constexpr size_t WS_H1F8 = 600 * MiB;
constexpr size_t WS_WOUT8 = 39 * MiB;
constexpr size_t WS_WPG8 = 38 * MiB;
constexpr size_t WS_WIN8 = 1001 * MiB;
constexpr size_t WS_END = 1004 * MiB;
constexpr int CW_BAR = 4096;
constexpr int CW_CNT = 16384;

constexpr int RING_BYTES = 131072;
constexpr int ATT_WSF = 102400;
constexpr int ATT_OST = 106496;
constexpr int MISC_OFF = 139264;
constexpr int TB_OFF = MISC_OFF + 512;
constexpr int MOE_OFF = TB_OFF + 3840;
constexpr int LDS_BYTES = 151552;
constexpr int MOE_E_OFF = MOE_OFF + 128 * 4 * 2 + MAXT * 4;
constexpr int MOE_O_OFF = MOE_E_OFF + 96 * 4 + MAXTE * 4;
static_assert(MOE_O_OFF + 256 * 4 <= LDS_BYTES && TB_OFF + 8192 <= LDS_BYTES, "LDS map");

#define LDS_WAIT() asm volatile("s_waitcnt lgkmcnt(0)" ::: "memory")
#define VM_WAIT() asm volatile("s_waitcnt vmcnt(0)" ::: "memory")
#define RLX_AGENT __ATOMIC_RELAXED, __HIP_MEMORY_SCOPE_AGENT

__device__ __forceinline__ unsigned pk2(float lo, float hi) { f32x2 v = {lo, hi}; bf16x2_t b = __builtin_convertvector(v, bf16x2_t); return __builtin_bit_cast(unsigned, b); }
__device__ __forceinline__ float bflo(unsigned u) { return __uint_as_float(u << 16); }
__device__ __forceinline__ float bfhi(unsigned u) { return __uint_as_float(u & 0xffff0000u); }
__device__ __forceinline__ void st8(bf16_t* p, f32x4 a, f32x4 b) { u32x4 w; w.x = pk2(a[0], a[1]); w.y = pk2(a[2], a[3]); w.z = pk2(b[0], b[1]); w.w = pk2(b[2], b[3]); *(u32x4*)p = w; }
__device__ __forceinline__ void ld8(const bf16_t* p, f32x4& a, f32x4& b) { const u32x4 w = *(const u32x4*)p; a = (f32x4){bflo(w.x), bfhi(w.x), bflo(w.y), bfhi(w.y)}; b = (f32x4){bflo(w.z), bfhi(w.z), bflo(w.w), bfhi(w.w)}; }
__device__ __forceinline__ float dot4(f32x4 a) { return (a[0] * a[0] + a[1] * a[1]) + (a[2] * a[2] + a[3] * a[3]); }
__device__ __forceinline__ float red_fq(float s) { s += __shfl_xor(s, 16); s += __shfl_xor(s, 32); return s; }
__device__ __forceinline__ float rsq(float x) { return __builtin_amdgcn_rsqf(x); }
__device__ __forceinline__ float fexp2(float x) { return __builtin_amdgcn_exp2f(x); }
__device__ __forceinline__ float frcp(float x) { return __builtin_amdgcn_rcpf(x); }

namespace pg8 {
constexpr int BM = 256, BK = 64, HALF = 128, HTB = HALF * BK * 2, STAGE_BYTES = 8 * HTB, NXCD = 8, WGM = 8;
__host__ __device__ __forceinline__ int lds_byte(int r, int c) { const int st = (r >> 4) * 2 + (c >> 5), rr = r & 15, cc = c & 31, ob = rr * 64 + cc * 2; return st * 1024 + (ob ^ (((ob >> 9) & 1) << 5)); }
__host__ __device__ __forceinline__ void stage_rc(int b, int& R, int& C) { const int st = b / 1024, sb = b % 1024, swz = sb ^ (((sb >> 9) & 1) << 5); R = (st >> 1) * 16 + swz / 64; C = (st & 1) * 32 + (swz % 64) / 2; }
__host__ __device__ __forceinline__ int perm32(int rho) { const int n = rho >> 4, i = rho & 15; return 8 * (i >> 2) + 4 * n + (i & 3); }
struct Unit { int pm, pn; };

__device__ __forceinline__ int xcd_remap(int L, int nwg) { const int q = nwg / NXCD, r = nwg % NXCD, xcd = L % NXCD, off = L / NXCD; return (xcd < r ? xcd * (q + 1) : r * (q + 1) + (xcd - r) * q) + off; }
struct DenseSched {
    const char* A; const char* Bt; const float* rs = nullptr; int K, nM, nN, nwg, G, c, wgm;
    __device__ __forceinline__ void init(const bf16_t* A_, const bf16_t* Bt_, int Mr, int N, int K_, int G_, int c_, int wgm_ = WGM) { A = (const char*)A_; Bt = (const char*)Bt_; K = K_; nM = Mr / BM; nN = N / BM; nwg = nM * nN; G = G_; c = c_; wgm = wgm_; }
    __device__ __forceinline__ bool next(int i, Unit& u) const {
        const int L = i * G + c; if (L >= nwg) return false;
        const int wgid = xcd_remap(L, nwg);
        const int nig = wgm * nN, gid = wgid / nig, fm = gid * wgm, gsz = (nM - fm) < wgm ? (nM - fm) : wgm;
        u.pm = fm + ((wgid % nig) % gsz); u.pn = (wgid % nig) / gsz; return true;
    }
    __device__ __forceinline__ const char* a_base(const Unit& u) const { return A + (size_t)u.pm * ((size_t)BM * K * 2); }
    __device__ __forceinline__ const char* b_base(const Unit& u) const { return Bt + (size_t)u.pn * ((size_t)BM * K * 2); }
    __device__ __forceinline__ const char* b_base2(const Unit& u) const { return b_base(u); }
    __device__ __forceinline__ const unsigned* a_rowptr(const Unit&, int) const { return nullptr; }
};
__device__ __forceinline__ unsigned gld_untracked(const unsigned* p) { unsigned r; asm volatile("global_load_dword %0, %1, off" : "=&v"(r) : "v"(p) : "memory"); return r; }

template <class Epi, class Sched, bool GATHER, bool BSPLIT, bool PRESCALE = false, bool FP8 = false, int WS2 = 0, int AS2 = 0>
__device__ __forceinline__ void gemm_phase(LAS unsigned char* lds, const int K_, const Sched& S, const Epi& E) {
    int K = K_; asm volatile("" : "+s"(K));
    int tid_ = threadIdx.x; asm volatile("" : "+v"(tid_));
    const int tid = tid_, wid = __builtin_amdgcn_readfirstlane(tid >> 6), lane = tid & 63, wr = wid >> 2, wc = wid & 3, fr = lane & 15, fq = lane >> 4;
    const int nt = K / BK, nth = BSPLIT ? nt / 2 : nt, ldb = BSPLIT ? K / 2 : K;
    int Rr[2], Cc[2]; unsigned voffB[2];
#pragma unroll
    for (int i = 0; i < 2; ++i) { stage_rc(tid * 16 + i * 8192, Rr[i], Cc[i]); const int Rb = (Rr[i] & ~31) + perm32(Rr[i] & 31); voffB[i] = (unsigned)(Rb * ldb + Cc[i]) * 2u; }
    const size_t kstep = (size_t)(BK * 2);
    const size_t hstepB = (size_t)HALF * ldb * 2;
    const unsigned hstepA = (unsigned)HALF * (unsigned)K * 2u;
    const unsigned ldsw = (unsigned)wid * 1024u;
    const int aoff = lds_byte(wr * 64 + fr, fq * 8), boff = lds_byte(wc * 32 + fr, fq * 8);
#define PG8_SA(b, h) (((b) * 2 + (h)) * HTB)
#define PG8_SB(b, h) ((4 + (b) * 2 + (h)) * HTB)
#define PG8_STAGE(bufoff, gbase, o0, o1) do { \
        __builtin_amdgcn_global_load_lds((const unsigned*)((const char*)(gbase) + (o0)), (LAS unsigned*)(lds + (bufoff) + ldsw), 16, 0, 0); \
        __builtin_amdgcn_global_load_lds((const unsigned*)((const char*)(gbase) + (o1)), (LAS unsigned*)(lds + (bufoff) + ldsw + 8192), 16, 0, 0); } while (0)
#define PG8_STAGE_B(bufoff, gbase) PG8_STAGE(bufoff, gbase, voffB[0], voffB[1])
#define PG8_LDA(dst, b, h) do { _Pragma("unroll") for (int m = 0; m < 4; ++m) _Pragma("unroll") for (int k = 0; k < 2; ++k) dst[m][k] = *(const LAS bf16x8*)(lds + PG8_SA(b, h) + aoff + m * 2048 + k * 1024); } while (0)
#define PG8_LDB(dst, b, h) do { _Pragma("unroll") for (int n = 0; n < 2; ++n) _Pragma("unroll") for (int k = 0; k < 2; ++k) dst[n][k] = *(const LAS bf16x8*)(lds + PG8_SB(b, h) + boff + n * 2048 + k * 1024); } while (0)
#define PG8_CAT(x, y) __builtin_shufflevector(__builtin_bit_cast(i32x4, x), __builtin_bit_cast(i32x4, y), 0, 1, 2, 3, 4, 5, 6, 7)
#define PG8_MMA(ai, bj, At, Bt) do { __builtin_amdgcn_s_setprio(1); _Pragma("unroll") for (int m = 0; m < 4; ++m) _Pragma("unroll") for (int n = 0; n < 2; ++n) { \
        if (FP8) { const i32x8 b8_ = PG8_CAT(Bt[n][0], Bt[n][1]), a8_ = PG8_CAT(At[m][0], At[m][1]); asm volatile("v_mfma_scale_f32_16x16x128_f8f6f4 %0, %1, %2, %0, %3, %4 op_sel_hi:[0,0,0]" : "+v"(acc[ai][bj][m][n]) : "v"(b8_), "v"(a8_), "v"(fp8_sw), "v"(fp8_sa)); } \
        else { _Pragma("unroll") for (int k = 0; k < 2; ++k) acc[ai][bj][m][n] = __builtin_amdgcn_mfma_f32_16x16x32_bf16(Bt[n][k], At[m][k], acc[ai][bj][m][n], 0, 0, 0); } } \
        __builtin_amdgcn_s_setprio(0); } while (0)
#define PG8_WAIT_V(n) asm volatile("s_waitcnt vmcnt(" #n ")" ::: "memory")
#define PG8_WAIT_L(n) asm volatile("s_waitcnt lgkmcnt(" #n ")" ::: "memory")
#define PG8_BAR __builtin_amdgcn_s_barrier()
#define PG8_SCHED __builtin_amdgcn_sched_barrier(0)
    Unit cur, nxt; int ui = 0;
    if (!S.next(0, cur)) return;
    int fp8_sw = (127 - WS2) * 0x01010101, fp8_sa = (127 - AS2) * 0x01010101; asm volatile("" : "+v"(fp8_sw), "+v"(fp8_sa));
    f32x4 acc[2][2][4][2];
#pragma unroll
    for (int a = 0; a < 2; ++a)
#pragma unroll
        for (int b = 0; b < 2; ++b)
#pragma unroll
            for (int m = 0; m < 4; ++m)
#pragma unroll
                for (int n = 0; n < 2; ++n) acc[a][b][m][n] = (f32x4){0.f, 0.f, 0.f, 0.f};
    bf16x8 At[4][2], B0[2][2], B1[2][2];
    unsigned oC[2][2], oN[2][2], rawN[2][2];
    if (GATHER) {
#pragma unroll
        for (int h = 0; h < 2; ++h)
#pragma unroll
            for (int i = 0; i < 2; ++i) rawN[h][i] = gld_untracked(S.a_rowptr(cur, Rr[i] + HALF * h));
        asm volatile("s_waitcnt vmcnt(0)" ::: "memory");
#pragma unroll
        for (int h = 0; h < 2; ++h)
#pragma unroll
            for (int i = 0; i < 2; ++i) { asm volatile("" : "+v"(rawN[h][i])); oC[h][i] = rawN[h][i] + (unsigned)Cc[i] * 2u; oN[h][i] = oC[h][i]; }
    } else {
#pragma unroll
        for (int h = 0; h < 2; ++h)
#pragma unroll
            for (int i = 0; i < 2; ++i) { oC[h][i] = (unsigned)(Rr[i] * K + Cc[i]) * 2u + (unsigned)h * hstepA; oN[h][i] = oC[h][i]; rawN[h][i] = 0u; }
    }
    const char* cA = S.a_base(cur); const char* cB = S.b_base(cur); const char* cB2 = S.b_base2(cur);
    PG8_STAGE_B(PG8_SB(0, 0), cB); PG8_STAGE_B(PG8_SB(0, 1), cB + hstepB); PG8_STAGE(PG8_SA(0, 0), cA, oC[0][0], oC[0][1]); PG8_STAGE(PG8_SA(0, 1), cA, oC[1][0], oC[1][1]);
    if (wr == 1) PG8_BAR;
    PG8_WAIT_V(2); PG8_BAR;
    PG8_STAGE_B(PG8_SB(1, 0), cB + kstep); PG8_STAGE(PG8_SA(1, 0), cA + kstep, oC[0][0], oC[0][1]); PG8_STAGE_B(PG8_SB(1, 1), cB + hstepB + kstep);
    PG8_WAIT_V(6); PG8_BAR;
    for (;;) {
        const bool has_next = S.next(ui + 1, nxt);
        const char* nA = has_next ? S.a_base(nxt) : cA; const char* nB = has_next ? S.b_base(nxt) : cB;
        if (GATHER) {
            if (has_next) {
#pragma unroll
                for (int h = 0; h < 2; ++h)
#pragma unroll
                    for (int i = 0; i < 2; ++i) rawN[h][i] = gld_untracked(S.a_rowptr(nxt, Rr[i] + HALF * h));
            }
        }
        for (int t = 0; t < nt; t += 2) {
            const bool last = (t == nt - 2);
            const char* a1 = cA + (size_t)(t + 1) * kstep;
            const char* a2 = last ? nA : cA + (size_t)(t + 2) * kstep;
            const char* b2 = last ? nB : ((BSPLIT && t + 2 >= nth) ? cB2 + (size_t)(t + 2 - nth) * kstep : cB + (size_t)(t + 2) * kstep);
            const char* a3 = a2 + kstep; const char* b3 = b2 + kstep;
            unsigned o2[2][2];
            if (GATHER && last && has_next) {
#pragma unroll
                for (int h = 0; h < 2; ++h)
#pragma unroll
                    for (int i = 0; i < 2; ++i) { asm volatile("" : "+v"(rawN[h][i])); oN[h][i] = rawN[h][i] + (unsigned)Cc[i] * 2u; }
            }
#pragma unroll
            for (int h = 0; h < 2; ++h)
#pragma unroll
                for (int i = 0; i < 2; ++i) o2[h][i] = (GATHER && last && has_next) ? oN[h][i] : oC[h][i];
            PG8_LDB(B0, 0, 0); PG8_LDB(B1, 0, 1); PG8_SCHED; PG8_LDA(At, 0, 0); PG8_STAGE(PG8_SA(1, 1), a1, oC[1][0], oC[1][1]);
            PG8_WAIT_V(8); PG8_WAIT_L(0); PG8_BAR; PG8_MMA(0, 0, At, B0); PG8_MMA(0, 1, At, B1); PG8_BAR; PG8_SCHED;
            PG8_LDA(At, 0, 1); PG8_STAGE_B(PG8_SB(0, 0), b2); PG8_STAGE_B(PG8_SB(0, 1), b2 + hstepB); PG8_STAGE(PG8_SA(0, 0), a2, o2[0][0], o2[0][1]);
            PG8_WAIT_V(8); PG8_WAIT_L(0); PG8_BAR; PG8_MMA(1, 0, At, B0); PG8_MMA(1, 1, At, B1); PG8_BAR; PG8_SCHED;
            PG8_LDB(B0, 1, 0); PG8_LDB(B1, 1, 1); PG8_SCHED; PG8_LDA(At, 1, 0); PG8_STAGE(PG8_SA(0, 1), a2, o2[1][0], o2[1][1]);
            PG8_WAIT_V(8); PG8_WAIT_L(0); PG8_BAR; PG8_MMA(0, 0, At, B0); PG8_MMA(0, 1, At, B1); PG8_BAR; PG8_SCHED;
            PG8_LDA(At, 1, 1); PG8_STAGE_B(PG8_SB(1, 0), b3); PG8_STAGE_B(PG8_SB(1, 1), b3 + hstepB); PG8_STAGE(PG8_SA(1, 0), a3, o2[0][0], o2[0][1]);
            PG8_WAIT_V(8); PG8_WAIT_L(0); PG8_BAR; PG8_MMA(1, 0, At, B0); PG8_MMA(1, 1, At, B1); PG8_BAR; PG8_SCHED;
        }
        if constexpr (FP8) asm volatile("s_nop 15\n\ts_nop 15" ::: "memory");
        float rsv[2][4];
        if constexpr (PRESCALE) {
#pragma unroll
            for (int a = 0; a < 2; ++a)
#pragma unroll
                for (int m = 0; m < 4; ++m) rsv[a][m] = *(const float*)((const char*)S.rs + (unsigned)(cur.pm * 256 + a * 128 + wr * 64 + m * 16 + fr) * 4u);
        }
        if (wr == 0) PG8_BAR;
        if constexpr (PRESCALE) {
#pragma unroll
            for (int a = 0; a < 2; ++a)
#pragma unroll
                for (int m = 0; m < 4; ++m)
#pragma unroll
                    for (int b = 0; b < 2; ++b)
#pragma unroll
                        for (int n = 0; n < 2; ++n) acc[a][b][m][n] *= rsv[a][m];
        }
        E(acc, cur, wr, wc, fr, fq);
        if (!has_next) break;
#pragma unroll
        for (int a = 0; a < 2; ++a)
#pragma unroll
            for (int b = 0; b < 2; ++b)
#pragma unroll
                for (int m = 0; m < 4; ++m)
#pragma unroll
                    for (int n = 0; n < 2; ++n) acc[a][b][m][n] = (f32x4){0.f, 0.f, 0.f, 0.f};
        cur = nxt; cA = nA; cB = nB; cB2 = S.b_base2(cur); ++ui;
        if (GATHER) {
#pragma unroll
            for (int h = 0; h < 2; ++h)
#pragma unroll
                for (int i = 0; i < 2; ++i) oC[h][i] = oN[h][i];
        }
        if (wr == 1) PG8_BAR;
    }
    PG8_WAIT_V(0);
    PG8_BAR;
#undef PG8_SA
#undef PG8_SB
#undef PG8_STAGE
#undef PG8_STAGE_B
#undef PG8_LDA
#undef PG8_LDB
#undef PG8_MMA
#undef PG8_CAT
#undef PG8_WAIT_V
#undef PG8_WAIT_L
#undef PG8_BAR
#undef PG8_SCHED
}
}

namespace att {
#define SBAR() __builtin_amdgcn_sched_barrier(0)
typedef LAS const char* lds_cptr;
__device__ __forceinline__ int crow(int r, int hi) { return (r & 3) + 8 * (r >> 2) + 4 * hi; }
__device__ __forceinline__ int dslot(int rot, int j) { const int s = rot + j; return s >= 6 ? s - 6 : s; }
__device__ __forceinline__ void glds16(const void* gsrc, unsigned lds_dst) { unsigned keep;
    asm volatile("s_mov_b32 %0, m0\n\ts_mov_b32 m0, %2\n\ts_nop 0\n\tglobal_load_lds_dwordx4 %1, off\n\ts_mov_b32 m0, %0" : "=&s"(keep) : "v"(gsrc), "s"(lds_dst) : "memory"); }
__device__ __forceinline__ float max3f(float a, float b, float c) { return __builtin_fmaxf(__builtin_fmaxf(a, b), c); }
__device__ __forceinline__ float rowmax(const f32x16& p0, const f32x16& p1) {
    float a = max3f(p0[0], p0[1], p1[0]), b = max3f(p0[2], p0[3], p1[1]); a = max3f(a, p1[2], p1[3]);
#pragma unroll
    for (int r = 4; r < 16; r += 4) { a = max3f(a, p0[r], p0[r + 1]); b = max3f(b, p0[r + 2], p0[r + 3]); a = max3f(a, p1[r], p1[r + 1]); b = max3f(b, p1[r + 2], p1[r + 3]); }
    const float m = __builtin_fmaxf(a, b);
    auto rr = __builtin_amdgcn_permlane32_swap(__float_as_uint(m), __float_as_uint(m), false, false);
    return __builtin_fmaxf(__uint_as_float(rr[0]), __uint_as_float(rr[1]));
}
template <int ND, bool NOLDS = false> __device__ __forceinline__ void qkt(f32x16& p0, f32x16& p1, lds_cptr Kslot, const bf16x8* qr, const f32x16& negm, int r32, int hi) {
    lds_cptr kb = Kslot + r32 * 128; const int sw = (r32 & 7) ^ ((r32 >> 3) & 1); lds_cptr kr = Kslot + 8192 + r32 * 64; const int swr = (r32 >> 2) & 3;
    bf16x8 kf[2 * ND];
#pragma unroll
    for (int d0 = 0; d0 < ND; ++d0) {
        if (NOLDS) { kf[2 * d0] = qr[d0]; kf[2 * d0 + 1] = qr[ND - 1 - d0]; }
        else if (d0 < 4) { const int o = ((2 * d0 + hi) ^ sw) * 16; kf[2 * d0] = *(const LAS bf16x8*)(kb + o); kf[2 * d0 + 1] = *(const LAS bf16x8*)(kb + o + 4096); }
        else { const int o = ((2 * (d0 - 4) + hi) ^ swr) * 16; kf[2 * d0] = *(const LAS bf16x8*)(kr + o); kf[2 * d0 + 1] = *(const LAS bf16x8*)(kr + o + 2048); }
    }
    __builtin_amdgcn_sched_barrier(0);
#pragma unroll
    for (int d0 = 0; d0 < ND; ++d0) {
        if (d0 == 0) { p0 = __builtin_amdgcn_mfma_f32_32x32x16_bf16(kf[0], qr[0], negm, 0, 0, 0); p1 = __builtin_amdgcn_mfma_f32_32x32x16_bf16(kf[1], qr[0], negm, 0, 0, 0); }
        else { p0 = __builtin_amdgcn_mfma_f32_32x32x16_bf16(kf[2 * d0], qr[d0], p0, 0, 0, 0); p1 = __builtin_amdgcn_mfma_f32_32x32x16_bf16(kf[2 * d0 + 1], qr[d0], p1, 0, 0, 0); }
    }
    __builtin_amdgcn_sched_barrier(0);
}
template <int ND> __device__ __forceinline__ void qkt_acc(f32x16& p0, f32x16& p1, lds_cptr Kslot, const bf16x8* qr, int r32, int hi) {
    lds_cptr kb = Kslot + r32 * 128; const int sw = (r32 & 7) ^ ((r32 >> 3) & 1);
    bf16x8 kf[2 * ND];
#pragma unroll
    for (int d0 = 0; d0 < ND; ++d0) { const int o = ((2 * d0 + hi) ^ sw) * 16; kf[2 * d0] = *(const LAS bf16x8*)(kb + o); kf[2 * d0 + 1] = *(const LAS bf16x8*)(kb + o + 4096); }
    __builtin_amdgcn_sched_barrier(0);
#pragma unroll
    for (int d0 = 0; d0 < ND; ++d0) { p0 = __builtin_amdgcn_mfma_f32_32x32x16_bf16(kf[2 * d0], qr[d0], p0, 0, 0, 0); p1 = __builtin_amdgcn_mfma_f32_32x32x16_bf16(kf[2 * d0 + 1], qr[d0], p1, 0, 0, 0); }
    __builtin_amdgcn_sched_barrier(0);
}
template <int ND, int HALF> __device__ __forceinline__ void qkt_half_acc(f32x16& p, lds_cptr Kslot, const bf16x8* qr, int r32, int hi) {
    lds_cptr kb = Kslot + r32 * 128 + HALF * 4096; const int sw = (r32 & 7) ^ ((r32 >> 3) & 1);
    bf16x8 kf[ND];
#pragma unroll
    for (int d0 = 0; d0 < ND; ++d0) kf[d0] = *(const LAS bf16x8*)(kb + ((2 * d0 + hi) ^ sw) * 16);
    __builtin_amdgcn_sched_barrier(0);
#pragma unroll
    for (int d0 = 0; d0 < ND; ++d0) p = __builtin_amdgcn_mfma_f32_32x32x16_bf16(kf[d0], qr[d0], p, 0, 0, 0);
    __builtin_amdgcn_sched_barrier(0);
}
template <int HALF> __device__ __forceinline__ void pv_half(f32x16* o, int vb, bf16x8 pa0, bf16x8 pa1) {
#pragma unroll
    for (int d0 = 0; d0 < 2; ++d0) { s16x4 lo[2], hi[2];
#pragma unroll
        for (int ks = 0; ks < 2; ++ks) {
            asm volatile("ds_read_b64_tr_b16 %0,%1 offset:%c2" : "=&v"(lo[ks]) : "v"(vb), "i"(d0 * 512 + (2 * HALF + ks) * 2048) : "memory");
            asm volatile("ds_read_b64_tr_b16 %0,%1 offset:%c2" : "=&v"(hi[ks]) : "v"(vb), "i"(d0 * 512 + (2 * HALF + ks) * 2048 + 1024) : "memory"); }
        asm volatile("s_waitcnt lgkmcnt(0)" ::: "memory"); SBAR();
#define PK(k) (bf16x8){lo[k][0], lo[k][1], lo[k][2], lo[k][3], hi[k][0], hi[k][1], hi[k][2], hi[k][3]}
        o[d0] = __builtin_amdgcn_mfma_f32_32x32x16_bf16(pa0, PK(0), o[d0], 0, 0, 0);
        o[d0] = __builtin_amdgcn_mfma_f32_32x32x16_bf16(pa1, PK(1), o[d0], 0, 0, 0);
#undef PK
    }
}
__device__ __forceinline__ void pv(f32x16* o, int vb, bf16x8 pa0, bf16x8 pa1, bf16x8 pa2, bf16x8 pa3) {
#pragma unroll
    for (int d0 = 0; d0 < 2; ++d0) { s16x4 lo[4], hi[4];
#pragma unroll
        for (int ks = 0; ks < 4; ++ks) {
            asm volatile("ds_read_b64_tr_b16 %0,%1 offset:%c2" : "=&v"(lo[ks]) : "v"(vb), "i"(d0 * 512 + ks * 2048) : "memory");
            asm volatile("ds_read_b64_tr_b16 %0,%1 offset:%c2" : "=&v"(hi[ks]) : "v"(vb), "i"(d0 * 512 + ks * 2048 + 1024) : "memory"); }
        asm volatile("s_waitcnt lgkmcnt(0)" ::: "memory"); SBAR();
#define PK(k) (bf16x8){lo[k][0], lo[k][1], lo[k][2], lo[k][3], hi[k][0], hi[k][1], hi[k][2], hi[k][3]}
        o[d0] = __builtin_amdgcn_mfma_f32_32x32x16_bf16(pa0, PK(0), o[d0], 0, 0, 0);
        o[d0] = __builtin_amdgcn_mfma_f32_32x32x16_bf16(pa1, PK(1), o[d0], 0, 0, 0);
        o[d0] = __builtin_amdgcn_mfma_f32_32x32x16_bf16(pa2, PK(2), o[d0], 0, 0, 0);
        o[d0] = __builtin_amdgcn_mfma_f32_32x32x16_bf16(pa3, PK(3), o[d0], 0, 0, 0);
#undef PK
    }
}
constexpr float THR = 8.0f;
struct SoftState { float mhat, l; f32x16 negm; f32x16 o[2]; };
struct SoftStateD { float mhat, l; f32x16 o[2]; };
__device__ __forceinline__ void softmax_pv(SoftState& st, f32x16& p0, f32x16& p1, LAS float* wsf, int vb, int r32, int hi) {
    const float rm = rowmax(p0, p1);
    if (__any(rm > THR)) {
        const float dl = __builtin_fmaxf(rm, 0.f);
        st.mhat += dl;
#pragma unroll
        for (int r = 0; r < 16; ++r) { p0[r] -= dl; p1[r] -= dl; }
#pragma unroll
        for (int r = 0; r < 16; ++r) st.negm[r] = -st.mhat;
        const float f = fexp2(-dl); st.l *= f;
        if (hi == 0) wsf[r32] = f;
        LDS_WAIT();
#pragma unroll
        for (int r = 0; r < 16; ++r) { const float fr_ = wsf[crow(r, hi)]; st.o[0][r] *= fr_; st.o[1][r] *= fr_; }
        LDS_WAIT();
    }
    float sacc = 0.f;
#pragma unroll
    for (int r = 0; r < 16; ++r) { p0[r] = fexp2(p0[r]); p1[r] = fexp2(p1[r]); sacc += p0[r] + p1[r]; }
    st.l += sacc;
    u32x4 w0, w1, w2, w3;
    w0 = (u32x4){pk2(p0[0], p0[1]), pk2(p0[2], p0[3]), pk2(p0[4], p0[5]), pk2(p0[6], p0[7])};
    w1 = (u32x4){pk2(p0[8], p0[9]), pk2(p0[10], p0[11]), pk2(p0[12], p0[13]), pk2(p0[14], p0[15])};
    w2 = (u32x4){pk2(p1[0], p1[1]), pk2(p1[2], p1[3]), pk2(p1[4], p1[5]), pk2(p1[6], p1[7])};
    w3 = (u32x4){pk2(p1[8], p1[9]), pk2(p1[10], p1[11]), pk2(p1[12], p1[13]), pk2(p1[14], p1[15])};
    pv(st.o, vb, __builtin_bit_cast(bf16x8, w0), __builtin_bit_cast(bf16x8, w1), __builtin_bit_cast(bf16x8, w2), __builtin_bit_cast(bf16x8, w3));
}
template <class ST, bool NOEXP = false> __device__ __forceinline__ void exp_pv(ST& st, f32x16& p0, f32x16& p1, int vb) {
    float sacc = 0.f;
#pragma unroll
    for (int r = 0; r < 16; ++r) { if (!NOEXP) { p0[r] = fexp2(p0[r]); p1[r] = fexp2(p1[r]); } sacc += p0[r] + p1[r]; }
    st.l += sacc;
    u32x4 w0, w1, w2, w3;
    w0 = (u32x4){pk2(p0[0], p0[1]), pk2(p0[2], p0[3]), pk2(p0[4], p0[5]), pk2(p0[6], p0[7])};
    w1 = (u32x4){pk2(p0[8], p0[9]), pk2(p0[10], p0[11]), pk2(p0[12], p0[13]), pk2(p0[14], p0[15])};
    w2 = (u32x4){pk2(p1[0], p1[1]), pk2(p1[2], p1[3]), pk2(p1[4], p1[5]), pk2(p1[6], p1[7])};
    w3 = (u32x4){pk2(p1[8], p1[9]), pk2(p1[10], p1[11]), pk2(p1[12], p1[13]), pk2(p1[14], p1[15])};
    pv(st.o, vb, __builtin_bit_cast(bf16x8, w0), __builtin_bit_cast(bf16x8, w1), __builtin_bit_cast(bf16x8, w2), __builtin_bit_cast(bf16x8, w3));
}
template <class ST> __device__ __forceinline__ void finish_rows(ST& st, LAS float* wsf, LAS bf16_t* stg, int r32, int hi) {
    float l = st.l;
    { auto rr = __builtin_amdgcn_permlane32_swap(__float_as_uint(l), __float_as_uint(l), false, false); l = __uint_as_float(rr[0]) + __uint_as_float(rr[1]); }
    if (hi == 0) { wsf[32 + r32] = l; wsf[64 + r32] = st.mhat + __builtin_amdgcn_logf(l); }
    LDS_WAIT();
#pragma unroll
    for (int r = 0; r < 16; ++r) { const int orow = crow(r, hi); const float rl = frcp(wsf[32 + orow]);
#pragma unroll
        for (int d0 = 0; d0 < 2; ++d0) stg[orow * 64 + d0 * 32 + r32] = (bf16_t)(pk2(st.o[d0][r] * rl, 0.f) & 0xffffu); }
    LDS_WAIT();
}

constexpr int MK_SLOT = 12288, MV_SLOT = 8192, M_NSLOT = 5, M_LK = 0, M_LV = M_NSLOT * MK_SLOT;
template <int MODE  > __device__ __forceinline__ void mla_unit(int b, int h, int qb, const bf16_t* QM, const bf16_t* KN, const bf16_t* KR, const bf16_t* VM, bf16_t* MIX, LAS char* shm) {
    int tid_ = threadIdx.x; asm volatile("" : "+v"(tid_)); const int tid = tid_, lane = tid & 63, r32 = lane & 31, hi = lane >> 5; const int wid = __builtin_amdgcn_readfirstlane(tid >> 6);
    const long rowbase = (long)b * SEQ; const int q0 = qb * 256;
    const unsigned lds0 = (unsigned)(uintptr_t)shm;
    LAS float* wsf = (LAS float*)(shm + ATT_WSF) + wid * 128;
    LAS bf16_t* stg = (LAS bf16_t*)(shm + ATT_OST) + wid * 2048;
    const long hb = ((long)b * 8 + h) * SEQ;
    const bf16_t* ksrc0 = KN + (hb + 8 * wid + (lane >> 3)) * 64 + (((lane & 7) ^ (lane >> 3) ^ (wid & 1)) * 8);
    const bf16_t* ksrc1 = KR + (rowbase + 16 * (wid & 3) + (lane >> 2)) * 32 + (((lane & 3) ^ ((lane >> 4) & 3)) * 8);
    const bf16_t* vsrc = VM + (hb + 8 * wid + ((lane >> 2) & 7)) * 64 + (lane >> 5) * 32 + (lane & 3) * 8;
    const unsigned kdst0 = lds0 + M_LK + wid * 1024, kdst1 = lds0 + M_LK + (8 + (wid & 3)) * 1024, vdst = lds0 + M_LV + wid * 1024;
#define MLA_DMA(t, s) do { glds16(ksrc0 + (long)(t) * 64 * 64, (unsigned)__builtin_amdgcn_readfirstlane(kdst0 + (s) * MK_SLOT)); \
        glds16(ksrc1 + (long)(t) * 64 * 32, (unsigned)__builtin_amdgcn_readfirstlane(kdst1 + (s) * MK_SLOT)); \
        glds16(vsrc + (long)(t) * 64 * 64, (unsigned)__builtin_amdgcn_readfirstlane(vdst + (s) * MV_SLOT)); } while (0)
    const int NT = (q0 + 256) / 64;
    if (MODE != 2) { MLA_DMA(0, 0); MLA_DMA(1, 1); MLA_DMA(2, 2); }
    const bf16_t* Qw = QM + (hb + q0 + wid * 32 + r32) * 96 + hi * 8;
    bf16x8 qr[6];
#pragma unroll
    for (int d0 = 0; d0 < 6; ++d0) qr[d0] = *(const bf16x8*)(Qw + d0 * 16);
#pragma unroll
    for (int d0 = 0; d0 < 6; ++d0) asm volatile("" : "+v"(qr[d0]));
    SoftStateD st; st.mhat = 0.f; st.l = 0.f; st.o[0] = f32x16{}; st.o[1] = f32x16{}; const f32x16 zc = f32x16{};
    const int qw0 = q0 + wid * 32, qrel = qw0 + r32;
    const int vb0 = (int)(lds0 + M_LV) + ((lane >> 4) & 1) * 32 + (lane & 3) * 8 + (4 * hi + ((lane & 15) >> 2)) * 64;
    f32x16 p0, p1;
#define MLA_QK(t) do { qkt<6, MODE == 7>(p0, p1, (lds_cptr)(shm + M_LK + sl * MK_SLOT), qr, zc, r32, hi); \
        if (64 * (t) + 63 > qw0) { const int kb = 64 * (t) + 4 * hi; \
            _Pragma("unroll") for (int r = 0; r < 16; ++r) { const int kv = kb + (r & 3) + 8 * (r >> 2); if (kv > qrel) p0[r] = -INFINITY; if (kv + 32 > qrel) p1[r] = -INFINITY; } } } while (0)
    int sl = 0, slp = 4, sln = 3;
    for (int t = 0; t < NT; ++t) {
        if (MODE == 2) asm volatile("s_waitcnt lgkmcnt(0)\n\ts_barrier" ::: "memory");
        else if (MODE == 5) asm volatile("s_waitcnt vmcnt(0) lgkmcnt(0)" ::: "memory");
        else if (t + 2 < NT) asm volatile("s_waitcnt vmcnt(6) lgkmcnt(0)\n\ts_barrier" ::: "memory");
        else if (t + 1 < NT) asm volatile("s_waitcnt vmcnt(3) lgkmcnt(0)\n\ts_barrier" ::: "memory");
        else asm volatile("s_waitcnt vmcnt(0) lgkmcnt(0)\n\ts_barrier" ::: "memory");
        if (MODE != 2 && t + 3 < NT) MLA_DMA(t + 3, sln);
        const bool valid = (MODE != 1) && (64 * t <= qw0 + 31);
        if (valid) { MLA_QK(t); if (MODE == 6) exp_pv<SoftStateD, true>(st, p0, p1, vb0 + sl * MV_SLOT); else if (MODE != 3) exp_pv(st, p0, p1, vb0 + sl * MV_SLOT); else { st.o[0] += p0; st.o[1] += p1; } }
        slp = sl; sl = (sl == 4) ? 0 : sl + 1; sln = (sln == 4) ? 0 : sln + 1;
    }
    finish_rows(st, wsf, stg, r32, hi);
    unsigned char* Ow = (unsigned char*)MIX + (rowbase + q0 + wid * 32) * 1024 + 512 + h * 64;
#pragma unroll
    for (int i = 0; i < 4; ++i) { const int row = i * 8 + (lane >> 3), ch = lane & 7; const u32x4 v = *(const LAS u32x4*)(stg + row * 64 + ch * 8); u32x2 q8;
        q8.x = (unsigned)__builtin_amdgcn_cvt_pk_fp8_f32(bflo(v.y) * FP8_MIX_MUL, bfhi(v.y) * FP8_MIX_MUL, __builtin_amdgcn_cvt_pk_fp8_f32(bflo(v.x) * FP8_MIX_MUL, bfhi(v.x) * FP8_MIX_MUL, 0, false), true);
        q8.y = (unsigned)__builtin_amdgcn_cvt_pk_fp8_f32(bflo(v.w) * FP8_MIX_MUL, bfhi(v.w) * FP8_MIX_MUL, __builtin_amdgcn_cvt_pk_fp8_f32(bflo(v.z) * FP8_MIX_MUL, bfhi(v.z) * FP8_MIX_MUL, 0, false), true);
        *(u32x2*)(Ow + (long)row * 1024 + ch * 8) = q8; }
    asm volatile("s_waitcnt lgkmcnt(0)\n\ts_barrier" ::: "memory");
#undef MLA_DMA
#undef MLA_QK
}

constexpr int D_LK = 0, D_LV = 49152;
struct DilGeom { int br, uu, d, res0, tb, nslot, rot; };
__device__ __forceinline__ DilGeom dil_geom(int uidx) {
    DilGeom g; g.br = 2 - (uidx >> 3); g.uu = uidx & 7; g.d = 1 << (2 * g.br);
    if (g.br == 2) { g.res0 = 2 * g.uu; g.tb = 0; g.nslot = 4; }
    else { g.res0 = (g.br == 0) ? 0 : (g.uu >> 1); const int Q0 = (g.br == 0) ? 256 * g.uu : 256 * (g.uu & 1); g.tb = Q0 / 64 - 2; g.nslot = 6; }
    g.rot = (g.br == 2) ? 0 : (4 * ((g.br == 0) ? g.uu : (g.uu & 1))) % 6;
    return g;
}
template <bool ISV, int MODE = 0> __device__ __forceinline__ void dil_issue_tiles(const DilGeom& g, long hb, const bf16_t* KA, const bf16_t* VA, unsigned lds0, int lane, int wid) {
    if (MODE == 4) return;
    for (int j = (g.br == 2) ? 0 : 2; j < g.nslot; ++j) {
        const int tile = (g.br == 2) ? (j & 1) : g.tb + j; const int res = (g.br == 2) ? g.res0 + (j >> 1) : g.res0; const int sj = dslot(g.rot, j);
        if (!ISV) { const long krow = res + (long)g.d * (64 * tile + 8 * wid + (lane >> 3));
            glds16(KA + (hb + krow) * 64 + (((lane & 7) ^ (lane >> 3) ^ (wid & 1)) * 8), (unsigned)__builtin_amdgcn_readfirstlane(lds0 + D_LK + sj * 8192 + wid * 1024)); }
        else { const long vrow = res + (long)g.d * (64 * tile + 8 * wid + ((lane >> 2) & 7));
            glds16(VA + (hb + vrow) * 64 + (lane >> 5) * 32 + (lane & 3) * 8, (unsigned)__builtin_amdgcn_readfirstlane(lds0 + D_LV + sj * 8192 + wid * 1024)); }
    }
}
template <int MODE  > __device__ __forceinline__ void dil_phase2(int b, int h, const bf16_t* QA, const bf16_t* KA, const bf16_t* VA, bf16_t* O2, bf16_t* O3, float* LSE2, float* LSE3, bf16_t* MIX, LAS char* shm, const LAS float* tbl) {
    int tid_ = threadIdx.x; asm volatile("" : "+v"(tid_)); const int tid = tid_, lane = tid & 63, r32 = lane & 31, hi = lane >> 5; const int wid = __builtin_amdgcn_readfirstlane(tid >> 6);
    const long rowbase = (long)b * SEQ; const long hb = ((long)b * 8 + h) * SEQ;
    const unsigned lds0 = (unsigned)(uintptr_t)shm;
    LAS float* wsf = (LAS float*)(shm + ATT_WSF) + wid * 128;
    LAS bf16_t* stg = (LAS bf16_t*)(shm + ATT_OST) + wid * 2048;
    const int vb0 = (int)(lds0 + D_LV) + ((lane >> 4) & 1) * 32 + (lane & 3) * 8 + (4 * hi + ((lane & 15) >> 2)) * 64;
    dil_issue_tiles<false, MODE>(dil_geom(0), hb, KA, VA, lds0, lane, wid);
    bf16x8 qn[4];
    { const DilGeom g0 = dil_geom(0); const int wres0 = g0.res0 + (wid >> 2), qs0 = 32 * (wid & 3);
      const bf16_t* Qw0 = QA + (hb + wres0 + (long)g0.d * (qs0 + r32)) * 64 + hi * 8;
#pragma unroll
      for (int d0 = 0; d0 < 4; ++d0) qn[d0] = *(const bf16x8*)(Qw0 + d0 * 16); }
    for (int uidx = 0; uidx < 24; ++uidx) {
        const DilGeom g = dil_geom(uidx); const int br = g.br, d = g.d;
        if (uidx == 16) { VM_WAIT(); __syncthreads(); __builtin_amdgcn_fence(__ATOMIC_ACQUIRE, "agent"); VM_WAIT(); }
        int wres, qs, j0, nj;
        if (br == 2) { wres = g.res0 + (wid >> 2); qs = 32 * (wid & 3); j0 = 2 * (wid >> 2); nj = (wid & 3) < 2 ? 1 : 2; }
        else { wres = g.res0; qs = (g.tb + 2) * 64 + 32 * wid; j0 = wid >> 1; nj = 3; }
        if (uidx == 0 || uidx == 16) asm volatile("s_waitcnt vmcnt(0) lgkmcnt(0)\n\ts_barrier" ::: "memory");
        else asm volatile("s_waitcnt vmcnt(8) lgkmcnt(0)\n\ts_barrier" ::: "memory");
        bf16x8 qr[4];
#pragma unroll
        for (int d0 = 0; d0 < 4; ++d0) { qr[d0] = qn[d0]; asm volatile("" : "+v"(qr[d0])); }
        dil_issue_tiles<true, MODE>(g, hb, KA, VA, lds0, lane, wid);
        u32x2 o2v[4], o3v[4]; float l2v[4], l3v[4];
        if (br == 0) {
#pragma unroll
            for (int i = 0; i < 4; ++i) { const int row = i * 8 + (lane >> 3), ch = lane & 7; const long hr = hb + qs + row;
                o2v[i] = *(const u32x2*)((const char*)O2 + hr * 64 + ch * 8); o3v[i] = *(const u32x2*)((const char*)O3 + hr * 64 + ch * 8); l2v[i] = LSE2[hr]; l3v[i] = LSE3[hr]; }
            asm volatile("" ::: "memory");
        }
        const LAS float* tbr = tbl + br * 320;
        SoftStateD st; st.mhat = 0.f; st.l = 0.f; st.o[0] = f32x16{}; st.o[1] = f32x16{};
        u32x4 pw[3][4]; int hmask = 0;
#pragma unroll
        for (int jj = 0; jj < 3; ++jj) {
            const int j = j0 + jj; const int tile = (br == 2) ? jj : g.tb + j; const int sj = dslot(g.rot, j);
            const bool live = (MODE != 1) && jj < nj && tile >= 0;
            const bool h0 = live && !(64 * tile > qs + 31) && !(64 * tile + 31 < qs - 128);
            const bool h1 = live && !(64 * tile + 32 > qs + 31) && !(64 * tile + 63 < qs - 128);
            const LAS float* tp = tbr + (qs + r32 - 64 * tile + 33 - 4 * hi);
            if (h0) { f32x16 s0;
#pragma unroll
                for (int r = 0; r < 16; ++r) { const int c0 = (r & 3) + 8 * (r >> 2); s0[r] = tp[63 - c0]; }
                qkt_half_acc<4, 0>(s0, (lds_cptr)(shm + D_LK + sj * 8192), qr, r32, hi);
                float sacc = 0.f;
#pragma unroll
                for (int r = 0; r < 16; ++r) { s0[r] = fexp2(s0[r]); sacc += s0[r]; }
                st.l += sacc;
                pw[jj][0] = (u32x4){pk2(s0[0], s0[1]), pk2(s0[2], s0[3]), pk2(s0[4], s0[5]), pk2(s0[6], s0[7])};
                pw[jj][1] = (u32x4){pk2(s0[8], s0[9]), pk2(s0[10], s0[11]), pk2(s0[12], s0[13]), pk2(s0[14], s0[15])}; }
            if (h1) { f32x16 s1;
#pragma unroll
                for (int r = 0; r < 16; ++r) { const int c0 = (r & 3) + 8 * (r >> 2); s1[r] = tp[31 - c0]; }
                qkt_half_acc<4, 1>(s1, (lds_cptr)(shm + D_LK + sj * 8192), qr, r32, hi);
                float sacc = 0.f;
#pragma unroll
                for (int r = 0; r < 16; ++r) { s1[r] = fexp2(s1[r]); sacc += s1[r]; }
                st.l += sacc;
                pw[jj][2] = (u32x4){pk2(s1[0], s1[1]), pk2(s1[2], s1[3]), pk2(s1[4], s1[5]), pk2(s1[6], s1[7])};
                pw[jj][3] = (u32x4){pk2(s1[8], s1[9]), pk2(s1[10], s1[11]), pk2(s1[12], s1[13]), pk2(s1[14], s1[15])}; }
            hmask |= (h0 ? 1 : 0) << (2 * jj) | (h1 ? 2 : 0) << (2 * jj);
        }
        asm volatile("s_waitcnt vmcnt(0) lgkmcnt(0)\n\ts_barrier" ::: "memory");
        if (uidx + 1 < 24) { const DilGeom gn = dil_geom(uidx + 1);
            dil_issue_tiles<false, MODE>(gn, hb, KA, VA, lds0, lane, wid);
            int wresn, qsn;
            if (gn.br == 2) { wresn = gn.res0 + (wid >> 2); qsn = 32 * (wid & 3); } else { wresn = gn.res0; qsn = (gn.tb + 2) * 64 + 32 * wid; }
            const bf16_t* Qwn = QA + (hb + wresn + (long)gn.d * (qsn + r32)) * 64 + hi * 8;
#pragma unroll
            for (int d0 = 0; d0 < 4; ++d0) qn[d0] = *(const bf16x8*)(Qwn + d0 * 16);
            asm volatile("" ::: "memory"); }
#pragma unroll
        for (int jj = 0; jj < 3; ++jj) {
            const int sj = dslot(g.rot, j0 + jj);
            if ((hmask >> (2 * jj)) & 1) pv_half<0>(st.o, vb0 + sj * 8192, __builtin_bit_cast(bf16x8, pw[jj][0]), __builtin_bit_cast(bf16x8, pw[jj][1]));
            if ((hmask >> (2 * jj)) & 2) pv_half<1>(st.o, vb0 + sj * 8192, __builtin_bit_cast(bf16x8, pw[jj][2]), __builtin_bit_cast(bf16x8, pw[jj][3]));
        }
        if (MODE != 3) finish_rows(st, wsf, stg, r32, hi);
        const long trow0 = rowbase + wres + (long)d * qs;
        if (MODE == 2 || MODE == 3) { } else
        if (br != 0) {
            bf16_t* Ob = (br == 1) ? O2 : O3; float* Lb = (br == 1) ? LSE2 : LSE3;
#pragma unroll
            for (int i = 0; i < 4; ++i) { const int row = i * 8 + (lane >> 3), ch = lane & 7; const long tr = trow0 + (long)d * row;
                const u32x4 v = *(const LAS u32x4*)(stg + row * 64 + ch * 8); u32x2 q8;
                q8.x = (unsigned)__builtin_amdgcn_cvt_pk_fp8_f32(bflo(v.y), bfhi(v.y), __builtin_amdgcn_cvt_pk_fp8_f32(bflo(v.x), bfhi(v.x), 0, false), true);
                q8.y = (unsigned)__builtin_amdgcn_cvt_pk_fp8_f32(bflo(v.w), bfhi(v.w), __builtin_amdgcn_cvt_pk_fp8_f32(bflo(v.z), bfhi(v.z), 0, false), true);
                *(u32x2*)((char*)Ob + (hb + tr - rowbase) * 64 + ch * 8) = q8;
                if (ch == 0) Lb[7 * rowbase + (long)h * SEQ + tr] = wsf[64 + row]; }
        } else {
#pragma unroll
            for (int i = 0; i < 4; ++i) { const int row = i * 8 + (lane >> 3), ch = lane & 7; const long tr = trow0 + row;
                f32x4 a1, b1, a2, b2, a3, b3;
                { const u32x4 w = *(const LAS u32x4*)(stg + row * 64 + ch * 8); a1 = (f32x4){bflo(w.x), bfhi(w.x), bflo(w.y), bfhi(w.y)}; b1 = (f32x4){bflo(w.z), bfhi(w.z), bflo(w.w), bfhi(w.w)}; }
                { const u32x2 w = o2v[i]; const f32x2 c0 = __builtin_amdgcn_cvt_pk_f32_fp8((int)w.x, false), c1 = __builtin_amdgcn_cvt_pk_f32_fp8((int)w.x, true), c2 = __builtin_amdgcn_cvt_pk_f32_fp8((int)w.y, false), c3 = __builtin_amdgcn_cvt_pk_f32_fp8((int)w.y, true); a2 = (f32x4){c0[0], c0[1], c1[0], c1[1]}; b2 = (f32x4){c2[0], c2[1], c3[0], c3[1]}; }
                { const u32x2 w = o3v[i]; const f32x2 c0 = __builtin_amdgcn_cvt_pk_f32_fp8((int)w.x, false), c1 = __builtin_amdgcn_cvt_pk_f32_fp8((int)w.x, true), c2 = __builtin_amdgcn_cvt_pk_f32_fp8((int)w.y, false), c3 = __builtin_amdgcn_cvt_pk_f32_fp8((int)w.y, true); a3 = (f32x4){c0[0], c0[1], c1[0], c1[1]}; b3 = (f32x4){c2[0], c2[1], c3[0], c3[1]}; }
                const float l1 = wsf[64 + row], l2 = l2v[i], l3 = l3v[i];
                const float mm = max3f(l1, l2, l3); const float e1 = fexp2(l1 - mm), e2 = fexp2(l2 - mm), e3 = fexp2(l3 - mm); const float inv = frcp(e1 + e2 + e3);
                const float w1 = e1 * inv, w2 = e2 * inv, w3 = e3 * inv;
                { const f32x4 ra = (a1 * w1 + a2 * w2 + a3 * w3) * FP8_MIX_MUL, rb = (b1 * w1 + b2 * w2 + b3 * w3) * FP8_MIX_MUL; u32x2 q8;
                  q8.x = (unsigned)__builtin_amdgcn_cvt_pk_fp8_f32(ra[2], ra[3], __builtin_amdgcn_cvt_pk_fp8_f32(ra[0], ra[1], 0, false), true);
                  q8.y = (unsigned)__builtin_amdgcn_cvt_pk_fp8_f32(rb[2], rb[3], __builtin_amdgcn_cvt_pk_fp8_f32(rb[0], rb[1], 0, false), true);
                  *(u32x2*)((unsigned char*)MIX + tr * 1024 + h * 64 + ch * 8) = q8; } }
        }
        LDS_WAIT();
    }
    VM_WAIT(); __syncthreads();
}
#undef SBAR
}

#define XB_TMO      128
#define XB_XCNT(j)  (256  + 64 * (j))
#define XB_XSUB(j)  (1280 + 64 * (j))
#define XB_XGEN(j)  (2304 + 64 * (j))
#define XB_TOP      3328
#define XB_TOPGEN   3392
#define XCD_BAR_WORDS 3456
#define XB_SPIN_CAP (1u << 18)

__device__ __forceinline__ unsigned xb_ld(unsigned* p)              { return __hip_atomic_load(p, __ATOMIC_RELAXED, __HIP_MEMORY_SCOPE_AGENT); }
__device__ __forceinline__ unsigned xb_add(unsigned* p, unsigned v) { return __hip_atomic_fetch_add(p, v, __ATOMIC_RELAXED, __HIP_MEMORY_SCOPE_AGENT); }
__device__ __forceinline__ unsigned xb_xcc_id() { return (unsigned)__builtin_amdgcn_s_getreg((3 << 11) | 20) & 0xFu; }
#define XB_SPIN(cond, bar) do { unsigned _sp = 0; while (cond) { __builtin_amdgcn_s_sleep(1); \
    if ((++_sp & 255u) == 0u) { if (xb_ld(&(bar)[XB_TMO])) break; if (_sp > XB_SPIN_CAP) { atomicAdd(&(bar)[XB_TMO], 1u); break; } } } } while (0)

struct XcdBarrier {
    unsigned* bar; unsigned x;
    volatile LAS unsigned* st;
};

__device__ __forceinline__ XcdBarrier xcd_barrier_post(unsigned* bar, volatile LAS unsigned* st) {
    XcdBarrier b; b.bar = bar; b.x = xb_xcc_id(); b.st = st;
    if (threadIdx.x == 0) (void)xb_add(&bar[XB_XCNT(b.x)], 1u);
    return b;
}
__device__ __forceinline__ void xcd_barrier_complete(unsigned* bar, unsigned x, unsigned& nloc, unsigned& nx) {
    const unsigned G = gridDim.x * gridDim.y * gridDim.z;
    unsigned sum, cnt, mine, sp = 0u;
    for (;;) {
        sum = 0u; cnt = 0u; mine = 0u;
#pragma unroll
        for (unsigned j = 0; j < 16; ++j) { const unsigned c = xb_ld(&bar[XB_XCNT(j)]); sum += c; cnt += (c > 0u) ? 1u : 0u; mine = (j == x) ? c : mine; }
        if (sum == G) break;
        __builtin_amdgcn_s_sleep(1);
        if ((++sp & 255u) == 0u) { if (xb_ld(&bar[XB_TMO])) break; if (sp > XB_SPIN_CAP) { atomicAdd(&bar[XB_TMO], 1u); break; } }
    }
    nloc = mine > 0u ? mine : 1u; nx = cnt > 0u ? cnt : 1u;
}

__device__ __forceinline__ void xcd_barrier(const XcdBarrier& b) {
    asm volatile("s_waitcnt vmcnt(0)" ::: "memory");
    __syncthreads();
    if (threadIdx.x == 0) {
        unsigned* bar = b.bar;
        __builtin_amdgcn_s_waitcnt(0);
        unsigned nloc = b.st[0], nx = b.st[1];
        if (nloc == 0u) { xcd_barrier_complete(bar, b.x, nloc, nx); b.st[0] = nloc; b.st[1] = nx; }
        const unsigned old = xb_add(&bar[XB_XSUB(b.x)], 1u);
        const unsigned gen = old / nloc;
        if (old + 1u == (gen + 1u) * nloc) {
            __builtin_amdgcn_fence(__ATOMIC_RELEASE, "agent");
            asm volatile("s_waitcnt vmcnt(0)" ::: "memory");
            const unsigned og = xb_add(&bar[XB_TOP], 1u);
            const unsigned tg = og / nx;
            if (og + 1u == (tg + 1u) * nx) xb_add(&bar[XB_TOPGEN], 1u);
            else XB_SPIN(xb_ld(&bar[XB_TOPGEN]) == tg, bar);
            __builtin_amdgcn_fence(__ATOMIC_ACQUIRE, "agent");
            xb_add(&bar[XB_XGEN(b.x)], 1u);
            asm volatile("s_waitcnt vmcnt(0)" ::: "memory");
        } else {
            XB_SPIN(xb_ld(&bar[XB_XGEN(b.x)]) == gen, bar);
            __builtin_amdgcn_fence(__ATOMIC_ACQUIRE, "agent");
            asm volatile("s_waitcnt vmcnt(0)" ::: "memory");
        }
    }
    __syncthreads();
}

struct Frame {
    LAS unsigned char* lds; volatile LAS unsigned* MISC; unsigned* ctl; unsigned char* ws;
    int tid, lane, wave, vcu, G;
};
struct Args {
    const float* in[28]; float* out; unsigned char* ws;
};
enum { I_X = 0, I_P, I_RELB, I_NMG, I_WIN, I_QNA, I_KNA, I_QAG, I_WQUP, I_KVAG, I_WKVUP, I_QNN, I_QNR, I_KNN, I_KNR, I_WOUT, I_NFG, I_WRG, I_BRG, I_WRE, I_BRE, I_WEG, I_WEU, I_WED, I_WPP, I_PNG, I_WPG, I_BPG };

__device__ __forceinline__ float wave_sum(float v) {
#pragma unroll
    for (int o = 1; o < 64; o <<= 1) v += __shfl_xor(v, o);
    return v;
}

template <class RowMap>
__device__ __forceinline__ void tr_item(const float* __restrict__ W, int N, const float* __restrict__ kscale, bf16_t* WT, int ldt, RowMap map, LAS float* scr, int k0, int n0, int lane) {
    f32x4 tv[8];
    const int krow = lane >> 3, nq = lane & 7;
#pragma unroll
    for (int i = 0; i < 8; ++i) tv[i] = __builtin_nontemporal_load((const f32x4*)(W + (size_t)(k0 + 8 * i + krow) * N + n0 + 4 * nq));
    if (kscale) {
#pragma unroll
        for (int i = 0; i < 8; ++i) tv[i] *= kscale[k0 + 8 * i + krow];
    }
#pragma unroll
    for (int i = 0; i < 8; ++i)
#pragma unroll
        for (int e = 0; e < 4; ++e) scr[(8 * i + krow) * 33 + 4 * nq + e] = tv[i][e];
    LDS_WAIT(); asm volatile("" ::: "memory");
    const int c = lane & 7;
#pragma unroll
    for (int j = 0; j < 4; ++j) { const int n = (lane >> 3) + 8 * j; const LAS float* s = scr + (8 * c) * 33 + n;
        u32x4 o; o.x = pk2(s[0 * 33], s[1 * 33]); o.y = pk2(s[2 * 33], s[3 * 33]); o.z = pk2(s[4 * 33], s[5 * 33]); o.w = pk2(s[6 * 33], s[7 * 33]);
        const int dr = map(n0 + n);
        if (dr >= 0) *(u32x4*)(WT + (size_t)dr * ldt + k0 + 8 * c) = o; }
    LDS_WAIT(); asm volatile("" ::: "memory");
}
template <class RowMap, bool KPERM>
__device__ __forceinline__ void tr_item8(const float* __restrict__ W, int N, const float* __restrict__ kscale, unsigned char* WT, int ldt, RowMap map, LAS float* scr, int k0, int n0, int lane) {
    f32x4 tv[8];
    const int krow = lane >> 3, nq = lane & 7;
#pragma unroll
    for (int i = 0; i < 8; ++i) tv[i] = __builtin_nontemporal_load((const f32x4*)(W + (size_t)(k0 + 8 * i + krow) * N + n0 + 4 * nq)) * FP8_WMUL;
    if (kscale) {
#pragma unroll
        for (int i = 0; i < 8; ++i) tv[i] *= kscale[k0 + 8 * i + krow];
    }
#pragma unroll
    for (int i = 0; i < 8; ++i)
#pragma unroll
        for (int e = 0; e < 4; ++e) scr[(8 * i + krow) * 33 + 4 * nq + e] = tv[i][e];
    LDS_WAIT(); asm volatile("" ::: "memory");
    const int c = lane & 7; const int oct = (k0 >> 3) + c, poct = KPERM ? (oct & ~7) + 2 * (oct & 3) + ((oct >> 2) & 1) : oct;
#pragma unroll
    for (int j = 0; j < 4; ++j) { const int n = (lane >> 3) + 8 * j; const LAS float* s = scr + (8 * c) * 33 + n;
        u32x2 o; o.x = (unsigned)__builtin_amdgcn_cvt_pk_fp8_f32(s[2 * 33], s[3 * 33], __builtin_amdgcn_cvt_pk_fp8_f32(s[0 * 33], s[1 * 33], 0, false), true);
        o.y = (unsigned)__builtin_amdgcn_cvt_pk_fp8_f32(s[6 * 33], s[7 * 33], __builtin_amdgcn_cvt_pk_fp8_f32(s[4 * 33], s[5 * 33], 0, false), true);
        const int dr = map(n0 + n);
        if (dr >= 0) *(u32x2*)(WT + (size_t)dr * ldt + poct * 8) = o; }
    LDS_WAIT(); asm volatile("" ::: "memory");
}
struct MapId { int off; __device__ __forceinline__ int operator()(int n) const { return off + n; } };
struct MapSlot { __device__ __forceinline__ int operator()(int L) const { return 256 * (L >> 8) + 128 * ((L >> 5) & 1) + 32 * ((L >> 6) & 3) + (L & 31); } };
__device__ __forceinline__ int slot_row(int s, int c64) { return 256 * (s >> 2) + 128 * (c64 >> 5) + 32 * (s & 3) + (c64 & 31); }
__device__ __forceinline__ int rope_j(int dim) { return 8 * ((dim & 15) >> 2) + 4 * (dim >> 4) + (dim & 3); }
struct MapWin { __device__ __forceinline__ int operator()(int L) const {
    if (L < 1024) return slot_row(L >> 6, L & 63);
    if (L < 1536) return 1024 + slot_row((L - 1024) >> 6, (L - 1024) & 63);
    if (L < 2176) return 1536 + slot_row((L - 1536) >> 6, (L - 1536) & 63);
    return 1536 + slot_row(10, rope_j(L - 2176));
} };
struct MapQup { __device__ __forceinline__ int operator()(int L) const { const int hd = L / 96, dd = L % 96;
    if (dd < 64) return slot_row(hd, dd);
    return 512 + slot_row(hd >> 1, 32 * (hd & 1) + rope_j(dd - 64));
} };
struct MapKVup { __device__ __forceinline__ int operator()(int L) const { const int hd = L >> 7, dd = L & 127;
    if (dd < 64) return slot_row(hd, dd);
    return 512 + slot_row(hd, dd - 64);
} };
struct MapGU { int up; __device__ __forceinline__ int operator()(int c) const { return (c >> 7) * 256 + up * 128 + (c & 127); } };

__device__ __forceinline__ int t5_bucket(int n) {
    if (n < 16) return n;
    int lg = 16 + (int)(__builtin_amdgcn_logf((float)n * 0.0625f) * (16.0f / 7.0f));
    return lg < 31 ? lg : 31;
}

#ifndef WD_IN_P0
#define WD_IN_P0 0
#endif
__device__ __forceinline__ void convert_wd(Frame& F, const Args& a, int rank, int count) {
    LAS float* scr = (LAS float*)(F.lds + F.wave * 16384);
    for (int r = rank * 8 + F.wave; r < NEXP * 256; r += count * 8) { const int e = r >> 8, q = r & 255;
        tr_item8<MapSlot, false>(a.in[I_WED] + (size_t)e * 512 * 1024, 1024, nullptr, F.ws + WS_WD + (size_t)e * 1024 * 512, 512, MapSlot{}, scr, 64 * (q >> 5), 32 * (q & 31), F.lane); }
}
__device__ __forceinline__ void p0_prologue(Frame& F, const Args& a) {
    LAS float* scr = (LAS float*)(F.lds + F.wave * 16384);
    const int gw = F.vcu * 8 + F.wave, NGW = F.G * 8, lane = F.lane;
    unsigned char* ws = F.ws;
    constexpr int I0 = 16 * 69, I1 = 6 * 24, I2 = 4 * 32, I3 = 0  , I4 = 16, I5 = NEXP * 256, I6 = NEXP * 256, I7 = WD_IN_P0 ? NEXP * 256 : 0, I8 = 4 * 32, I9 = 0  ;
    constexpr int NITEMS = I0 + I1 + I2 + I3 + I4 + I5 + I6 + I7 + I8 + I9;
    for (int it = gw; it < NITEMS; it += NGW) {
        int r = it;
        if (r < I0) { tr_item8<MapWin, true>(a.in[I_WIN], INC, a.in[I_NMG], ws + WS_WIN8, 1024, MapWin{}, scr, 64 * (r / 69), 32 * (r % 69), lane); continue; } r -= I0;
        if (r < I1) { tr_item8<MapQup, true>(a.in[I_WQUP], 768, a.in[I_QAG], ws + WS_WQUP, 512, MapQup{}, scr, 64 * (r / 24), 32 * (r % 24), lane); continue; } r -= I1;
        if (r < I2) { tr_item8<MapKVup, true>(a.in[I_WKVUP], 1024, a.in[I_KVAG], ws + WS_WKVUP, 256, MapKVup{}, scr, 64 * (r / 32), 32 * (r % 32), lane); continue; } r -= I2;
        if (r < I3) { tr_item(a.in[I_WOUT], 1024, nullptr, (bf16_t*)(ws + WS_WOUT), 1024, MapSlot{}, scr, 64 * (r / 32), 32 * (r % 32), lane); continue; } r -= I3;
        if (r < I4) { tr_item(a.in[I_WRE], 32, a.in[I_NFG], (bf16_t*)(ws + WS_WR), 1024, MapId{0}, scr, 64 * r, 0, lane); continue; } r -= I4;
        if (r < I5) { const int e = r >> 8, q = r & 255; tr_item8<MapGU, true>(a.in[I_WEG] + (size_t)e * 1024 * 512, 512, a.in[I_NFG], ws + WS_WGU + (size_t)e * 1024 * 1024, 1024, MapGU{0}, scr, 64 * (q >> 4), 32 * (q & 15), lane); continue; } r -= I5;
        if (r < I6) { const int e = r >> 8, q = r & 255; tr_item8<MapGU, true>(a.in[I_WEU] + (size_t)e * 1024 * 512, 512, a.in[I_NFG], ws + WS_WGU + (size_t)e * 1024 * 1024, 1024, MapGU{1}, scr, 64 * (q >> 4), 32 * (q & 15), lane); continue; } r -= I6;
        if (r < I7) { const int e = r >> 8, q = r & 255; tr_item(a.in[I_WED] + (size_t)e * 512 * 1024, 1024, nullptr, (bf16_t*)(ws + WS_WD) + (size_t)e * 1024 * 512, 512, MapSlot{}, scr, 64 * (q >> 5), 32 * (q & 31), lane); continue; } r -= I7;
        if (r < I8) { tr_item(a.in[I_WPP], 1024, nullptr, (bf16_t*)(ws + WS_WPP), 256, MapSlot{}, scr, 64 * (r / 32), 32 * (r % 32), lane); continue; } r -= I8;
        tr_item(a.in[I_WPG], 1024, nullptr, (bf16_t*)(ws + WS_WPG), 1024, MapSlot{}, scr, 64 * (r / 32), 32 * (r % 32), lane);
    }
    const int gt = F.vcu * 512 + F.tid, NGT = F.G * 512;
    { const float* wo = a.in[I_WOUT]; unsigned char* w8 = ws + WS_WOUT8;
      for (int i = gt; i < 1024 * 128; i += NGT) { const int n = i & 1023, k8 = i >> 10; float v[8];
#pragma unroll
          for (int j = 0; j < 8; ++j) v[j] = __builtin_nontemporal_load(wo + (size_t)(k8 * 8 + j) * 1024 + n) * FP8_WMUL;
          u32x2 q8; q8.x = (unsigned)__builtin_amdgcn_cvt_pk_fp8_f32(v[2], v[3], __builtin_amdgcn_cvt_pk_fp8_f32(v[0], v[1], 0, false), true);
          q8.y = (unsigned)__builtin_amdgcn_cvt_pk_fp8_f32(v[6], v[7], __builtin_amdgcn_cvt_pk_fp8_f32(v[4], v[5], 0, false), true);
          *(u32x2*)(w8 + (size_t)MapSlot{}(n) * 1024 + k8 * 8) = q8; } }
    { const float* wg = a.in[I_WPG]; unsigned char* w8 = ws + WS_WPG8;
      for (int i = gt; i < 1024 * 128; i += NGT) { const int n = i & 1023, k8 = i >> 10; float v[8];
#pragma unroll
          for (int j = 0; j < 8; ++j) v[j] = __builtin_nontemporal_load(wg + (size_t)(k8 * 8 + j) * 1024 + n) * FP8_WMUL;
          u32x2 q8; q8.x = (unsigned)__builtin_amdgcn_cvt_pk_fp8_f32(v[2], v[3], __builtin_amdgcn_cvt_pk_fp8_f32(v[0], v[1], 0, false), true);
          q8.y = (unsigned)__builtin_amdgcn_cvt_pk_fp8_f32(v[6], v[7], __builtin_amdgcn_cvt_pk_fp8_f32(v[4], v[5], 0, false), true);
          const int pk8 = (k8 & ~7) + 2 * (k8 & 3) + ((k8 >> 2) & 1);
          *(u32x2*)(w8 + (size_t)MapSlot{}(n) * 1024 + pk8 * 8) = q8; } }
    { bf16_t* WR = (bf16_t*)(ws + WS_WR); const float* wrg = a.in[I_WRG]; const float* nfg = a.in[I_NFG];
      for (int i = gt; i < 224 * 1024; i += NGT) { const int rr = 32 + (i >> 10), k = i & 1023; float v = 0.f; if (rr >= 128 && rr < 132) v = wrg[k * 4 + (rr - 128)] * nfg[k]; WR[(size_t)rr * 1024 + k] = (bf16_t)(pk2(v, 0.f) & 0xffffu); }
      unsigned char* WI = ws + WS_WIN8;
      for (int i = gt; i < 96 * 1024; i += NGT) { const int q = i >> 10, k = i & 1023; const int rr = (q < 32) ? 1536 + slot_row(10, 32 + q) : 1536 + slot_row(11, q - 32); WI[(size_t)rr * 1024 + k] = 0; } }
    { float* cs = (float*)(ws + WS_ROPE);
      for (int i = gt; i < 2048 * 16; i += NGT) { const int pos = i >> 4, k = i & 15; const float inv = __builtin_amdgcn_exp2f(-(float)k * (13.287712379549449f / 16.0f));
          const float ang = (float)pos * inv; double rv = (double)ang * 0.15915494309189535; rv -= __builtin_floor(rv); const float rf = (float)rv;
          cs[pos * 32 + k] = __builtin_amdgcn_cosf(rf); cs[pos * 32 + 16 + k] = __builtin_amdgcn_sinf(rf); }
      float* tb = (float*)(ws + WS_TBG); const float* relb = a.in[I_RELB];
      for (int i = gt; i < 3 * 8 * 320; i += NGT) { const int br = i / 2560, hh = (i / 320) & 7, idx = i % 320, delta = idx - 96;
          float v = -1e30f; if (delta >= 0 && delta <= 128) v = relb[t5_bucket(delta << (2 * br)) * 8 + hh] * LOG2E; tb[i] = v; }
      { float* z0 = (float*)(ws + WS_SSQCQ); float* z1 = (float*)(ws + WS_SSQCKV); float* z2 = (float*)(ws + WS_SSQE); for (int i = gt; i < M; i += NGT) { z0[i] = 0.f; z1[i] = 0.f; z2[i] = 0.f; } }
      { const u32x4 zz = {0u, 0u, 0u, 0u};
        for (int i = gt; i < M * 8; i += NGT) *(u32x4*)(ws + WS_CQ + (size_t)(i >> 3) * 512 + 384 + 16 * (i & 7)) = zz;
        for (int i = gt; i < 768 * 8; i += NGT) *(u32x4*)(ws + WS_WQUP + (size_t)(i >> 3) * 512 + 384 + 16 * (i & 7)) = zz; }
      i32x4* rr4 = (i32x4*)(ws + WS_ROWREC); unsigned* ro = (unsigned*)(ws + WS_ROWOFF);
      for (int i = gt; i < MAXT * 256; i += NGT) { rr4[i] = (i32x4){-1, 0, 0, 0}; ro[i] = 0u; }
      i32x4* rr5 = (i32x4*)(ws + WS_ROWREC2); unsigned* ro5 = (unsigned*)(ws + WS_ROWOFF2);
      for (int i = gt; i < MAXTE * 256; i += NGT) { rr5[i] = (i32x4){-1, 0, 0, 0}; ro5[i] = 0u; } }
    { const f32x4* p4 = (const f32x4*)a.in[I_P]; u32x4* pb = (u32x4*)((char*)a.out + PB_IN_OUT);
      for (int i0 = gt; i0 < M * PLE / 8; i0 += 4 * NGT) { f32x4 u[4], v[4];
#pragma unroll
          for (int j = 0; j < 4; ++j) { const int i = i0 + j * NGT; if (i < M * PLE / 8) { u[j] = __builtin_nontemporal_load(p4 + 2 * i); v[j] = __builtin_nontemporal_load(p4 + 2 * i + 1); } }
#pragma unroll
          for (int j = 0; j < 4; ++j) { const int i = i0 + j * NGT; if (i < M * PLE / 8) { u32x4 o; o.x = pk2(u[j][0], u[j][1]); o.y = pk2(u[j][2], u[j][3]); o.z = pk2(v[j][0], v[j][1]); o.w = pk2(v[j][2], v[j][3]); pb[i] = o; } } } }
    { const float* x = a.in[I_X]; float* rs1 = (float*)(ws + WS_RSTD1);
      for (int m0 = gw; m0 < M; m0 += 4 * NGW) {
          f32x4 v[4][4];
#pragma unroll
          for (int q = 0; q < 4; ++q) { const int m = m0 + q * NGW; if (m < M) { const f32x4* xr = (const f32x4*)(x + (size_t)m * DM) + lane;
#pragma unroll
              for (int j = 0; j < 4; ++j) v[q][j] = __builtin_nontemporal_load(xr + 64 * j); } }
#pragma unroll
          for (int q = 0; q < 4; ++q) { const int m = m0 + q * NGW; if (m < M) { float s = 0.f;
#pragma unroll
              for (int j = 0; j < 4; ++j) s += dot4(v[q][j]);
              const float rstd = rsq(wave_sum(s) * (1.f / DM) + EPS);
              if (lane == 0) rs1[m] = rstd;
#pragma unroll
              for (int j = 0; j < 4; ++j) { const f32x4 y = v[q][j]; const int o = (lane >> 1) + 32 * j, po = (o & ~7) + 2 * (o & 3) + ((o >> 2) & 1);
                  const unsigned hi4 = (unsigned)__builtin_amdgcn_cvt_pk_fp8_f32(y[2], y[3], __builtin_amdgcn_cvt_pk_fp8_f32(y[0], y[1], 0, false), true);
                  const f32x2 ha = __builtin_amdgcn_cvt_pk_f32_fp8((int)hi4, false), hb = __builtin_amdgcn_cvt_pk_f32_fp8((int)hi4, true);
                  const unsigned lo4 = (unsigned)__builtin_amdgcn_cvt_pk_fp8_f32(y[2] - hb[0], y[3] - hb[1], __builtin_amdgcn_cvt_pk_fp8_f32(y[0] - ha[0], y[1] - ha[1], 0, false), true);
                  const size_t pos = (size_t)m * DM + 8 * po + 4 * (lane & 1);
                  *(unsigned*)(ws + WS_XB8 + pos) = hi4; *(unsigned*)(ws + WS_XL8 + pos) = lo4; } } }
      } }
}

__device__ __forceinline__ size_t hrow(size_t r, int hd) { return (r >> 11) * (8 * SEQ) + (size_t)hd * SEQ + (r & (SEQ - 1)); }
typedef f32x4 AccT[2][2][4][2];
#define EPI_ROWS for (int ai = 0; ai < 2; ++ai) _Pragma("unroll") for (int m = 0; m < 4; ({ if (m & 1) asm volatile("" ::: "memory"); }), ++m)
#define EPI_ROW(u) ((u).pm * 256 + ai * 128 + wr * 64 + m * 16 + fr)
#define EPI_FENCE() asm volatile("" ::: "memory")
#define EPI_HALF for (int ai = 0; ai < 2; ++ai)
#define EPI_M4 _Pragma("unroll") for (int m = 0; m < 4; ++m)

struct EpiInProj {
    bf16_t *QA, *KA, *VA, *CQ, *CKV, *KR; float *ssq_cq, *ssq_ckv; const float *qn_gain, *kn_gain, *knr_gain, *rope_cs;
    __device__ __forceinline__ void operator()(const AccT& acc, const pg8::Unit& u, int wr, int wc, int fr, int fq) const {
        const int pn = u.pn;
        if (pn < 4) {
            const bool isq = pn < 2; const int head = (pn & 1) * 4 + wc; const float* gain = isq ? qn_gain : kn_gain; bf16_t* dst = isq ? QA : KA; const float sc = isq ? C2A : 1.0f;
            f32x4 g[2][2];
#pragma unroll
            for (int bj = 0; bj < 2; ++bj)
#pragma unroll
                for (int n = 0; n < 2; ++n) g[bj][n] = *(const f32x4*)(gain + 32 * bj + 8 * fq + 4 * n) * sc;
#pragma unroll
            EPI_ROWS { const size_t row = EPI_ROW(u);
                float ss = dot4(acc[ai][0][m][0]) + dot4(acc[ai][0][m][1]) + dot4(acc[ai][1][m][0]) + dot4(acc[ai][1][m][1]); ss = red_fq(ss);
                const float rn = rsq(ss * (1.f / 64.f) + EPS);
#pragma unroll
                for (int bj = 0; bj < 2; ++bj) st8(dst + hrow(row, head) * 64 + 32 * bj + 8 * fq, acc[ai][bj][m][0] * rn * g[bj][0], acc[ai][bj][m][1] * rn * g[bj][1]); }
        } else if (pn < 6) {
#pragma unroll
            EPI_ROWS { const size_t row = EPI_ROW(u);
#pragma unroll
                for (int bj = 0; bj < 2; ++bj) { const int col = (pn - 4) * 256 + 64 * wc + 32 * bj + 8 * fq; st8(VA + hrow(row, col >> 6) * 64 + (col & 63), acc[ai][bj][m][0], acc[ai][bj][m][1]); } }
        } else {
            const int s = 4 * (pn - 6) + wc;
            if (s < 10) {
                const bool iscq = s < 6; bf16_t* dst = iscq ? CQ : CKV; const int ld = iscq ? 512 : 256; const int col = iscq ? 64 * s : 64 * (s - 6);
                float* sq = iscq ? ssq_cq : ssq_ckv;
#pragma unroll
                EPI_ROWS { const size_t row = EPI_ROW(u);
                    float ss = dot4(acc[ai][0][m][0]) + dot4(acc[ai][0][m][1]) + dot4(acc[ai][1][m][0]) + dot4(acc[ai][1][m][1]); ss = red_fq(ss);
                    if (fq == 0) (void)__hip_atomic_fetch_add(sq + row, ss, RLX_AGENT);
                    {
                        u32x4 q16;
#pragma unroll
                        for (int bj = 0; bj < 2; ++bj) { const f32x4 a = acc[ai][bj][m][0], b = acc[ai][bj][m][1];
                            const unsigned lo8 = (unsigned)__builtin_amdgcn_cvt_pk_fp8_f32(a[2], a[3], __builtin_amdgcn_cvt_pk_fp8_f32(a[0], a[1], 0, false), true);
                            const unsigned hi8 = (unsigned)__builtin_amdgcn_cvt_pk_fp8_f32(b[2], b[3], __builtin_amdgcn_cvt_pk_fp8_f32(b[0], b[1], 0, false), true);
                            if (bj == 0) { q16.x = lo8; q16.y = hi8; } else { q16.z = lo8; q16.w = hi8; } }
                        *(u32x4*)((unsigned char*)dst + row * ld + col + 16 * fq) = q16; } }
            } else if (s == 10) {
                const f32x4 g1 = *(const f32x4*)(knr_gain + 4 * fq), g2 = *(const f32x4*)(knr_gain + 16 + 4 * fq);
#pragma unroll
                EPI_HALF { f32x4 cv[4], sv[4];
                EPI_M4 { const int pos = (int)(EPI_ROW(u) & (SEQ - 1)); cv[m] = *(const f32x4*)(rope_cs + pos * 32 + 4 * fq); sv[m] = *(const f32x4*)(rope_cs + pos * 32 + 16 + 4 * fq); }
                EPI_M4 { const size_t row = EPI_ROW(u);
                    f32x4 x1 = acc[ai][0][m][0], x2 = acc[ai][0][m][1];
                    float ss = red_fq(dot4(x1) + dot4(x2)); const float rn = rsq(ss * (1.f / 32.f) + EPS);
                    x1 = x1 * rn * g1; x2 = x2 * rn * g2;
                    const f32x4 c = cv[m], sn = sv[m];
                    const f32x4 o1 = x1 * c - x2 * sn, o2 = x2 * c + x1 * sn;
                    u32x2 w1, w2; w1.x = pk2(o1[0], o1[1]); w1.y = pk2(o1[2], o1[3]); w2.x = pk2(o2[0], o2[1]); w2.y = pk2(o2[2], o2[3]);
                    *(u32x2*)(KR + row * 32 + 4 * fq) = w1; *(u32x2*)(KR + row * 32 + 16 + 4 * fq) = w2; }
                EPI_FENCE(); }
            }
        }
    }
};
struct EpiRawSsq {
    unsigned char* O; float* ssq;
    __device__ __forceinline__ void operator()(const AccT& acc, const pg8::Unit& u, int wr, int wc, int fr, int fq) const {
        const unsigned rowb = (unsigned)u.pm * 256u + wr * 64u + fr, colb = 256u * u.pn + 64u * wc + 8u * fq;
#pragma unroll
        EPI_ROWS { const unsigned row = rowb + ai * 128 + m * 16;
            float ss = dot4(acc[ai][0][m][0]) + dot4(acc[ai][0][m][1]) + dot4(acc[ai][1][m][0]) + dot4(acc[ai][1][m][1]); ss = red_fq(ss);
            if (fq == 0) (void)__hip_atomic_fetch_add(ssq + row, ss, RLX_AGENT);
            u32x4 w16;
#pragma unroll
            for (int bj = 0; bj < 2; ++bj) { const f32x4 a = acc[ai][bj][m][0], b = acc[ai][bj][m][1];
                const unsigned lo8 = (unsigned)__builtin_amdgcn_cvt_pk_fp8_f32(a[2], a[3], __builtin_amdgcn_cvt_pk_fp8_f32(a[0], a[1], 0, false), true);
                const unsigned hi8 = (unsigned)__builtin_amdgcn_cvt_pk_fp8_f32(b[2], b[3], __builtin_amdgcn_cvt_pk_fp8_f32(b[0], b[1], 0, false), true);
                if (bj == 0) { w16.x = lo8; w16.y = hi8; } else { w16.z = lo8; w16.w = hi8; } }
            *(u32x4*)(O + (row * 1024u + 256u * u.pn + 64u * wc + 16u * fq)) = w16; }
    }
};
struct EpiQup {
    bf16_t* QM; const float *ssq_cq, *nope_gain, *rope_gain, *rope_cs;
    __device__ __forceinline__ void operator()(const AccT& acc, const pg8::Unit& u, int wr, int wc, int fr, int fq) const {
        const int pn = u.pn;
        if (pn < 2) {
            const int head = 4 * pn + wc; f32x4 g[2][2];
#pragma unroll
            for (int bj = 0; bj < 2; ++bj)
#pragma unroll
                for (int n = 0; n < 2; ++n) g[bj][n] = *(const f32x4*)(nope_gain + 32 * bj + 8 * fq + 4 * n) * C2M;
            float sq[2][4];
#pragma unroll
            EPI_HALF EPI_M4 sq[ai][m] = ssq_cq[EPI_ROW(u)];
#pragma unroll
            EPI_HALF EPI_M4 { const size_t row = EPI_ROW(u);
                const float rq = rsq(sq[ai][m] * (1.f / 384.f) + EPS);
                f32x4 v[2][2]; float ss = 0.f;
#pragma unroll
                for (int bj = 0; bj < 2; ++bj)
#pragma unroll
                    for (int n = 0; n < 2; ++n) { v[bj][n] = acc[ai][bj][m][n] * rq; ss += dot4(v[bj][n]); }
                ss = red_fq(ss); const float rn = rsq(ss * (1.f / 64.f) + EPS);
#pragma unroll
                for (int bj = 0; bj < 2; ++bj) st8(QM + hrow(row, head) * 96 + 32 * bj + 8 * fq, v[bj][0] * rn * g[bj][0], v[bj][1] * rn * g[bj][1]); }
        } else {
            const f32x4 g1 = *(const f32x4*)(rope_gain + 4 * fq) * C2M, g2 = *(const f32x4*)(rope_gain + 16 + 4 * fq) * C2M;
#pragma unroll
            EPI_HALF { float sq[4]; f32x4 cc[4], sn[4];
                EPI_M4 { const size_t row = EPI_ROW(u); const int pos = (int)(row & (SEQ - 1)); sq[m] = ssq_cq[row]; cc[m] = *(const f32x4*)(rope_cs + pos * 32 + 4 * fq); sn[m] = *(const f32x4*)(rope_cs + pos * 32 + 16 + 4 * fq); }
                EPI_M4 { const size_t row = EPI_ROW(u); const float rq = rsq(sq[m] * (1.f / 384.f) + EPS);
#pragma unroll
                    for (int bj = 0; bj < 2; ++bj) { const int head = 2 * wc + bj;
                        f32x4 x1 = acc[ai][bj][m][0] * rq, x2 = acc[ai][bj][m][1] * rq;
                        float ss = red_fq(dot4(x1) + dot4(x2)); const float rn = rsq(ss * (1.f / 32.f) + EPS);
                        x1 = x1 * rn * g1; x2 = x2 * rn * g2;
                        const f32x4 o1 = x1 * cc[m] - x2 * sn[m], o2 = x2 * cc[m] + x1 * sn[m];
                        u32x2 w1, w2; w1.x = pk2(o1[0], o1[1]); w1.y = pk2(o1[2], o1[3]); w2.x = pk2(o2[0], o2[1]); w2.y = pk2(o2[2], o2[3]);
                        *(u32x2*)(QM + hrow(row, head) * 96 + 64 + 4 * fq) = w1; *(u32x2*)(QM + hrow(row, head) * 96 + 80 + 4 * fq) = w2; } }
                EPI_FENCE(); }
        }
    }
};
struct EpiKVup {
    bf16_t *KN, *VM; const float *ssq_ckv, *nope_gain;
    __device__ __forceinline__ void operator()(const AccT& acc, const pg8::Unit& u, int wr, int wc, int fr, int fq) const {
        const int pn = u.pn;
        float sq[2][4];
#pragma unroll
        EPI_HALF EPI_M4 sq[ai][m] = ssq_ckv[EPI_ROW(u)];
        if (pn < 2) {
            const int head = 4 * pn + wc; f32x4 g[2][2];
#pragma unroll
            for (int bj = 0; bj < 2; ++bj)
#pragma unroll
                for (int n = 0; n < 2; ++n) g[bj][n] = *(const f32x4*)(nope_gain + 32 * bj + 8 * fq + 4 * n);
#pragma unroll
            EPI_HALF EPI_M4 { const size_t row = EPI_ROW(u);
                const float rk = rsq(sq[ai][m] * (1.f / 256.f) + EPS);
                f32x4 v[2][2]; float ss = 0.f;
#pragma unroll
                for (int bj = 0; bj < 2; ++bj)
#pragma unroll
                    for (int n = 0; n < 2; ++n) { v[bj][n] = acc[ai][bj][m][n] * rk; ss += dot4(v[bj][n]); }
                ss = red_fq(ss); const float rn = rsq(ss * (1.f / 64.f) + EPS);
#pragma unroll
                for (int bj = 0; bj < 2; ++bj) st8(KN + hrow(row, head) * 64 + 32 * bj + 8 * fq, v[bj][0] * rn * g[bj][0], v[bj][1] * rn * g[bj][1]); }
        } else {
#pragma unroll
            EPI_HALF EPI_M4 { const size_t row = EPI_ROW(u);
                const float rk = rsq(sq[ai][m] * (1.f / 256.f) + EPS);
#pragma unroll
                for (int bj = 0; bj < 2; ++bj) { const int col = (pn - 2) * 256 + 64 * wc + 32 * bj + 8 * fq; st8(VM + hrow(row, col >> 6) * 64 + (col & 63), acc[ai][bj][m][0] * rk, acc[ai][bj][m][1] * rk); } }
        }
    }
};
struct EpiWout {
    const unsigned char* XH8; bf16_t* H1B; float* ssq; unsigned char* H1F8;
    __device__ __forceinline__ void operator()(const AccT& acc, const pg8::Unit& u, int wr, int wc, int fr, int fq) const {
        const unsigned rowb = (unsigned)u.pm * 256u + wr * 64u + fr, offb = rowb * 1024u + 256u * u.pn + 64u * wc + 8u * fq;
        const char* const xc = (const char*)XH8; char* const hc = (char*)H1B; char* const sc = (char*)ssq;
        u32x4 xh[2][4], xl[2][4];
#pragma unroll
        for (int ai = 0; ai < 2; ++ai)
#pragma unroll
            for (int m = 0; m < 4; ++m) { const unsigned po = (rowb + ai * 128 + m * 16) * 1024u + 256u * u.pn + 64u * wc + 16u * fq;
                xh[ai][m] = *(const u32x4*)(xc + po); xl[ai][m] = *(const u32x4*)(xc + po + (unsigned)(WS_XL8 - WS_XB8)); }
        EPI_FENCE();
#pragma unroll
        for (int ai = 0; ai < 2; ++ai) {
#pragma unroll
            for (int m = 0; m < 4; ++m) { float ss = 0.f; u32x4 q16;
#pragma unroll
                for (int bj = 0; bj < 2; ++bj) { const unsigned h_x = bj ? xh[ai][m].z : xh[ai][m].x, h_y = bj ? xh[ai][m].w : xh[ai][m].y, l_x = bj ? xl[ai][m].z : xl[ai][m].x, l_y = bj ? xl[ai][m].w : xl[ai][m].y;
                    const f32x2 xa = __builtin_amdgcn_cvt_pk_f32_fp8((int)h_x, false) + __builtin_amdgcn_cvt_pk_f32_fp8((int)l_x, false), xb = __builtin_amdgcn_cvt_pk_f32_fp8((int)h_x, true) + __builtin_amdgcn_cvt_pk_f32_fp8((int)l_x, true);
                    const f32x2 xc2 = __builtin_amdgcn_cvt_pk_f32_fp8((int)h_y, false) + __builtin_amdgcn_cvt_pk_f32_fp8((int)l_y, false), xd = __builtin_amdgcn_cvt_pk_f32_fp8((int)h_y, true) + __builtin_amdgcn_cvt_pk_f32_fp8((int)l_y, true);
                    const f32x4 h0 = acc[ai][bj][m][0] + (f32x4){xa[0], xa[1], xb[0], xb[1]}, h1 = acc[ai][bj][m][1] + (f32x4){xc2[0], xc2[1], xd[0], xd[1]};
                    ss += dot4(h0) + dot4(h1); st8((bf16_t*)(hc + (offb + (unsigned)(ai * 128 + m * 16) * 1024u + 32u * bj) * 2u), h0, h1);
                    const unsigned lo8 = (unsigned)__builtin_amdgcn_cvt_pk_fp8_f32(h0[2], h0[3], __builtin_amdgcn_cvt_pk_fp8_f32(h0[0], h0[1], 0, false), true);
                    const unsigned hi8 = (unsigned)__builtin_amdgcn_cvt_pk_fp8_f32(h1[2], h1[3], __builtin_amdgcn_cvt_pk_fp8_f32(h1[0], h1[1], 0, false), true);
                    if (bj == 0) { q16.x = lo8; q16.y = hi8; } else { q16.z = lo8; q16.w = hi8; } }
                *(u32x4*)((char*)H1F8 + ((rowb + ai * 128 + m * 16) * 1024u + 256u * u.pn + 64u * wc + 16u * fq)) = q16;
                ss = red_fq(ss); if (fq == 0) *(float*)(sc + ((4u * u.pn + wc) * (unsigned)M + rowb + ai * 128 + m * 16) * 4u) = ss; }
            EPI_FENCE(); }
    }
};
struct EpiNull {
    float* sink;
    __device__ __forceinline__ void operator()(const AccT& acc, const pg8::Unit& u, int wr, int wc, int fr, int fq) const {
        float s = 0.f;
#pragma unroll
        for (int ai = 0; ai < 2; ++ai)
#pragma unroll
            for (int bj = 0; bj < 2; ++bj)
#pragma unroll
                for (int m = 0; m < 4; ++m)
#pragma unroll
                    for (int n = 0; n < 2; ++n) s += acc[ai][bj][m][n][0] + acc[ai][bj][m][n][1] + acc[ai][bj][m][n][2] + acc[ai][bj][m][n][3];
        if (s == 1.2345e37f) sink[0] = s;
    }
};
struct EpiRoute {
    const float *ssq_h1, *b_rg, *b_re; float* rstd2; i32x4* route; unsigned* cnt;
    __device__ __forceinline__ void operator()(const AccT& acc, const pg8::Unit& u, int wr, int wc, int fr, int fq) const {
        if (wc != 0) return;
        const f32x4 be0 = *(const f32x4*)(b_re + 8 * fq), be1 = *(const f32x4*)(b_re + 8 * fq + 4), bg = *(const f32x4*)b_rg;
        float r2v[2][4];
        float pv4[2][4][4];
#pragma unroll
        EPI_HALF EPI_M4 { const unsigned row = (unsigned)EPI_ROW(u);
#pragma unroll
            for (int q = 0; q < 4; ++q) pv4[ai][m][q] = *(const float*)((const char*)ssq_h1 + ((unsigned)(4 * fq + q) * (unsigned)M + row) * 4u); }
#pragma unroll
        EPI_HALF EPI_M4 { const size_t row = EPI_ROW(u);
            const float s = red_fq((pv4[ai][m][0] + pv4[ai][m][1]) + (pv4[ai][m][2] + pv4[ai][m][3]));
            r2v[ai][m] = rsq(s * (1.f / 1024.f) + EPS);
            if (fq == 0) rstd2[row] = r2v[ai][m]; }
        int pairv[2][4]; float wav[2][4], wbv[2][4]; bool mine[2][4];
#pragma unroll
        EPI_HALF EPI_M4 { const float r2 = r2v[ai][m];
            const f32x4 e0 = acc[ai][0][m][0] * r2 + be0, e1 = acc[ai][0][m][1] * r2 + be1;
            const f32x4 gloc = acc[ai][1][m][0] * r2 + bg;
            float gl[4];
#pragma unroll
            for (int j = 0; j < 4; ++j) gl[j] = __shfl(gloc[j], fr);
            int gi = 0; float gm = gl[0];
#pragma unroll
            for (int j = 1; j < 4; ++j) if (gl[j] > gm) { gm = gl[j]; gi = j; }
            float den = 0.f;
#pragma unroll
            for (int j = 0; j < 4; ++j) den += __expf(gl[j] - gm);
            const float gate = 1.0f / den;
            float el[8] = {e0[0], e0[1], e0[2], e0[3], e1[0], e1[1], e1[2], e1[3]};
            int i1 = 0; float l1 = el[0];
#pragma unroll
            for (int j = 1; j < 8; ++j) if (el[j] > l1) { l1 = el[j]; i1 = j; }
            int i2 = -1; float l2 = -INFINITY;
#pragma unroll
            for (int j = 0; j < 8; ++j) if (j != i1 && el[j] > l2) { l2 = el[j]; i2 = j; }
            const float w1 = gate / (1.0f + __expf(l2 - l1)), w2 = gate - w1;
            const int ea = i1 < i2 ? i1 : i2, eb = i1 < i2 ? i2 : i1;
            wav[ai][m] = i1 < i2 ? w1 : w2; wbv[ai][m] = i1 < i2 ? w2 : w1;
            pairv[ai][m] = gi * 28 + (ea * (15 - ea)) / 2 + (eb - ea - 1); mine[ai][m] = (fq == gi); }
        unsigned posv[2][4];
#pragma unroll
        EPI_HALF EPI_M4 { posv[ai][m] = 0u; if (mine[ai][m]) posv[ai][m] = __hip_atomic_fetch_add(cnt + 16 * pairv[ai][m], 1u, RLX_AGENT); }
#pragma unroll
        EPI_HALF EPI_M4 { if (mine[ai][m]) route[EPI_ROW(u)] = (i32x4){pairv[ai][m], (int)posv[ai][m], (int)__float_as_uint(wav[ai][m]), (int)__float_as_uint(wbv[ai][m])}; }
    }
};
struct EpiGateUp {
    const i32x4* rowrec2; bf16_t* HDN;
    __device__ __forceinline__ void operator()(const AccT& acc, const pg8::Unit& u, int wr, int wc, int fr, int fq) const {
        const unsigned rowb = (unsigned)u.pm * 256u + wr * 64u + fr, colb = (unsigned)u.pn * 128u + 32u * wc + 8u * fq;
        const char* const rc = (const char*)rowrec2; char* const hc = (char*)HDN;
        i32x4 rec[2][4];
#pragma unroll
        for (int ai = 0; ai < 2; ++ai)
#pragma unroll
            for (int m = 0; m < 4; ++m) rec[ai][m] = *(const i32x4*)(rc + (rowb + ai * 128 + m * 16) * 16u);
        EPI_FENCE();
#pragma unroll
        for (int ai = 0; ai < 2; ++ai) {
#pragma unroll
            for (int m = 0; m < 4; ++m) { const i32x4 rcd = rec[ai][m];
                const float r2 = __uint_as_float((unsigned)rcd.y), w = __uint_as_float((unsigned)rcd.z); const unsigned pr = (unsigned)rcd.w >> 1, slot = (unsigned)rcd.w & 1u;
                f32x4 hd[2];
#pragma unroll
                for (int n = 0; n < 2; ++n)
#pragma unroll
                    for (int e = 0; e < 4; ++e) { const float g = acc[ai][0][m][n][e] * r2, up = acc[ai][1][m][n][e] * r2; hd[n][e] = g * frcp(1.0f + fexp2(-g * LOG2E)) * up * (w * FP8_HDN_MUL); }
                const unsigned eoff = rcd.x >= 0 ? pr * 1024u + slot * 512u + colb : (unsigned)(WS_DUMMY - WS_HDN) + colb;
                u32x2 q8; q8.x = (unsigned)__builtin_amdgcn_cvt_pk_fp8_f32(hd[0][2], hd[0][3], __builtin_amdgcn_cvt_pk_fp8_f32(hd[0][0], hd[0][1], 0, false), true);
                q8.y = (unsigned)__builtin_amdgcn_cvt_pk_fp8_f32(hd[1][2], hd[1][3], __builtin_amdgcn_cvt_pk_fp8_f32(hd[1][0], hd[1][1], 0, false), true);
                *(u32x2*)(hc + eoff) = q8; }
            EPI_FENCE(); }
    }
};
struct EpiDown {
    const i32x4* rowrec; const bf16_t* H1B; unsigned char* H2F8;
    __device__ __forceinline__ void operator()(const AccT& acc, const pg8::Unit& u, int wr, int wc, int fr, int fq) const {
        const unsigned rowb = (unsigned)u.pm * 256u + wr * 64u + fr, colb = 256u * u.pn + 64u * wc + 8u * fq;
        const char* const rc = (const char*)rowrec; const char* const h1c = (const char*)H1B;
        int tk[2][4];
#pragma unroll
        for (int ai = 0; ai < 2; ++ai)
#pragma unroll
            for (int m = 0; m < 4; ++m) tk[ai][m] = *(const int*)(rc + (rowb + ai * 128 + m * 16) * 16u);
        u32x4 hv[2][4][2];
#pragma unroll
        for (int ai = 0; ai < 2; ++ai)
#pragma unroll
            for (int m = 0; m < 4; ++m) { const unsigned tok = tk[ai][m] < 0 ? 0u : (unsigned)tk[ai][m];
#pragma unroll
                for (int bj = 0; bj < 2; ++bj) hv[ai][m][bj] = *(const u32x4*)(h1c + (tok * 1024u + colb + 32u * bj) * 2u); }
        EPI_FENCE();
#pragma unroll
        for (int ai = 0; ai < 2; ++ai) {
#pragma unroll
            for (int m = 0; m < 4; ++m) { const int tok = tk[ai][m];
                const unsigned foff = tok >= 0 ? (unsigned)tok * 1024u + 256u * u.pn + 64u * wc + 16u * fq : (unsigned)(WS_DUMMY - WS_H2F8) + 16u * fq;
                u32x4 qh16, ql16;
#pragma unroll
                for (int bj = 0; bj < 2; ++bj) { const u32x4 w = hv[ai][m][bj];
                    const f32x4 a = (f32x4){bflo(w.x), bfhi(w.x), bflo(w.y), bfhi(w.y)}, b = (f32x4){bflo(w.z), bfhi(w.z), bflo(w.w), bfhi(w.w)};
                    const f32x4 r0 = a + acc[ai][bj][m][0], r1 = b + acc[ai][bj][m][1];
                    u32x2 qh, ql;
                    qh.x = (unsigned)__builtin_amdgcn_cvt_pk_fp8_f32(r0[2], r0[3], __builtin_amdgcn_cvt_pk_fp8_f32(r0[0], r0[1], 0, false), true);
                    qh.y = (unsigned)__builtin_amdgcn_cvt_pk_fp8_f32(r1[2], r1[3], __builtin_amdgcn_cvt_pk_fp8_f32(r1[0], r1[1], 0, false), true);
                    const f32x2 h0a = __builtin_amdgcn_cvt_pk_f32_fp8((int)qh.x, false), h0b = __builtin_amdgcn_cvt_pk_f32_fp8((int)qh.x, true), h1a = __builtin_amdgcn_cvt_pk_f32_fp8((int)qh.y, false), h1b = __builtin_amdgcn_cvt_pk_f32_fp8((int)qh.y, true);
                    ql.x = (unsigned)__builtin_amdgcn_cvt_pk_fp8_f32(r0[2] - h0b[0], r0[3] - h0b[1], __builtin_amdgcn_cvt_pk_fp8_f32(r0[0] - h0a[0], r0[1] - h0a[1], 0, false), true);
                    ql.y = (unsigned)__builtin_amdgcn_cvt_pk_fp8_f32(r1[2] - h1b[0], r1[3] - h1b[1], __builtin_amdgcn_cvt_pk_fp8_f32(r1[0] - h1a[0], r1[1] - h1a[1], 0, false), true);
                    if (bj == 0) { qh16.x = qh.x; qh16.y = qh.y; ql16.x = ql.x; ql16.y = ql.y; } else { qh16.z = qh.x; qh16.w = qh.y; ql16.z = ql.x; ql16.w = ql.y; } }
                *(u32x4*)((char*)H2F8 + foff) = qh16;
                *(u32x4*)((char*)H2F8 + (foff + (unsigned)(WS_H2L8 - WS_H2F8))) = ql16; }
            EPI_FENCE(); }
    }
};
struct EpiFinal {
    const unsigned char* H2F8; const bf16_t* E; const float* ssq_e; const LAS float* tb; float* out;
    __device__ __forceinline__ void operator()(const AccT& acc, const pg8::Unit& u, int wr, int wc, int fr, int fq) const {
        const unsigned colb = 256u * u.pn + 64u * wc + 8u * fq;
        const unsigned rowb = (unsigned)u.pm * 256u + wr * 64u + fr, offb = rowb * 1024u + colb;
        const char* const h2c = (const char*)H2F8; const char* const ec = (const char*)E; const char* const sqc = (const char*)ssq_e; char* const oc = (char*)out;
        u32x4 hv[2][4], lv[2][4], ev[2][4]; float sq[2][4]; unsigned sp[2][2][4][4];
#define EPIF_OFF(ai, m, bj) (offb + (unsigned)((ai) * 128 + (m) * 16) * 1024u + 32u * (bj))
#define EPIF_POFF(ai, m) ((rowb + (unsigned)((ai) * 128 + (m) * 16)) * 1024u + 256u * u.pn + 64u * wc + 16u * fq)
#define EPIF_LOAD_E(ai) do { _Pragma("unroll") for (int m = 0; m < 4; ++m) { sq[ai][m] = *(const float*)(sqc + (rowb + (ai) * 128 + m * 16) * 4u); \
            ev[ai][m] = *(const u32x4*)(ec + EPIF_POFF(ai, m)); } } while (0)
#define EPIF_LOAD_H(ai) do { _Pragma("unroll") for (int m = 0; m < 4; ++m) { hv[ai][m] = *(const u32x4*)(h2c + EPIF_POFF(ai, m)); lv[ai][m] = *(const u32x4*)(h2c + EPIF_POFF(ai, m) + (unsigned)(WS_H2L8 - WS_H2F8)); } } while (0)
        EPIF_LOAD_E(0); EPIF_LOAD_E(1);
        __builtin_amdgcn_sched_barrier(0);
#pragma unroll
        for (int bj = 0; bj < 2; ++bj) {
            const f32x4 bp0 = *(const LAS f32x4*)(tb + colb + 32 * bj), bp1 = *(const LAS f32x4*)(tb + colb + 32 * bj + 4);
#pragma unroll
            for (int ai = 0; ai < 2; ++ai)
#pragma unroll
                for (int m = 0; m < 4; ++m) {
                    const f32x4 z0 = acc[ai][bj][m][0] * (-LOG2E) + bp0, z1 = acc[ai][bj][m][1] * (-LOG2E) + bp1;
                    f32x4 s0, s1;
#pragma unroll
                    for (int e = 0; e < 4; ++e) { s0[e] = frcp(1.0f + fexp2(z0[e])); s1[e] = frcp(1.0f + fexp2(z1[e])); }
                    sp[ai][bj][m][0] = pk2(s0[0], s0[1]); sp[ai][bj][m][1] = pk2(s0[2], s0[3]); sp[ai][bj][m][2] = pk2(s1[0], s1[1]); sp[ai][bj][m][3] = pk2(s1[2], s1[3]); __builtin_amdgcn_sched_barrier(0); }
            __builtin_amdgcn_sched_barrier(0); }
        EPIF_LOAD_H(0); __builtin_amdgcn_sched_barrier(0); EPIF_LOAD_H(1);
        __builtin_amdgcn_sched_barrier(0);
#pragma unroll
        for (int ai = 0; ai < 2; ++ai) {
#pragma unroll
            for (int bj = 0; bj < 2; ++bj) {
                const f32x4 gn0 = *(const LAS f32x4*)(tb + 1024 + colb + 32 * bj), gn1 = *(const LAS f32x4*)(tb + 1024 + colb + 32 * bj + 4);
#pragma unroll
                for (int m = 0; m < 4; ++m) { const float re = rsq(sq[ai][m] * (1.f / 1024.f) + EPS); u32x2 hw, lw; if (bj == 0) { hw.x = hv[ai][m].x; hw.y = hv[ai][m].y; lw.x = lv[ai][m].x; lw.y = lv[ai][m].y; } else { hw.x = hv[ai][m].z; hw.y = hv[ai][m].w; lw.x = lv[ai][m].z; lw.y = lv[ai][m].w; } u32x2 ew; if (bj == 0) { ew.x = ev[ai][m].x; ew.y = ev[ai][m].y; } else { ew.x = ev[ai][m].z; ew.y = ev[ai][m].w; }
                    const unsigned* q = sp[ai][bj][m];
                    const f32x2 ha = __builtin_amdgcn_cvt_pk_f32_fp8((int)hw.x, false) + __builtin_amdgcn_cvt_pk_f32_fp8((int)lw.x, false), hb = __builtin_amdgcn_cvt_pk_f32_fp8((int)hw.x, true) + __builtin_amdgcn_cvt_pk_f32_fp8((int)lw.x, true);
                    const f32x2 hc = __builtin_amdgcn_cvt_pk_f32_fp8((int)hw.y, false) + __builtin_amdgcn_cvt_pk_f32_fp8((int)lw.y, false), hd = __builtin_amdgcn_cvt_pk_f32_fp8((int)hw.y, true) + __builtin_amdgcn_cvt_pk_f32_fp8((int)lw.y, true);
                    const f32x4 h0 = (f32x4){ha[0], ha[1], hb[0], hb[1]}, h1 = (f32x4){hc[0], hc[1], hd[0], hd[1]};
                    const f32x2 ea = __builtin_amdgcn_cvt_pk_f32_fp8((int)ew.x, false), eb = __builtin_amdgcn_cvt_pk_f32_fp8((int)ew.x, true), ec2 = __builtin_amdgcn_cvt_pk_f32_fp8((int)ew.y, false), ed = __builtin_amdgcn_cvt_pk_f32_fp8((int)ew.y, true);
                    const f32x4 e0 = (f32x4){ea[0], ea[1], eb[0], eb[1]} * gn0 * re, e1 = (f32x4){ec2[0], ec2[1], ed[0], ed[1]} * gn1 * re;
                    const f32x4 g0 = (f32x4){bflo(q[0]), bfhi(q[0]), bflo(q[1]), bfhi(q[1])}, g1 = (f32x4){bflo(q[2]), bfhi(q[2]), bflo(q[3]), bfhi(q[3])};
                    f32x4 oa = h0 + g0 * e0, ob = h1 + g1 * e1;
#pragma unroll
                    for (int e = 0; e < 4; ++e) {
                        auto s1 = __builtin_amdgcn_permlane16_swap(__float_as_uint(oa[e]), __float_as_uint(ob[e]), false, false);
                        auto s2 = __builtin_amdgcn_permlane32_swap(s1[0], s1[1], false, false);
                        oa[e] = __uint_as_float(s2[0]); ob[e] = __uint_as_float(s2[1]); }
                    char* o = oc + (EPIF_OFF(ai, m, bj) - 4u * fq) * 4u;
                    *(f32x4*)o = oa; *(f32x4*)(o + 64) = ob; __builtin_amdgcn_sched_barrier(0); } }
            __builtin_amdgcn_sched_barrier(0); }
#undef EPIF_LOAD_E
#undef EPIF_LOAD_H
#undef EPIF_POFF
#undef EPIF_OFF
    }
};

struct MoeSchedUp {
    const LAS int* tinfoE; int T, G, c; const char* A; const char* W; const unsigned* rowoff;
    __device__ __forceinline__ bool next(int i, pg8::Unit& u) const { const int nun = T * 4, L = i * G + c; if (L >= nun) return false; const int w = pg8::xcd_remap(L, nun); u.pm = w >> 2; u.pn = w & 3; return true; }
    __device__ __forceinline__ const char* a_base(const pg8::Unit&) const { return A; }
    __device__ __forceinline__ const char* b_base(const pg8::Unit& u) const { const int e = tinfoE[u.pm]; return W + (size_t)e * (1024 * 1024) + (size_t)u.pn * (256 * 1024); }
    __device__ __forceinline__ const char* b_base2(const pg8::Unit& u) const { return b_base(u); }
    __device__ __forceinline__ const unsigned* a_rowptr(const pg8::Unit& u, int r) const { return rowoff + u.pm * 256 + r; }
};
struct MoeSchedDown {
    const LAS int* tinfo; int T, G, c; const char* A; const char* W;
    __device__ __forceinline__ bool next(int i, pg8::Unit& u) const { const int nun = T * 4, L = i * G + c; if (L >= nun) return false; const int w = pg8::xcd_remap(L, nun); u.pm = w >> 2; u.pn = w & 3; return true; }
    __device__ __forceinline__ const char* a_base(const pg8::Unit& u) const { return A + (size_t)u.pm * (256 * 1024); }
    __device__ __forceinline__ const char* b_base(const pg8::Unit& u) const { const int e = tinfo[u.pm] >> 8; return W + (size_t)e * (1024 * 512) + (size_t)u.pn * (256 * 512); }
    __device__ __forceinline__ const char* b_base2(const pg8::Unit& u) const { const int e = tinfo[u.pm] & 255; return W + (size_t)e * (1024 * 512) + (size_t)u.pn * (256 * 512); }
    __device__ __forceinline__ const unsigned* a_rowptr(const pg8::Unit&, int) const { return nullptr; }
};

#ifndef MK_REPEAT
#define MK_REPEAT 0
#endif
#define WSP(T, off) ((T*)(F.ws + (off)))
__device__ __forceinline__ void phase1(Frame& F, const Args& args) {
    {
        pg8::DenseSched S; S.init(WSP(const bf16_t, WS_XB8), WSP(const bf16_t, WS_WIN8), M, INC_PAD, 512, F.G, (int)blockIdx.x, WGM_INPROJ); S.rs = WSP(const float, WS_RSTD1);
        EpiInProj E{WSP(bf16_t, WS_QA), WSP(bf16_t, WS_KA), WSP(bf16_t, WS_VA), WSP(bf16_t, WS_CQ), WSP(bf16_t, WS_CKV), WSP(bf16_t, WS_KROPE),
                    WSP(float, WS_SSQCQ), WSP(float, WS_SSQCKV), args.in[I_QNA], args.in[I_KNA], args.in[I_KNR], WSP(const float, WS_ROPE)};
        pg8::gemm_phase<EpiInProj, pg8::DenseSched, false, false, true, true, FP8_WS2, 0>(F.lds, 512, S, E);
    }
}
__device__ __forceinline__ void phase2(Frame& F, const Args& args) {
    {
        pg8::DenseSched S; S.init(WSP(const bf16_t, WS_CQ), WSP(const bf16_t, WS_WQUP), M, 768, 256, F.G, (int)blockIdx.x);
        EpiQup E{WSP(bf16_t, WS_QM), WSP(const float, WS_SSQCQ), args.in[I_QNN], args.in[I_QNR], WSP(const float, WS_ROPE)};
        pg8::gemm_phase<EpiQup, pg8::DenseSched, false, false, false, true, FP8_WS2, 0>(F.lds, 256, S, E);
    }
    {
        pg8::DenseSched S; S.init(WSP(const bf16_t, WS_CKV), WSP(const bf16_t, WS_WKVUP), M, 1024, 128, F.G, (int)blockIdx.x);
        EpiKVup E{WSP(bf16_t, WS_KN), WSP(bf16_t, WS_VM), WSP(const float, WS_SSQCKV), args.in[I_KNN]};
        pg8::gemm_phase<EpiKVup, pg8::DenseSched, false, false, false, true, FP8_WS2, 0>(F.lds, 128, S, E);
    }
}
__device__ __forceinline__ void phase3(Frame& F, const Args& args) {
    LAS char* shm = (LAS char*)F.lds;
    LAS float* tbl = (LAS float*)(F.lds + TB_OFF);
    if (F.G == 256) {
        const int xcd = F.vcu >> 5, jj = F.vcu & 31, grp = jj >> 2, k = jj & 3;
        for (int r = 0; r < 4; ++r) {
            const int bh = 32 * xcd + 8 * r + grp, b = bh >> 3, h = bh & 7;
#if (MK_REPEAT >> 12) & 7
            for (int q = 0; q < 2; ++q) att::mla_unit<(MK_REPEAT >> 12) & 7>(b, h, q ? k : 7 - k, WSP(const bf16_t, WS_QM), WSP(const bf16_t, WS_KN), WSP(const bf16_t, WS_KROPE), WSP(const bf16_t, WS_VM), WSP(bf16_t, WS_O2), shm);
#endif
            for (int q = 0; q < (((MK_REPEAT >> 10) & 1) ? 4 : 2); ++q)
                att::mla_unit<0>(b, h, (q & 1) ? k : 7 - k, WSP(const bf16_t, WS_QM), WSP(const bf16_t, WS_KN), WSP(const bf16_t, WS_KROPE), WSP(const bf16_t, WS_VM), (bf16_t*)args.out, shm);
        }
    } else {
        for (int bh = F.vcu; bh < BATCH * 8; bh += F.G)
            for (int qb = 0; qb < 8; ++qb)
                att::mla_unit<0>(bh >> 3, bh & 7, qb, WSP(const bf16_t, WS_QM), WSP(const bf16_t, WS_KN), WSP(const bf16_t, WS_KROPE), WSP(const bf16_t, WS_VM), (bf16_t*)args.out, shm);
    }
    for (int bh = F.vcu; bh < BATCH * 8; bh += F.G) {
        const int b = bh >> 3, h = bh & 7;
        for (int i = F.tid; i < 960; i += 512) tbl[i] = WSP(const float, WS_TBG)[(i / 320) * 2560 + h * 320 + (i % 320)];
        __syncthreads();
#if (MK_REPEAT >> 16) & 7
        att::dil_phase2<(MK_REPEAT >> 16) & 7>(b, h, WSP(const bf16_t, WS_QA), WSP(const bf16_t, WS_KA), WSP(const bf16_t, WS_VA), WSP(bf16_t, WS_O2), WSP(bf16_t, WS_O3),
                            WSP(float, WS_LSE2), WSP(float, WS_LSE3), (bf16_t*)args.out, shm, tbl);
#endif
        for (int rep = 0; rep < (((MK_REPEAT >> 11) & 1) ? 2 : 1); ++rep)
            att::dil_phase2<0>(b, h, WSP(const bf16_t, WS_QA), WSP(const bf16_t, WS_KA), WSP(const bf16_t, WS_VA), WSP(bf16_t, WS_O2), WSP(bf16_t, WS_O3),
                            WSP(float, WS_LSE2), WSP(float, WS_LSE3), (bf16_t*)args.out, shm, tbl);
        __syncthreads();
    }
}
__device__ __forceinline__ void phase4(Frame& F, const Args& args) {
#if (MK_REPEAT >> 18) & 1
    { pg8::DenseSched S; S.init((const bf16_t*)args.out, WSP(const bf16_t, WS_WOUT), M, 1024, 1024, F.G, (int)blockIdx.x);
      EpiNull E{WSP(float, WS_RSTD2)}; pg8::gemm_phase<EpiNull, pg8::DenseSched, false, false>(F.lds, 1024, S, E); }
#endif
    pg8::DenseSched S; S.init((const bf16_t*)args.out, WSP(const bf16_t, WS_WOUT8), M, 1024, 512, F.G, (int)blockIdx.x);
    EpiWout E{WSP(const unsigned char, WS_XB8), WSP(bf16_t, WS_H1B), WSP(float, WS_SSQH1), WSP(unsigned char, WS_H1F8)};
    pg8::gemm_phase<EpiWout, pg8::DenseSched, false, false, false, true, FP8_WS2, FP8_MIX_AS2>(F.lds, 512, S, E);
}
__device__ __forceinline__ void phase5(Frame& F, const Args& args) {
    pg8::DenseSched S; S.init(WSP(const bf16_t, WS_H1B), WSP(const bf16_t, WS_WR), M, 256, 1024, F.G, (int)blockIdx.x);
    EpiRoute E{WSP(const float, WS_SSQH1), args.in[I_BRG], args.in[I_BRE], WSP(float, WS_RSTD2), WSP(i32x4, WS_ROUTE), F.ctl + CW_CNT};
    pg8::gemm_phase<EpiRoute, pg8::DenseSched, false, false>(F.lds, 1024, S, E);
}
__device__ __forceinline__ int pair_index(int g, int x, int y) { const int a = x < y ? x : y, b = x < y ? y : x; return g * 28 + (a * (15 - a)) / 2 + (b - a - 1); }
__device__ __forceinline__ void phase6(Frame& F, const Args& args) {
    LAS int* mo_cnt = (LAS int*)(F.lds + MOE_OFF); LAS int* mo_start = mo_cnt + 128; LAS int* tinfo = mo_cnt + 256;
    LAS int* e_cnt = (LAS int*)(F.lds + MOE_E_OFF); LAS int* e_start = e_cnt + 32; LAS int* tinfoE = e_cnt + 96;
    LAS int* offA = (LAS int*)(F.lds + MOE_O_OFF); LAS int* offB = offA + 128;
    if (F.tid < NPAIR) mo_cnt[F.tid] = (int)__hip_atomic_load(F.ctl + CW_CNT + 16 * F.tid, RLX_AGENT);
    __syncthreads();
    if (F.tid == 0) { int acc = 0; for (int p = 0; p < NPAIR; ++p) { mo_start[p] = acc; acc += (mo_cnt[p] + 255) >> 8; } mo_start[NPAIR] = acc; }
    if (F.tid >= 128 && F.tid < 128 + NEXP) { const int e = F.tid - 128, g = e >> 3, x = e & 7; int s = 0; for (int y = 0; y < 8; ++y) if (y != x) s += mo_cnt[pair_index(g, x, y)]; e_cnt[e] = s; }
    if (F.tid >= 256 && F.tid < 256 + NPAIR) { const int p = F.tid - 256, g = p / 28, q = p % 28; int ea = 0; while (ea < 6 && ((ea + 1) * (14 - ea)) / 2 <= q) ++ea; const int eb = ea + 1 + (q - (ea * (15 - ea)) / 2);
        int sa = 0, sb = 0;
        for (int y = 0; y < 8; ++y) { if (y != ea) { const int pp = pair_index(g, ea, y); if (pp < p) sa += mo_cnt[pp]; } if (y != eb) { const int pp = pair_index(g, eb, y); if (pp < p) sb += mo_cnt[pp]; } }
        offA[p] = sa; offB[p] = sb; }
    __syncthreads();
    if (F.tid == 64) { int acc = 0; for (int e = 0; e < NEXP; ++e) { e_start[e] = acc; acc += (e_cnt[e] + 255) >> 8; } e_start[NEXP] = acc; }
    if (F.tid < NPAIR) { const int p = F.tid, g = p / 28, q = p % 28; int ea = 0; while (ea < 6 && ((ea + 1) * (14 - ea)) / 2 <= q) ++ea; const int eb = ea + 1 + (q - (ea * (15 - ea)) / 2);
        const int info = ((8 * g + ea) << 8) | (8 * g + eb); const int t0 = mo_start[p], t1 = mo_start[p + 1]; for (int t = t0; t < t1; ++t) tinfo[t] = info; }
    __syncthreads();
    if (F.tid >= 128 && F.tid < 128 + NEXP) { const int e = F.tid - 128; const int t0 = e_start[e], t1 = e_start[e + 1]; for (int t = t0; t < t1; ++t) tinfoE[t] = e; }
    __syncthreads();
    const i32x4* route = WSP(const i32x4, WS_ROUTE); const float* rstd2 = WSP(const float, WS_RSTD2);
    i32x4* rowrec = WSP(i32x4, WS_ROWREC); i32x4* rowrec2 = WSP(i32x4, WS_ROWREC2); unsigned* rowoff2 = WSP(unsigned, WS_ROWOFF2);
    for (int tok = F.vcu * 512 + F.tid; tok < M; tok += F.G * 512) { const i32x4 r = route[tok]; const int p = r.x; const int prow = (mo_start[p] << 8) + r.y; const int rs = (int)__float_as_uint(rstd2[tok]);
        rowrec[prow] = (i32x4){tok, rs, r.z, r.w};
        const int info = tinfo[mo_start[p]]; const int xa = info >> 8, xb = info & 255;
        const int ra = (e_start[xa] << 8) + offA[p] + r.y, rb = (e_start[xb] << 8) + offB[p] + r.y;
        rowrec2[ra] = (i32x4){tok, rs, r.z, 2 * prow}; rowoff2[ra] = (unsigned)tok * 1024u;
        rowrec2[rb] = (i32x4){tok, rs, r.w, 2 * prow + 1}; rowoff2[rb] = (unsigned)tok * 1024u; }
}
__device__ __forceinline__ void phase7(Frame& F, const Args& args) {
    const LAS int* e_start = (const LAS int*)(F.lds + MOE_E_OFF) + 32; const LAS int* tinfoE = (const LAS int*)(F.lds + MOE_E_OFF) + 96;
    MoeSchedUp S{tinfoE, e_start[NEXP], F.G, (int)blockIdx.x, WSP(const char, WS_H1F8), WSP(const char, WS_WGU), WSP(const unsigned, WS_ROWOFF2)};
    EpiGateUp E{WSP(const i32x4, WS_ROWREC2), WSP(bf16_t, WS_HDN)};
    pg8::gemm_phase<EpiGateUp, MoeSchedUp, true, false, false, true, FP8_WS2, 0>(F.lds, 512, S, E);
    if (!WD_IN_P0) {
        const int rem = (e_start[NEXP] * 4) % F.G, c = (int)blockIdx.x;
        if (rem == 0) convert_wd(F, args, c, F.G); else if (c >= rem) convert_wd(F, args, c - rem, F.G - rem);
    }
}
__device__ __forceinline__ void phase8(Frame& F, const Args& args) {
    const LAS int* mo_start = (const LAS int*)(F.lds + MOE_OFF) + 128; const LAS int* tinfo = (const LAS int*)(F.lds + MOE_OFF) + 256;
    MoeSchedDown S{tinfo, mo_start[NPAIR], F.G, (int)blockIdx.x, WSP(const char, WS_HDN), WSP(const char, WS_WD)};
    EpiDown E{WSP(const i32x4, WS_ROWREC), WSP(const bf16_t, WS_H1B), WSP(unsigned char, WS_H2F8)};
    pg8::gemm_phase<EpiDown, MoeSchedDown, false, true, false, true, FP8_WS2, FP8_HDN_AS2>(F.lds, 512, S, E);
    {
        pg8::DenseSched S2; S2.init((const bf16_t*)((const char*)args.out + PB_IN_OUT), WSP(const bf16_t, WS_WPP), M, 1024, 256, F.G, (int)blockIdx.x);
        EpiRawSsq E2{WSP(unsigned char, WS_E), WSP(float, WS_SSQE)};
        pg8::gemm_phase<EpiRawSsq, pg8::DenseSched, false, false>(F.lds, 256, S2, E2);
    }
}
#ifndef MK_STAGGER9
#define MK_STAGGER9 0
#endif
__device__ __forceinline__ void stagger_start(unsigned ticks) {
    if (ticks) { const unsigned long long t0 = __builtin_amdgcn_s_memrealtime(); while (__builtin_amdgcn_s_memrealtime() - t0 < (unsigned long long)ticks) __builtin_amdgcn_s_sleep(16); }
}
__device__ __forceinline__ void phase9(Frame& F, const Args& args, const bf16_t* Esrc) {
    stagger_start(((blockIdx.x >> 3) & 3) * MK_STAGGER9);
    pg8::DenseSched S; S.init(WSP(const bf16_t, WS_H2F8), WSP(const bf16_t, WS_WPG8), M, 1024, 512, F.G, (int)blockIdx.x);
    LAS float* tb = (LAS float*)(F.lds + TB_OFF);
    for (int i = F.tid; i < 1024; i += 512) { tb[i] = args.in[I_BPG][i] * (-LOG2E); tb[1024 + i] = args.in[I_PNG][i]; }
    __syncthreads();
    EpiFinal E{WSP(const unsigned char, WS_H2F8), Esrc, WSP(const float, WS_SSQE), tb, args.out};
    pg8::gemm_phase<EpiFinal, pg8::DenseSched, false, false, false, true, FP8_WS2, 0>(F.lds, 512, S, E);
}

__global__ void __launch_bounds__(512, 2) hybrid_fwd(Args args) {
    extern __shared__ __attribute__((aligned(16))) unsigned char lds_raw[];
    Frame F;
    F.lds = (LAS unsigned char*)lds_raw;
    F.MISC = (volatile LAS unsigned*)(F.lds + MISC_OFF);
    F.tid = threadIdx.x; F.lane = F.tid & 63; F.wave = __builtin_amdgcn_readfirstlane(F.tid >> 6);
    F.G = gridDim.x; { const int bx = blockIdx.x; F.vcu = (F.G % 8 == 0) ? (bx % 8) * (F.G / 8) + bx / 8 : bx; }
    F.ws = args.ws; F.ctl = (unsigned*)(args.ws + WS_CTL);
    for (int u = F.tid; u < 128; u += 512) ((LAS unsigned*)(F.lds + MISC_OFF))[u] = 0u;
    __syncthreads();
    XcdBarrier bar = xcd_barrier_post(F.ctl + CW_BAR, F.MISC + 8);
#define RUN(k, call) do { call; if ((MK_REPEAT >> (k)) & 1) { xcd_barrier(bar); call; } } while (0)
    RUN(0, p0_prologue(F, args)); xcd_barrier(bar);
    RUN(1, phase1(F, args)); xcd_barrier(bar);
    RUN(2, phase2(F, args)); xcd_barrier(bar);
    RUN(3, phase3(F, args)); xcd_barrier(bar);
    RUN(4, phase4(F, args)); xcd_barrier(bar);
    phase5(F, args); xcd_barrier(bar);
    phase6(F, args); xcd_barrier(bar);
    RUN(7, phase7(F, args)); xcd_barrier(bar);
    RUN(8, phase8(F, args)); xcd_barrier(bar);
    phase9(F, args, WSP(const bf16_t, WS_E));
#undef RUN
}

extern "C" void kernel_launch(void* const* d_in, const int* in_sizes, int n_in, void* d_out, int out_size, void* d_ws, size_t ws_size, hipStream_t stream) {
    static int grid = 0;
    if (grid == 0) {
        if (n_in != 28 || in_sizes[0] != M * DM || out_size != M * DM || ws_size < WS_END) { fprintf(stderr, "kernel_launch: unexpected problem (n_in %d, in0 %d, out %d, ws %zu); nothing launched\n", n_in, n_in > 0 ? in_sizes[0] : -1, out_size, ws_size); grid = -1; return; }
        int dev = 0, cus = 0, per_cu = 0;
        if (hipGetDevice(&dev) != hipSuccess || hipDeviceGetAttribute(&cus, hipDeviceAttributeMultiprocessorCount, dev) != hipSuccess) { grid = -1; return; }
        if (hipFuncSetAttribute((const void*)hybrid_fwd, hipFuncAttributeMaxDynamicSharedMemorySize, LDS_BYTES) != hipSuccess) { fprintf(stderr, "kernel_launch: hipFuncSetAttribute failed\n"); grid = -1; return; }
        if (hipOccupancyMaxActiveBlocksPerMultiprocessor(&per_cu, (const void*)hybrid_fwd, 512, LDS_BYTES) != hipSuccess || per_cu < 1) { fprintf(stderr, "kernel_launch: occupancy query reports %d workgroups per CU\n", per_cu); }
        (void)hipGetLastError();
        grid = cus;
    }
    if (grid < 0) return;
    if (hipMemsetAsync((char*)d_ws + WS_CTL, 0, CTL_ZERO_BYTES, stream) != hipSuccess) return;
    Args a{};
    for (int i = 0; i < 28; ++i) a.in[i] = (const float*)d_in[i];
    a.out = (float*)d_out; a.ws = (unsigned char*)d_ws;
    hipLaunchKernelGGL(hybrid_fwd, dim3(grid), dim3(512), LDS_BYTES, stream, a);
}
```
